# Optimizing an MI355X kernel written in HIP

```python
import jax, jax.numpy as jnp
from jax import lax
import numpy as np

D_MODEL = 2048
BATCH = 4
SEQ = 8192
DEPTH = 4

FOX_W = 3 * D_MODEL // 8
RWKV_W = 5 * D_MODEL // 16
RET_W = D_MODEL - FOX_W - RWKV_W
FOX_HEAD_DIM = 128
FOX_HEADS = FOX_W // FOX_HEAD_DIM
RWKV_HEAD_DIM = 64
RWKV_HEADS = RWKV_W // RWKV_HEAD_DIM
RET_HEAD_DIM = 128
RET_HEADS = RET_W // RET_HEAD_DIM
DECAY_LORA = 64
ICLR_LORA = 64
GATE_LORA = 128
D_FF = 4 * D_MODEL
BLOCK_Q = 128
RET_CHUNK = 128
ROPE_BASE = 10000.0
LN_EPS = 1e-5
RWKV_GN_EPS = 64e-5
RET_GN_EPS = 1e-5
ALPHA = (2 * DEPTH) ** 0.25
BETA = (8 * DEPTH) ** -0.25

FOX_SIZES = (FOX_W, FOX_W, FOX_W, FOX_HEADS)
RWKV_SIZES = (RWKV_W, RWKV_W, RWKV_W, DECAY_LORA, ICLR_LORA, GATE_LORA)
RET_SIZES = (RET_W, RET_W, RET_W, RET_W)
FOX_COLS = sum(FOX_SIZES)
RWKV_COLS = sum(RWKV_SIZES)
RET_COLS = sum(RET_SIZES)
P_IN = FOX_COLS + RWKV_COLS + RET_COLS

kernel_name = 'hybrid_fox_rwkv7_retention_deepnorm'


def _split(h, sizes):
    out, o = [], 0
    for s in sizes:
        out.append(h[..., o:o + s])
        o += s
    return out


def layer_norm(x, g, b):
    xf = x.astype(jnp.float32)
    mu = jnp.mean(xf, -1, keepdims=True)
    var = jnp.mean(jnp.square(xf - mu), -1, keepdims=True)
    return ((xf - mu) * lax.rsqrt(var + LN_EPS) * g + b).astype(x.dtype)


def head_norm(y, g, b, eps):
    mu = jnp.mean(y, -1, keepdims=True)
    var = jnp.mean(jnp.square(y - mu), -1, keepdims=True)
    hd = y.shape[-2:]
    return (y - mu) * lax.rsqrt(var + eps) * g.reshape(hd) + b.reshape(hd)


def rotary(x):
    half = x.shape[-1] // 2
    inv = 1.0 / (ROPE_BASE ** (jnp.arange(half, dtype=jnp.float32) / half))
    ang = jnp.arange(x.shape[1], dtype=jnp.float32)[:, None] * inv[None, :]
    cos = jnp.cos(ang)[None, :, None, :]
    sin = jnp.sin(ang)[None, :, None, :]
    x1, x2 = x[..., :half], x[..., half:]
    return jnp.concatenate([x1 * cos - x2 * sin, x1 * sin + x2 * cos], -1)


def forgetting_attention(q, k, v, f_logit):
    B, S, H, d = q.shape
    c = jnp.cumsum(jax.nn.log_sigmoid(f_logit), axis=1).transpose(0, 2, 1)
    qh = (q * d ** -0.5).transpose(0, 2, 1, 3)
    kh = k.transpose(0, 2, 1, 3)
    vh = v.transpose(0, 2, 1, 3)
    kpos = jnp.arange(S)

    def one_block(i):
        start = i * BLOCK_Q
        qb = lax.dynamic_slice_in_dim(qh, start, BLOCK_Q, axis=2)
        cb = lax.dynamic_slice_in_dim(c, start, BLOCK_Q, axis=2)
        s = jnp.einsum('bhqd,bhkd->bhqk', qb, kh) + cb[..., None] - c[:, :, None, :]
        qpos = start + jnp.arange(BLOCK_Q)
        s = jnp.where(kpos[None, :] <= qpos[:, None], s, -jnp.inf)
        p = jax.nn.softmax(s, axis=-1)
        return jnp.einsum('bhqk,bhkd->bhqd', p, vh)

    out = lax.map(one_block, jnp.arange(S // BLOCK_Q))
    return out.transpose(1, 0, 3, 2, 4).reshape(B, S, H * d)


def rwkv7_time_mix(h, mu, w0, w_up, a0, a_up, g_up, k_k, k_a, r_k, gn_w, gn_b):
    B, S, _ = h.shape
    H, N = RWKV_HEADS, RWKV_HEAD_DIM
    h_prev = jnp.pad(h, ((0, 0), (1, 0), (0, 0)))[:, :-1]
    h = h + (h_prev - h) * mu
    r, k, v, wd, ad, gd = _split(h, RWKV_SIZES)
    w = -jax.nn.softplus(-(w0 + jnp.tanh(wd) @ w_up)) - 0.5
    decay = jnp.exp(-jnp.exp(w))
    a = jax.nn.sigmoid(a0 + ad @ a_up)
    g = jax.nn.sigmoid(gd) @ g_up
    hs = lambda t: t.reshape(B, S, H, N)
    kk = hs(k * k_k)
    kk = kk / jnp.maximum(jnp.sqrt(jnp.sum(kk * kk, -1, keepdims=True)), 1e-12)
    k = k * (1.0 + (a - 1.0) * k_a)
    r, k, v, a, decay = hs(r), hs(k), hs(v), hs(a), hs(decay)
    a_vec = -kk
    b_vec = kk * a

    def step(state, inp):
        r_t, w_t, k_t, v_t, a_t, b_t = inp
        sa = jnp.einsum('bhvk,bhk->bhv', state, a_t)
        state = (state * w_t[:, :, None, :] + sa[..., None] * b_t[:, :, None, :]
                 + v_t[..., None] * k_t[:, :, None, :])
        return state, jnp.einsum('bhvk,bhk->bhv', state, r_t)

    tm = lambda t: jnp.moveaxis(t, 1, 0)
    state0 = jnp.zeros((B, H, N, N), r.dtype)
    _, y = lax.scan(step, state0, (tm(r), tm(decay), tm(k), tm(v), tm(a_vec), tm(b_vec)))
    y = jnp.moveaxis(y, 0, 1)
    y = head_norm(y, gn_w, gn_b, RWKV_GN_EPS)
    y = y + jnp.sum(r * k * r_k, -1, keepdims=True) * v
    return y.reshape(B, S, H * N) * g


def retention(q, k, v, g, gn_w, gn_b):
    B, S, H, d = q.shape
    C = RET_CHUNK
    n = S // C
    log_g = jnp.log(1.0 - 2.0 ** (-5.0 - jnp.arange(H, dtype=jnp.float32)))
    pos = jnp.arange(C, dtype=jnp.float32)
    rel = pos[:, None] - pos[None, :]
    inner_decay = jnp.where(rel >= 0, jnp.exp(log_g[:, None, None] * jnp.maximum(rel, 0.0)), 0.0)
    q_decay = jnp.exp(log_g[:, None] * (pos + 1.0))[..., None]
    k_decay = jnp.exp(log_g[:, None] * (C - 1.0 - pos))[..., None]
    chunk_decay = jnp.exp(log_g * C)[:, None, None]
    q = rotary(q)
    k = rotary(k) * d ** -0.5
    ch = lambda t: t.reshape(B, n, C, H, d).transpose(1, 0, 3, 2, 4)

    def step(R, inp):
        qc, kc, vc = inp
        inner = jnp.einsum('bhqd,bhkd->bhqk', qc, kc) * inner_decay
        o = (jnp.einsum('bhqk,bhkd->bhqd', inner, vc)
             + jnp.einsum('bhqd,bhde->bhqe', qc, R) * q_decay)
        R = chunk_decay * R + jnp.einsum('bhkd,bhke->bhde', kc * k_decay, vc)
        return R, o

    R0 = jnp.zeros((B, H, d, d), q.dtype)
    _, o = lax.scan(step, R0, (ch(q), ch(k), ch(v)))
    o = o.transpose(1, 0, 3, 2, 4).reshape(B, S, H, d)
    o = head_norm(o, gn_w, gn_b, RET_GN_EPS).reshape(B, S, H * d)
    return jax.nn.silu(g) * o


def setup_inputs(seed: int = 0) -> dict:
    key = jax.random.key(seed)
    ks = jax.random.split(key, 24)
    f32 = jnp.float32
    nrm = lambda k, shape, s: jax.random.normal(k, shape, f32) * s
    uni = lambda k, shape, lo, hi: jax.random.uniform(k, shape, f32, lo, hi)
    L = DEPTH
    return {
        'x': nrm(ks[0], (BATCH, SEQ, D_MODEL), 1.0),
        'w_in': nrm(ks[1], (L, D_MODEL, P_IN), D_MODEL ** -0.5),
        'fox_forget_bias': uni(ks[2], (L, FOX_HEADS), 1.0, 4.0),
        'rwkv_mu': uni(ks[3], (L, RWKV_COLS), 0.0, 1.0),
        'rwkv_w0': uni(ks[4], (L, RWKV_W), -5.0, 0.0),
        'rwkv_w_up': nrm(ks[5], (L, DECAY_LORA, RWKV_W), 0.1),
        'rwkv_a0': nrm(ks[6], (L, RWKV_W), 0.1),
        'rwkv_a_up': nrm(ks[7], (L, ICLR_LORA, RWKV_W), ICLR_LORA ** -0.5),
        'rwkv_g_up': nrm(ks[8], (L, GATE_LORA, RWKV_W), GATE_LORA ** -0.5),
        'rwkv_k_k': 0.85 + nrm(ks[9], (L, RWKV_W), 0.05),
        'rwkv_k_a': 1.0 + nrm(ks[10], (L, RWKV_W), 0.05),
        'rwkv_r_k': nrm(ks[11], (L, RWKV_HEADS, RWKV_HEAD_DIM), 0.1),
        'rwkv_gn_w': 1.0 + nrm(ks[12], (L, RWKV_W), 0.05),
        'rwkv_gn_b': nrm(ks[13], (L, RWKV_W), 0.02),
        'ret_gn_w': 1.0 + nrm(ks[14], (L, RET_W), 0.05),
        'ret_gn_b': nrm(ks[15], (L, RET_W), 0.02),
        'w_out': nrm(ks[16], (L, D_MODEL, D_MODEL), BETA * D_MODEL ** -0.5),
        'ln1_g': 1.0 + nrm(ks[17], (L, D_MODEL), 0.05),
        'ln1_b': nrm(ks[18], (L, D_MODEL), 0.02),
        'w_up': nrm(ks[19], (L, D_MODEL, D_FF), BETA * D_MODEL ** -0.5),
        'w_down': nrm(ks[20], (L, D_FF, D_MODEL), BETA * D_FF ** -0.5),
        'ln2_g': 1.0 + nrm(ks[21], (L, D_MODEL), 0.05),
        'ln2_b': nrm(ks[22], (L, D_MODEL), 0.02),
    }


def reference(x, w_in, fox_forget_bias, rwkv_mu, rwkv_w0, rwkv_w_up, rwkv_a0, rwkv_a_up,
              rwkv_g_up, rwkv_k_k, rwkv_k_a, rwkv_r_k, rwkv_gn_w, rwkv_gn_b, ret_gn_w, ret_gn_b,
              w_out, ln1_g, ln1_b, w_up, w_down, ln2_g, ln2_b):
    B, S, _ = x.shape
    for l in range(DEPTH):
        h = jnp.einsum('bsd,dp->bsp', x, w_in[l]).astype(jnp.float32)
        h_fox, h_rwkv, h_ret = _split(h, (FOX_COLS, RWKV_COLS, RET_COLS))

        fq, fk, fv, ff = _split(h_fox, FOX_SIZES)
        fh = lambda t: t.reshape(B, S, FOX_HEADS, FOX_HEAD_DIM)
        y_fox = forgetting_attention(fh(fq), fh(fk), fh(fv), ff + fox_forget_bias[l])

        y_rwkv = rwkv7_time_mix(h_rwkv, rwkv_mu[l], rwkv_w0[l], rwkv_w_up[l], rwkv_a0[l],
                                rwkv_a_up[l], rwkv_g_up[l], rwkv_k_k[l], rwkv_k_a[l],
                                rwkv_r_k[l], rwkv_gn_w[l], rwkv_gn_b[l])

        rq, rk, rv, rg = _split(h_ret, RET_SIZES)
        rh = lambda t: t.reshape(B, S, RET_HEADS, RET_HEAD_DIM)
        y_ret = retention(rh(rq), rh(rk), rh(rv), rg, ret_gn_w[l], ret_gn_b[l])

        mix = jnp.concatenate([y_fox, y_rwkv, y_ret], axis=-1).astype(x.dtype)
        x = layer_norm(ALPHA * x + mix @ w_out[l], ln1_g[l], ln1_b[l])

        hid = jnp.square(jax.nn.relu(x @ w_up[l]))
        x = layer_norm(ALPHA * x + hid @ w_down[l], ln2_g[l], ln2_b[l])
    return x
```

```cpp
#include <hip/hip_runtime.h>
#include <hip/hip_bf16.h>
#include <cstdio>
#include <cstdint>
#include <cmath>
__device__ __forceinline__ int otid() { int t = (int)threadIdx.x; asm volatile("; otid" : "+v"(t)); return t; }
namespace pg8 {
#define PG8_LAS __attribute__((address_space(3)))
typedef unsigned short bf16_t;
typedef short bf16x8 __attribute__((ext_vector_type(8)));
typedef float f32x4 __attribute__((ext_vector_type(4)));
typedef unsigned u32x4 __attribute__((ext_vector_type(4)));
constexpr int BM = 256, BK = 64, HALF = 128, HTB = HALF * BK * 2  , STAGE_BYTES = 8 * HTB, NXCD = 8, WGM = 8;

__host__ __device__ __forceinline__ int lds_byte(int r, int c) { const int st = (r >> 4) * 2 + (c >> 5), rr = r & 15, cc = c & 31, ob = rr * 64 + cc * 2; return st * 1024 + (ob ^ (((ob >> 9) & 1) << 5)); }
__host__ __device__ __forceinline__ void stage_rc(int b, int& R, int& C) { const int st = b / 1024, sb = b % 1024, swz = sb ^ (((sb >> 9) & 1) << 5); R = (st >> 1) * 16 + swz / 64; C = (st & 1) * 32 + (swz % 64) / 2; }
__host__ __device__ __forceinline__ int perm32(int rho) { const int n = rho >> 4, i = rho & 15; return 8 * (i >> 2) + 4 * n + (i & 3); }

struct Unit { int pm, pn; };
struct Gemm { const bf16_t* A; const bf16_t* Bt; int M, N, K; };

struct StaticOrder {
    int nM, nN, nwg, G, c;
    __host__ __device__ void init(int M, int N, int G_, int c_) { nM = M / BM; nN = N / BM; nwg = nM * nN; G = G_; c = c_; }
    __host__ __device__ bool next(int i, Unit& u) const {
        const long L = (long)i * G + c; if (L >= nwg) return false;
        int wgid = (int)L; { const int q = nwg / NXCD, r = nwg % NXCD, xcd = wgid % NXCD, off = wgid / NXCD; wgid = (xcd < r ? xcd * (q + 1) : r * (q + 1) + (xcd - r) * q) + off; }
        const int nig = WGM * nN, gid = wgid / nig, fm = gid * WGM, gsz = (nM - fm) < WGM ? (nM - fm) : WGM;
        u.pm = fm + ((wgid % nig) % gsz); u.pn = (wgid % nig) / gsz; return true;
    }
    __device__ __forceinline__ void a_ready(const Unit&) const {}
    __device__ __forceinline__ void done(const Unit&) const {}
};

__device__ __forceinline__ unsigned cvt_pk_bf16(float lo, float hi) { unsigned r; asm volatile("v_cvt_pk_bf16_f32 %0, %1, %2" : "=v"(r) : "v"(lo), "v"(hi)); return r; }
typedef float f32x2 __attribute__((ext_vector_type(2)));
__device__ __forceinline__ f32x2 gelu_pk(f32x2 v) {
    const f32x2 av = __builtin_elementwise_abs(v), d = av * 0.2316418882f + 1.0f;
    f32x2 t; t.x = __builtin_amdgcn_rcpf(d.x); t.y = __builtin_amdgcn_rcpf(d.y);
    f32x2 q = t * 0.5307027145f + (-0.7265760135f); q = q * t + 0.7107068705f; q = q * t + (-0.142248368f); q = q * t + 0.127414796f; q = q * t;
    const f32x2 s = (v * v) * (-0.72134752044f);
    f32x2 e; e.x = __builtin_amdgcn_exp2f(s.x); e.y = __builtin_amdgcn_exp2f(s.y);
    const f32x2 m = v * (q * e), r = v - m;
    f32x2 o; o.x = v.x < 0.f ? m.x : r.x; o.y = v.y < 0.f ? m.y : r.y; return o;
}

template <int ACT  > struct EpiBf16 {
    static constexpr bool PERM = true, AFTER_DRAIN = false; static_assert(ACT == 0 || ACT == 1, "EpiBf16: ACT is 0 (none) or 1 (gelu_pk)");
    bf16_t* O; int ldc; const float* bias; int split_cols; size_t split_stride; float scale0;
    __device__ __forceinline__ void operator()(const f32x4 (&acc)[2][2][4][2], const Unit& u, int wr, int wc, int fr, int fq) const {
        const int row0 = u.pm * BM + wr * 64 + fr; int colt = u.pn * BM; bf16_t* base = O;
        float sc = 1.f; if (split_cols) { const int t = colt / split_cols; base += (size_t)t * split_stride; colt -= t * split_cols; if (t == 0) sc = scale0; }
        const int col0 = colt + wc * 32 + 8 * fq, bcol0 = u.pn * BM + wc * 32 + 8 * fq;
        f32x4 bv[2][2];
#pragma unroll
        for (int bj = 0; bj < 2; ++bj)
#pragma unroll
            for (int n = 0; n < 2; ++n) bv[bj][n] = bias ? *(const f32x4*)(bias + bcol0 + bj * HALF + 4 * n) : (f32x4){0.f, 0.f, 0.f, 0.f};
#pragma unroll
        for (int ai = 0; ai < 2; ++ai)
#pragma unroll
            for (int m = 0; m < 4; ++m) { bf16_t* rowp = base + (size_t)(row0 + ai * HALF + m * 16) * ldc + col0;
#pragma unroll
                for (int bj = 0; bj < 2; ++bj) { f32x4 v0 = acc[ai][bj][m][0] + bv[bj][0], v1 = acc[ai][bj][m][1] + bv[bj][1];
                    if (ACT == 1) { f32x2 a = gelu_pk((f32x2){v0[0], v0[1]}), b = gelu_pk((f32x2){v0[2], v0[3]}), c = gelu_pk((f32x2){v1[0], v1[1]}), d = gelu_pk((f32x2){v1[2], v1[3]});
                        v0 = (f32x4){a.x, a.y, b.x, b.y}; v1 = (f32x4){c.x, c.y, d.x, d.y}; }
                    v0 = v0 * sc; v1 = v1 * sc; u32x4 w; w.x = cvt_pk_bf16(v0[0], v0[1]); w.y = cvt_pk_bf16(v0[2], v0[3]); w.z = cvt_pk_bf16(v1[0], v1[1]); w.w = cvt_pk_bf16(v1[2], v1[3]);
                    *(u32x4*)(rowp + bj * HALF) = w; } }
    }
};

struct PanelStats {
    unsigned* xbuf;
    unsigned* cnt;
    unsigned* tmo;
    int ntn; float eps;
    unsigned code;
    __device__ __forceinline__ bool run(const f32x4 (&v)[2][2][4][2], const Unit& u, int wr, int wc, int fr, int fq, PG8_LAS unsigned char* lds, int wid, int lane) const {
        typedef float f32x2v __attribute__((ext_vector_type(2)));
        PG8_LAS f32x2v* P = (PG8_LAS f32x2v*)lds;
        PG8_LAS f32x2v* S = (PG8_LAS f32x2v*)(lds + 8192);
        PG8_LAS unsigned* flag = (PG8_LAS unsigned*)(lds + 8192 + 2048);
#pragma unroll
        for (int ai = 0; ai < 2; ++ai)
#pragma unroll
            for (int m = 0; m < 4; ++m) {
                float s = 0.f;
#pragma unroll
                for (int bj = 0; bj < 2; ++bj)
#pragma unroll
                    for (int n = 0; n < 2; ++n) { const f32x4 x = v[ai][bj][m][n]; s += (x[0] + x[1]) + (x[2] + x[3]); }
                s += __shfl_xor(s, 16); s += __shfl_xor(s, 32);
                const float mw = s * (1.0f / 64.0f); float q = 0.f;
#pragma unroll
                for (int bj = 0; bj < 2; ++bj)
#pragma unroll
                    for (int n = 0; n < 2; ++n) { const f32x4 d = v[ai][bj][m][n] - mw; q += (d[0] * d[0] + d[1] * d[1]) + (d[2] * d[2] + d[3] * d[3]); }
                q += __shfl_xor(q, 16); q += __shfl_xor(q, 32);
                if (fq == 0) P[(ai * HALF + wr * 64 + m * 16 + fr) * 4 + wc] = (f32x2v){mw, q};
            }
        asm volatile("s_waitcnt lgkmcnt(0)" ::: "memory"); __builtin_amdgcn_s_barrier(); asm volatile("" ::: "memory");
#if defined(BROKEN_EXCHANGE_NO_WAIT)
#warning BROKEN CONTROL BUILD: the row-statistics exchange does not wait; results are wrong by design
        if (blockIdx.x >= 64) { const long long t0_ = clock64(); while (clock64() - t0_ < 60000) __builtin_amdgcn_s_sleep(8); }
#endif
        const int row = wid * 32 + (lane & 31);
        if (lane < 32) {
            const f32x2v a = P[row * 4 + 0], b = P[row * 4 + 1], c = P[row * 4 + 2], d = P[row * 4 + 3];
            const float mt = (a.x + b.x + c.x + d.x) * 0.25f;
            const float da = a.x - mt, db = b.x - mt, dc = c.x - mt, dd = d.x - mt;
            const float m2 = (a.y + b.y) + (c.y + d.y) + 64.0f * ((da * da + db * db) + (dc * dc + dd * dd));
            unsigned long long* slot = (unsigned long long*)xbuf + ((size_t)(u.pm * BM + row) * 4 + u.pn);
            __hip_atomic_store(slot, ((unsigned long long)__float_as_uint(m2) << 32) | __float_as_uint(mt), __ATOMIC_RELAXED, __HIP_MEMORY_SCOPE_AGENT);
        }
        asm volatile("s_waitcnt vmcnt(0)" ::: "memory");
        if (lane == 0) __hip_atomic_fetch_add(cnt + 64 * u.pm, 1u, __ATOMIC_RELAXED, __HIP_MEMORY_SCOPE_AGENT);
        if (wid == 0) {
            bool dead = false; const unsigned long long t0 = __builtin_amdgcn_s_memrealtime(); const unsigned want = 8u * (unsigned)ntn;
            for (;;) {
#if defined(BROKEN_EXCHANGE_NO_WAIT)
                break;
#endif
                if ((unsigned)__builtin_amdgcn_readfirstlane(__hip_atomic_load(cnt + 64 * u.pm, __ATOMIC_RELAXED, __HIP_MEMORY_SCOPE_AGENT)) >= want) break;
                if (__builtin_amdgcn_s_memrealtime() - t0 > 2000000ull) {
                    if (lane == 0) { unsigned expect = 0u; __hip_atomic_compare_exchange_strong(tmo + 1, &expect, code | (unsigned)(u.pm & 0xff), __ATOMIC_RELAXED, __ATOMIC_RELAXED, __HIP_MEMORY_SCOPE_AGENT);
                                     __hip_atomic_store(tmo, 1u, __ATOMIC_RELAXED, __HIP_MEMORY_SCOPE_AGENT); }
                    dead = true; break; }
                __builtin_amdgcn_s_sleep(2);
            }
            __builtin_amdgcn_fence(__ATOMIC_ACQUIRE, "agent");
            if (lane == 0) flag[0] = dead ? 1u : 0u;
        }
        asm volatile("s_waitcnt vmcnt(0) lgkmcnt(0)" ::: "memory"); __builtin_amdgcn_s_barrier(); asm volatile("" ::: "memory");
        const bool bad = flag[0] != 0u;
        if (lane < 32) {
            const unsigned long long* slot = (const unsigned long long*)xbuf + (size_t)(u.pm * BM + row) * 4; float mt[4], m2[4]; float ms = 0.f;
#pragma unroll
            for (int t = 0; t < 4; ++t) { if (t < ntn) { const unsigned long long w = __hip_atomic_load(slot + t, __ATOMIC_RELAXED, __HIP_MEMORY_SCOPE_AGENT); mt[t] = __uint_as_float((unsigned)w); m2[t] = __uint_as_float((unsigned)(w >> 32)); } else { mt[t] = 0.f; m2[t] = 0.f; } ms += mt[t]; }
            const float mean = ms / (float)ntn; float q = 0.f;
#pragma unroll
            for (int t = 0; t < 4; ++t) if (t < ntn) { const float dm = mt[t] - mean; q += m2[t] + 256.0f * dm * dm; }
            S[row] = (f32x2v){mean, 1.0f / sqrtf(q / (256.0f * (float)ntn) + eps)};
        }
        asm volatile("s_waitcnt lgkmcnt(0)" ::: "memory"); __builtin_amdgcn_s_barrier(); asm volatile("" ::: "memory");
        return bad;
    }
};
struct EpiLnRes {
    static constexpr bool PERM = false, AFTER_DRAIN = true;
    const float* base; float* out; int ldc; const float* bias; PanelStats st; unsigned poison;
    __device__ __forceinline__ void fused(f32x4 (&acc)[2][2][4][2], const Unit& u, int wr, int wc, int fr, int fq, PG8_LAS unsigned char* lds, int wid, int lane) const {
        typedef float f32x2v __attribute__((ext_vector_type(2)));
        const PG8_LAS f32x2v* S = (const PG8_LAS f32x2v*)(lds + 8192);
        const int col0 = u.pn * BM + wc * 32 + 4 * fq;
#pragma unroll
        for (int bj = 0; bj < 2; ++bj)
#pragma unroll
            for (int n = 0; n < 2; ++n) { const f32x4 bv = bias ? *(const f32x4*)(bias + col0 + bj * HALF + n * 16) : (f32x4){0.f, 0.f, 0.f, 0.f};
#pragma unroll
                for (int ai = 0; ai < 2; ++ai)
#pragma unroll
                    for (int m = 0; m < 4; ++m) acc[ai][bj][m][n] += bv; }
        f32x4 pre[4][2][2];
#pragma unroll
        for (int m = 0; m < 4; ++m) { const size_t off = (size_t)(u.pm * BM + wr * 64 + m * 16 + fr) * ldc + col0;
#pragma unroll
            for (int bj = 0; bj < 2; ++bj)
#pragma unroll
                for (int n = 0; n < 2; ++n) pre[m][bj][n] = *(const f32x4*)(base + off + bj * HALF + n * 16); }
        const bool bad = st.run(acc, u, wr, wc, fr, fq, lds, wid, lane) || poison != 0u;
        const float qnan = __builtin_nanf("");
#pragma unroll
        for (int ai = 0; ai < 2; ++ai)
#pragma unroll
            for (int m = 0; m < 4; ++m) { const int r = ai * HALF + wr * 64 + m * 16 + fr; const f32x2v sr = S[r]; const size_t off = (size_t)(u.pm * BM + r) * ldc + col0;
#pragma unroll
                for (int bj = 0; bj < 2; ++bj)
#pragma unroll
                    for (int n = 0; n < 2; ++n) { const f32x4 bs = ai == 0 ? pre[m][bj][n] : *(const f32x4*)(base + off + bj * HALF + n * 16); f32x4 o = bs + (acc[ai][bj][m][n] - sr.x) * sr.y;
                        if (bad) o = (f32x4){qnan, qnan, qnan, qnan}; *(f32x4*)(out + off + bj * HALF + n * 16) = o; }
                if (m & 1) asm volatile("" ::: "memory"); }
    }
};
struct EpiLnResLn {
    static constexpr bool PERM = false, AFTER_DRAIN = true;
    const float* base; float* out; bf16_t* xn; int ldc; const float* bias; PanelStats st1, st2; unsigned poison;
    __device__ __forceinline__ void fused(f32x4 (&acc)[2][2][4][2], const Unit& u, int wr, int wc, int fr, int fq, PG8_LAS unsigned char* lds, int wid, int lane) const {
        typedef float f32x2v __attribute__((ext_vector_type(2))); typedef unsigned u32x2v __attribute__((ext_vector_type(2)));
        const PG8_LAS f32x2v* S = (const PG8_LAS f32x2v*)(lds + 8192);
        const int col0 = u.pn * BM + wc * 32 + 4 * fq;
#pragma unroll
        for (int bj = 0; bj < 2; ++bj)
#pragma unroll
            for (int n = 0; n < 2; ++n) { const f32x4 bv = bias ? *(const f32x4*)(bias + col0 + bj * HALF + n * 16) : (f32x4){0.f, 0.f, 0.f, 0.f};
#pragma unroll
                for (int ai = 0; ai < 2; ++ai)
#pragma unroll
                    for (int m = 0; m < 4; ++m) acc[ai][bj][m][n] += bv; }
        bool bad = st1.run(acc, u, wr, wc, fr, fq, lds, wid, lane) || poison != 0u;
        const float qnan = __builtin_nanf("");
#pragma unroll
        for (int ai = 0; ai < 2; ++ai)
#pragma unroll
            for (int m = 0; m < 4; ++m) { const int r = ai * HALF + wr * 64 + m * 16 + fr; const f32x2v sr = S[r]; const size_t off = (size_t)(u.pm * BM + r) * ldc + col0;
#pragma unroll
                for (int bj = 0; bj < 2; ++bj)
#pragma unroll
                    for (int n = 0; n < 2; ++n) { const f32x4 bs = *(const f32x4*)(base + off + bj * HALF + n * 16); acc[ai][bj][m][n] = bs + (acc[ai][bj][m][n] - sr.x) * sr.y; }
                asm volatile("" : "+v"(acc[ai][0][m][0]), "+v"(acc[ai][0][m][1]), "+v"(acc[ai][1][m][0]), "+v"(acc[ai][1][m][1]));
                if (m & 1) asm volatile("" ::: "memory"); }
        const bool bad1 = bad;
        bad = st2.run(acc, u, wr, wc, fr, fq, lds, wid, lane) || bad;
#pragma unroll
        for (int ai = 0; ai < 2; ++ai)
#pragma unroll
            for (int m = 0; m < 4; ++m) { const int r = ai * HALF + wr * 64 + m * 16 + fr; const f32x2v sr = S[r]; const size_t off = (size_t)(u.pm * BM + r) * ldc + col0;
#pragma unroll
                for (int bj = 0; bj < 2; ++bj)
#pragma unroll
                    for (int n = 0; n < 2; ++n) { const f32x4 x1 = acc[ai][bj][m][n]; *(f32x4*)(out + off + bj * HALF + n * 16) = bad1 ? (f32x4){qnan, qnan, qnan, qnan} : x1;
                        const f32x4 o = (x1 - sr.x) * sr.y; u32x2v w; w.x = cvt_pk_bf16(o[0], o[1]); w.y = cvt_pk_bf16(o[2], o[3]);
                        if (bad) { w.x = 0x7fc07fc0u; w.y = 0x7fc07fc0u; } *(u32x2v*)(xn + off + bj * HALF + n * 16) = w; }
                asm volatile("" ::: "memory"); }
    }
};

template <class Epi, class Sched, bool ALIGN_EPI = false, bool SP2 = false>
__device__ __forceinline__ void gemm_phase(PG8_LAS unsigned char* lds, const Gemm g, const Sched& S, const Epi& E) {
    const int tid = otid(), wid = __builtin_amdgcn_readfirstlane(tid >> 6), lane = tid & 63, wr = wid >> 2, wc = wid & 3, fr = lane & 15, fq = lane >> 4;
    const int K = g.K, nt = K / BK;
    unsigned voffA[2], voffB[2];
#pragma unroll
    for (int i = 0; i < 2; ++i) { int R, C; stage_rc(tid * 16 + i * 8192, R, C); const int Rb = Epi::PERM ? ((R & ~31) + perm32(R & 31)) : R;
        voffA[i] = (unsigned)(R * K + C) * 2u; voffB[i] = (unsigned)(Rb * K + C) * 2u; }
    const size_t kstep = (size_t)(BK * 2);
    const size_t hstep = (size_t)HALF * K * 2;
    const size_t tstep = 2 * hstep;
    const unsigned ldsw = (unsigned)wid * 1024u;
    const int aoff = lds_byte(wr * 64 + fr, fq * 8), boff = lds_byte(wc * 32 + fr, fq * 8);
#define PG8_SA(b, h) (((b) * 2 + (h)) * HTB)
#define PG8_SB(b, h) ((4 + (b) * 2 + (h)) * HTB)
#define PG8_STAGE(bufoff, gbase, voff) do { _Pragma("unroll") for (int _i = 0; _i < 2; ++_i) \
        __builtin_amdgcn_global_load_lds((const unsigned*)((const char*)(gbase) + (voff)[_i]), (PG8_LAS unsigned*)(lds + (bufoff) + ldsw + _i * 8192), 16, 0, 0); } while (0)
#define PG8_LDA(dst, b, h) do { _Pragma("unroll") for (int m = 0; m < 4; ++m) _Pragma("unroll") for (int k = 0; k < 2; ++k) dst[m][k] = *(const PG8_LAS bf16x8*)(lds + PG8_SA(b, h) + aoff + m * 2048 + k * 1024); } while (0)
#define PG8_LDB(dst, b, h) do { _Pragma("unroll") for (int n = 0; n < 2; ++n) _Pragma("unroll") for (int k = 0; k < 2; ++k) dst[n][k] = *(const PG8_LAS bf16x8*)(lds + PG8_SB(b, h) + boff + n * 2048 + k * 1024); } while (0)
#define PG8_MMA(ai, bj, At, Bt) do { __builtin_amdgcn_s_setprio(1); _Pragma("unroll") for (int m = 0; m < 4; ++m) _Pragma("unroll") for (int n = 0; n < 2; ++n) _Pragma("unroll") for (int k = 0; k < 2; ++k) \
        acc[ai][bj][m][n] = __builtin_amdgcn_mfma_f32_16x16x32_bf16(Bt[n][k], At[m][k], acc[ai][bj][m][n], 0, 0, 0); __builtin_amdgcn_s_setprio(0); } while (0)
#define PG8_WAIT_V(n) asm volatile("s_waitcnt vmcnt(" #n ")" ::: "memory")
#define PG8_WAIT_L(n) asm volatile("s_waitcnt lgkmcnt(" #n ")" ::: "memory")
#define PG8_BAR __builtin_amdgcn_s_barrier()
#define PG8_SCHED __builtin_amdgcn_sched_barrier(0)
    Unit cur, nxt; int ui = 0;
    if (!S.next(0, cur)) return;
    f32x4 acc[2][2][4][2];
#pragma unroll
    for (int a = 0; a < 2; ++a)
#pragma unroll
        for (int b = 0; b < 2; ++b)
#pragma unroll
            for (int m = 0; m < 4; ++m)
#pragma unroll
                for (int n = 0; n < 2; ++n) acc[a][b][m][n] = (f32x4){0.f, 0.f, 0.f, 0.f};
    bf16x8 At[4][2], B0[2][2], B1[2][2];
    const char* cA = (const char*)g.A + (size_t)cur.pm * tstep; const char* cB = (const char*)g.Bt + (size_t)cur.pn * tstep;
    S.a_ready(cur);
    if constexpr (SP2) {
        PG8_STAGE(PG8_SB(0, 0), cB, voffB); PG8_STAGE(PG8_SB(0, 1), cB + hstep, voffB); PG8_STAGE(PG8_SA(0, 0), cA, voffA); PG8_STAGE(PG8_SA(0, 1), cA + hstep, voffA);
        if (wr == 1) PG8_BAR;
        PG8_WAIT_V(2); PG8_BAR;
        PG8_STAGE(PG8_SB(1, 0), cB + kstep, voffB); PG8_STAGE(PG8_SA(1, 0), cA + kstep, voffA); PG8_STAGE(PG8_SB(1, 1), cB + hstep + kstep, voffB);
        PG8_WAIT_V(6); PG8_BAR;
    } else {
        PG8_STAGE(PG8_SB(0, 0), cB, voffB); PG8_STAGE(PG8_SA(0, 0), cA, voffA); PG8_STAGE(PG8_SB(0, 1), cB + hstep, voffB); PG8_STAGE(PG8_SA(0, 1), cA + hstep, voffA);
        if (wr == 1) PG8_BAR;
        PG8_WAIT_V(4); PG8_BAR;
        PG8_STAGE(PG8_SB(1, 0), cB + kstep, voffB); PG8_STAGE(PG8_SA(1, 0), cA + kstep, voffA); PG8_STAGE(PG8_SB(1, 1), cB + hstep + kstep, voffB);
        PG8_WAIT_V(6); PG8_BAR;
    }
    for (;;) {
        const bool has_next = S.next(ui + 1, nxt);
        const char* nA = has_next ? (const char*)g.A + (size_t)nxt.pm * tstep : cA; const char* nB = has_next ? (const char*)g.Bt + (size_t)nxt.pn * tstep : cB;
        for (int t = 0; t < nt; t += 2) {
            const bool last = (t == nt - 2);
            const char* a1 = cA + (size_t)(t + 1) * kstep;
            const char* a2 = last ? nA : cA + (size_t)(t + 2) * kstep; const char* b2 = last ? nB : cB + (size_t)(t + 2) * kstep;
            const char* a3 = a2 + kstep; const char* b3 = b2 + kstep;
            if (last && has_next) S.a_ready(nxt);
            if constexpr (SP2) {
            PG8_LDB(B0, 0, 0); PG8_LDB(B1, 0, 1); PG8_SCHED; PG8_LDA(At, 0, 0); PG8_STAGE(PG8_SA(1, 1), a1 + hstep, voffA);
            PG8_WAIT_V(8); PG8_WAIT_L(0); PG8_BAR; PG8_MMA(0, 0, At, B0); PG8_MMA(0, 1, At, B1); PG8_BAR; PG8_SCHED;
            PG8_LDA(At, 0, 1); PG8_STAGE(PG8_SB(0, 0), b2, voffB); PG8_STAGE(PG8_SB(0, 1), b2 + hstep, voffB); PG8_STAGE(PG8_SA(0, 0), a2, voffA);
            PG8_WAIT_V(8); PG8_WAIT_L(0); PG8_BAR; PG8_MMA(1, 0, At, B0); PG8_MMA(1, 1, At, B1); PG8_BAR; PG8_SCHED;
            PG8_LDB(B0, 1, 0); PG8_LDB(B1, 1, 1); PG8_SCHED; PG8_LDA(At, 1, 0); PG8_STAGE(PG8_SA(0, 1), a2 + hstep, voffA);
            PG8_WAIT_V(8); PG8_WAIT_L(0); PG8_BAR; PG8_MMA(0, 0, At, B0); PG8_MMA(0, 1, At, B1); PG8_BAR; PG8_SCHED;
            PG8_LDA(At, 1, 1); PG8_STAGE(PG8_SB(1, 0), b3, voffB); PG8_STAGE(PG8_SB(1, 1), b3 + hstep, voffB); PG8_STAGE(PG8_SA(1, 0), a3, voffA);
            PG8_WAIT_V(8); PG8_WAIT_L(0); PG8_BAR; PG8_MMA(1, 0, At, B0); PG8_MMA(1, 1, At, B1); PG8_BAR; PG8_SCHED;
            } else {
            PG8_LDB(B0, 0, 0); PG8_SCHED; PG8_LDA(At, 0, 0); PG8_STAGE(PG8_SA(1, 1), a1 + hstep, voffA);
            PG8_WAIT_L(8); PG8_BAR; PG8_WAIT_L(0); PG8_MMA(0, 0, At, B0); PG8_BAR; PG8_SCHED;
            PG8_LDB(B1, 0, 1); PG8_STAGE(PG8_SB(0, 0), b2, voffB);
            PG8_BAR; PG8_WAIT_L(0); PG8_MMA(0, 1, At, B1); PG8_BAR;
            PG8_LDA(At, 0, 1); PG8_STAGE(PG8_SA(0, 0), a2, voffA);
            PG8_BAR; PG8_WAIT_L(0); PG8_MMA(1, 0, At, B0); PG8_BAR; PG8_SCHED;
            PG8_STAGE(PG8_SB(0, 1), b2 + hstep, voffB);
            PG8_WAIT_V(6); PG8_BAR; PG8_MMA(1, 1, At, B1); PG8_BAR;
            PG8_LDB(B0, 1, 0); PG8_SCHED; PG8_LDA(At, 1, 0); PG8_STAGE(PG8_SA(0, 1), a2 + hstep, voffA);
            PG8_WAIT_L(8); PG8_BAR; PG8_WAIT_L(0); PG8_MMA(0, 0, At, B0); PG8_BAR; PG8_SCHED;
            PG8_LDB(B1, 1, 1); PG8_STAGE(PG8_SB(1, 0), b3, voffB);
            PG8_BAR; PG8_WAIT_L(0); PG8_MMA(0, 1, At, B1); PG8_BAR;
            PG8_LDA(At, 1, 1); PG8_STAGE(PG8_SA(1, 0), a3, voffA);
            PG8_BAR; PG8_WAIT_L(0); PG8_MMA(1, 0, At, B0); PG8_BAR; PG8_SCHED;
            PG8_STAGE(PG8_SB(1, 1), b3 + hstep, voffB);
            PG8_WAIT_V(6); PG8_BAR; PG8_MMA(1, 1, At, B1); PG8_BAR;
            }
        }
        if constexpr (ALIGN_EPI) { if (wr == 0) PG8_BAR; }
        if constexpr (!Epi::AFTER_DRAIN) { E(acc, cur, wr, wc, fr, fq); S.done(cur); }
        if (!has_next) break;
#pragma unroll
        for (int a = 0; a < 2; ++a)
#pragma unroll
            for (int b = 0; b < 2; ++b)
#pragma unroll
                for (int m = 0; m < 4; ++m)
#pragma unroll
                    for (int n = 0; n < 2; ++n) acc[a][b][m][n] = (f32x4){0.f, 0.f, 0.f, 0.f};
        cur = nxt; cA = nA; cB = nB; ++ui;
        if constexpr (ALIGN_EPI) { if (wr == 1) PG8_BAR; }
    }
    PG8_WAIT_V(0);
    if constexpr (!ALIGN_EPI) { if (wr == 0) PG8_BAR; }
    PG8_BAR;
    if constexpr (Epi::AFTER_DRAIN) { E.fused(acc, cur, wr, wc, fr, fq, lds, wid, lane); S.done(cur); }
#undef PG8_SA
#undef PG8_SB
#undef PG8_STAGE
#undef PG8_LDA
#undef PG8_LDB
#undef PG8_MMA
#undef PG8_WAIT_V
#undef PG8_WAIT_L
#undef PG8_BAR
#undef PG8_SCHED
}
}
namespace pg8 {
struct EpiRelu2 {
    static constexpr bool PERM = true, AFTER_DRAIN = false;
    bf16_t* O; int ldc;
    __device__ __forceinline__ void operator()(const f32x4 (&acc)[2][2][4][2], const Unit& u, int wr, int wc, int fr, int fq) const {
        const int row0 = u.pm * BM + wr * 64 + fr, col0 = u.pn * BM + wc * 32 + 8 * fq;
#pragma unroll
        for (int ai = 0; ai < 2; ++ai)
#pragma unroll
            for (int m = 0; m < 4; ++m) { bf16_t* rowp = O + (size_t)(row0 + ai * HALF + m * 16) * ldc + col0;
#pragma unroll
                for (int bj = 0; bj < 2; ++bj) { f32x4 v0 = acc[ai][bj][m][0], v1 = acc[ai][bj][m][1];
#pragma unroll
                    for (int j = 0; j < 4; ++j) { const float a = fmaxf(v0[j], 0.f), b = fmaxf(v1[j], 0.f); v0[j] = a * a; v1[j] = b * b; }
                    u32x4 w; w.x = cvt_pk_bf16(v0[0], v0[1]); w.y = cvt_pk_bf16(v0[2], v0[3]); w.z = cvt_pk_bf16(v1[0], v1[1]); w.w = cvt_pk_bf16(v1[2], v1[3]);
                    *(u32x4*)(rowp + bj * HALF) = w; } }
    }
};
struct EpiResid {
    static constexpr bool PERM = false, AFTER_DRAIN = false;
    float* X; int ldc; float alpha;
    __device__ __forceinline__ void operator()(const f32x4 (&acc)[2][2][4][2], const Unit& u, int wr, int wc, int fr, int fq) const {
        const int row0 = u.pm * BM + wr * 64 + fr, col0 = u.pn * BM + wc * 32 + 4 * fq;
#pragma unroll
        for (int ai = 0; ai < 2; ++ai)
#pragma unroll
            for (int m = 0; m < 4; ++m) { float* rowp = X + (size_t)(row0 + ai * HALF + m * 16) * ldc + col0;
#pragma unroll
                for (int bj = 0; bj < 2; ++bj)
#pragma unroll
                    for (int n = 0; n < 2; ++n) { f32x4* q = (f32x4*)(rowp + bj * HALF + n * 16); *q = *q * alpha + acc[ai][bj][m][n]; } }
    }
};
}
#ifndef PG8_SP2
#define PG8_SP2 true
#endif
#ifndef PG8_ALIGN
#define PG8_ALIGN true
#endif
namespace fox {
constexpr int D = 128;
constexpr int LDQ = 7168;
constexpr int LDO = 2048;
constexpr float THR = 8.f;
constexpr bool WSKIP = false;
constexpr float SCALE = 0.08838834764831845f;
constexpr int NW = 8, QBLK = 32, KVBLK = 64, QB = NW * QBLK;
constexpr int SHM_V = KVBLK * D * 2, SHM_K = KVBLK * D * 2;
constexpr int CB_OFF = 2 * SHM_V + 2 * SHM_K + NW * 64 * 4;
constexpr int LDS_BYTES = CB_OFF + 2 * 64 * 4;
using bf16 = __hip_bfloat16;
typedef short bf16x8 __attribute__((ext_vector_type(8)));
typedef short s16x4 __attribute__((ext_vector_type(4)));
typedef float f32x16 __attribute__((ext_vector_type(16)));
typedef float f32x4 __attribute__((ext_vector_type(4)));
typedef unsigned u32x4 __attribute__((ext_vector_type(4)));
template <class A, class Bt> struct same_t { static constexpr bool v = false; };
template <class A> struct same_t<A, A> { static constexpr bool v = true; };

#define KSWZ(row, colB) ((row) * 256 + ((colB) ^ (((row) & 7) << 4)))
#define SBAR() __builtin_amdgcn_sched_barrier(0)
__device__ __forceinline__ int v_st(int k, int c) { const int kk = (k & ~0xC) | ((k & 4) << 1) | ((k & 8) >> 1); return ((kk >> 3) * 4 + (c >> 5)) * 512 + ((kk & 7) * 32 + (c & 31)) * 2; }
__device__ __forceinline__ int v_rd_base(int lane) { return ((lane & 3) << 3) | (((lane >> 2) & 3) << 6) | (((lane >> 4) & 1) << 5) | (((lane >> 5) & 1) << 8); }
constexpr int v_rd_off(int d0, int ks, int half) { return d0 * 512 + ks * 4096 + half * 2048; }
__device__ __forceinline__ int crow(int r, int hi) { return (r & 3) + 8 * (r >> 2) + 4 * hi; }
__device__ __forceinline__ unsigned cvtpk(float lo, float hi) {
    unsigned r; asm volatile("v_cvt_pk_bf16_f32 %0, %1, %2" : "=v"(r) : "v"(lo), "v"(hi)); return r;
}
__device__ __forceinline__ bf16x8 pack8(f32x4 a, f32x4 b) {
    u32x4 w = {cvtpk(a[0], a[1]), cvtpk(a[2], a[3]), cvtpk(b[0], b[1]), cvtpk(b[2], b[3])};
    return *reinterpret_cast<bf16x8*>(&w);
}
template <class T> __device__ __forceinline__ bf16x8 load8(const T* p) {
    if constexpr (same_t<T, float>::v) { return pack8(*(const f32x4*)p, *(const f32x4*)(p + 4)); }
    else { return *reinterpret_cast<const bf16x8*>(p); }
}
__device__ __forceinline__ void mask_tile(f32x16& p0, f32x16& p1, int dq, unsigned W) {
    const float NEG = -__builtin_inff();
#pragma unroll
    for (int r = 0; r < 16; ++r) {
        const int c = (r & 3) + 8 * (r >> 2);
        if ((unsigned)(dq - c) >= W) p0[r] = NEG;
        if ((unsigned)(dq - c - 32) >= W) p1[r] = NEG;
    }
}
__device__ __forceinline__ void partialSM(f32x16& p0, f32x16& p1, float& m_reg, float& mn, float& alpha) {
    float pmax = p0[0]; for (int r = 1; r < 16; ++r) pmax = fmaxf(pmax, p0[r]); for (int r = 0; r < 16; ++r) pmax = fmaxf(pmax, p1[r]);
    { auto rr = __builtin_amdgcn_permlane32_swap(__float_as_uint(pmax), __float_as_uint(pmax), false, false);
      pmax = fmaxf(__uint_as_float(rr[0]), __uint_as_float(rr[1])); }
    constexpr float C2 = 1.4426950408889634f * SCALE;
    if (__builtin_expect(__all((pmax - m_reg) * SCALE <= THR), 1)) { mn = m_reg; alpha = 1.f; }
    else { mn = fmaxf(m_reg, pmax); alpha = __builtin_amdgcn_exp2f((m_reg - mn) * C2); m_reg = mn; }
    const float mnL = -mn * C2;
    for (int r = 0; r < 16; ++r) p0[r] = fmaf(p0[r], C2, mnL); for (int r = 0; r < 16; ++r) p1[r] = fmaf(p1[r], C2, mnL);
    for (int r = 0; r < 16; ++r) p0[r] = __builtin_amdgcn_exp2f(p0[r]);
}
__device__ __forceinline__ void finishSM(f32x16& p0, f32x16& p1, float alpha, float& l_reg, bf16x8& pa0, bf16x8& pa1, bf16x8& pa2, bf16x8& pa3) {
    for (int r = 0; r < 16; ++r) p1[r] = __builtin_amdgcn_exp2f(p1[r]);
    float ps = 0; for (int r = 0; r < 16; ++r) ps += p0[r]; for (int r = 0; r < 16; ++r) ps += p1[r];
    { auto rr = __builtin_amdgcn_permlane32_swap(__float_as_uint(ps), __float_as_uint(ps), false, false);
      ps = __uint_as_float(rr[0]) + __uint_as_float(rr[1]); }
    l_reg = l_reg * alpha + ps;
#define PK4(P, B_, OUT) do { unsigned a0 = cvtpk(P[B_+0], P[B_+1]), a1 = cvtpk(P[B_+2], P[B_+3]);                          \
        unsigned b0 = cvtpk(P[B_+4], P[B_+5]), b1 = cvtpk(P[B_+6], P[B_+7]);                                             \
        auto r0 = __builtin_amdgcn_permlane32_swap(a0, b0, false, false); auto r1 = __builtin_amdgcn_permlane32_swap(a1, b1, false, false); \
        u32x4 w = {r0[0], r1[0], r0[1], r1[1]}; OUT = *reinterpret_cast<bf16x8*>(&w); } while (0)
    PK4(p0, 0, pa0); PK4(p0, 8, pa1); PK4(p1, 0, pa2); PK4(p1, 8, pa3);
#undef PK4
}
template <int KB, bool SK>
__device__ __forceinline__ void qkt(f32x16& p0, f32x16& p1, const char* K_lds, int r32, int hi, const bf16x8* qr, bool act) {
    const float* cbp = (const float*)(K_lds + 2 * SHM_K + NW * 64 * 4) + KB * 64;
    if (SK && !act) { const float NEG = -__builtin_inff();
#pragma unroll
        for (int r = 0; r < 16; ++r) { p0[r] = NEG; p1[r] = NEG; } return; }
    {
      const float c0 = cbp[r32], c1 = cbp[32 + r32];
      const unsigned u0 = __float_as_uint(c0), h0 = u0 & 0xffff0000u; const float r0 = c0 - __uint_as_float(h0); const unsigned m0 = __float_as_uint(r0) & 0xffff0000u; const unsigned l0 = __float_as_uint(r0 - __uint_as_float(m0));
      const unsigned u1 = __float_as_uint(c1), h1 = u1 & 0xffff0000u; const float r1 = c1 - __uint_as_float(h1); const unsigned m1 = __float_as_uint(r1) & 0xffff0000u; const unsigned l1 = __float_as_uint(r1 - __uint_as_float(m1));
      const u32x4 a0 = {(h0 >> 16) | m0, l0 >> 16, 0u, 0u}, a1 = {(h1 >> 16) | m1, l1 >> 16, 0u, 0u};
      const unsigned on = hi == 0 ? 0x3f803f80u : 0u; const u32x4 ones = {on, on, 0u, 0u};
      p0 = __builtin_amdgcn_mfma_f32_32x32x16_bf16(*reinterpret_cast<const bf16x8*>(&a0), *reinterpret_cast<const bf16x8*>(&ones), f32x16{}, 0, 0, 0);
      p1 = __builtin_amdgcn_mfma_f32_32x32x16_bf16(*reinterpret_cast<const bf16x8*>(&a1), *reinterpret_cast<const bf16x8*>(&ones), f32x16{}, 0, 0, 0); }
    const char* kb[4];
#pragma unroll
    for (int dd = 0; dd < 4; ++dd) kb[dd] = K_lds + KB * SHM_K + KSWZ(r32, (dd * 16 + hi * 8) * 2);
#pragma unroll
    for (int d0 = 0; d0 < 8; ++d0) { const char* a = kb[d0 & 3] + (d0 >> 2) * 128;
        bf16x8 b0 = *reinterpret_cast<const bf16x8*>(a);
        bf16x8 b1 = *reinterpret_cast<const bf16x8*>(a + 32 * 256);
        p0 = __builtin_amdgcn_mfma_f32_32x32x16_bf16(b0, qr[d0], p0, 0, 0, 0);
        p1 = __builtin_amdgcn_mfma_f32_32x32x16_bf16(b1, qr[d0], p1, 0, 0, 0); }
}
template <int VB, bool SK>
__device__ __forceinline__ void pv_tile(f32x16* o, int vb0, bf16x8 pa0, bf16x8 pa1, bf16x8 pa2, bf16x8 pa3, bool act) {
    if (SK && !act) return;
#define TRRD(dst, off) asm volatile("ds_read_b64_tr_b16 %0, %1 offset:%2" : "=&v"(dst) : "v"(vb0), "i"(off) : "memory")
#define PV_D0(d0) do { s16x4 l0, l1, l2, l3, h0, h1, h2, h3; constexpr int b_ = VB * SHM_V + v_rd_off(d0, 0, 0);     \
        TRRD(l0, b_); TRRD(h0, b_ + 2048); TRRD(l1, b_ + 4096); TRRD(h1, b_ + 6144); TRRD(l2, b_ + 8192); TRRD(h2, b_ + 10240); TRRD(l3, b_ + 12288); TRRD(h3, b_ + 14336); \
        asm volatile("s_waitcnt lgkmcnt(0)" ::: "memory"); SBAR();                 \
        o[d0] = __builtin_amdgcn_mfma_f32_32x32x16_bf16(pa0, (bf16x8){l0[0], l0[1], l0[2], l0[3], h0[0], h0[1], h0[2], h0[3]}, o[d0], 0, 0, 0);   \
        o[d0] = __builtin_amdgcn_mfma_f32_32x32x16_bf16(pa1, (bf16x8){l1[0], l1[1], l1[2], l1[3], h1[0], h1[1], h1[2], h1[3]}, o[d0], 0, 0, 0);   \
        o[d0] = __builtin_amdgcn_mfma_f32_32x32x16_bf16(pa2, (bf16x8){l2[0], l2[1], l2[2], l2[3], h2[0], h2[1], h2[2], h2[3]}, o[d0], 0, 0, 0);   \
        o[d0] = __builtin_amdgcn_mfma_f32_32x32x16_bf16(pa3, (bf16x8){l3[0], l3[1], l3[2], l3[3], h3[0], h3[1], h3[2], h3[3]}, o[d0], 0, 0, 0); } while (0)
    PV_D0(0); PV_D0(1); PV_D0(2); PV_D0(3);
#undef PV_D0
#undef TRRD
}

template <class TIn, class TOut> struct BlockRef { const TIn* Q; const TIn* K; const TIn* V; TOut* O; const float* C; int P0; };
template <class TIn> struct Seam {
    bf16x8 qr[8];
    bf16x8 st_v0, st_v1, st_k0, st_k1; f32x4 sf0, sf1, sf2, sf3; float st_c;
    f32x4 tq[16];
};
__device__ __forceinline__ int swa_jlo(int P0, int W) { const int lowk = P0 - W + 1; return lowk > 0 ? lowk / KVBLK : 0; }
#define ROW(p, k0, rr) ((p) + (size_t)((k0) + (rr)) * LDQ + sc)
#define VMW() asm volatile("s_waitcnt vmcnt(0)" ::: "memory")
#define VMWN(n) asm volatile("s_waitcnt vmcnt(%0)" :: "i"(n) : "memory")
#define SLOAD_H(Kp, Vp, Cp, k0) do { S.st_v0 = load8<TIn>(ROW(Vp, k0, sr)); S.st_v1 = load8<TIn>(ROW(Vp, k0, 32 + sr));              \
                         S.st_k0 = load8<TIn>(ROW(Kp, k0, sr)); S.st_k1 = load8<TIn>(ROW(Kp, k0, 32 + sr)); if (tid < 64) S.st_c = (Cp)[(k0) + tid]; } while (0)
#define SWRITE_HK(bf) do { *(bf16x8*)(K_lds + (bf) * SHM_K + kws) = S.st_k0; *(bf16x8*)(K_lds + (bf) * SHM_K + kws + 32 * 256) = S.st_k1; if (tid < 64) ((float*)(lds + CB_OFF))[(bf) * 64 + tid] = S.st_c; } while (0)
#define SWRITE_HV(bf) do { *(bf16x8*)(V_lds + (bf) * SHM_V + vst0) = S.st_v0; *(bf16x8*)(V_lds + (bf) * SHM_V + vst1) = S.st_v1; } while (0)
#define SWRITE_H(bf) do { SWRITE_HV(bf); SWRITE_HK(bf); } while (0)
#define SLOAD_F(p, k0) do { S.sf0 = *(const f32x4*)ROW(p, k0, sr); S.sf1 = *(const f32x4*)(ROW(p, k0, sr) + 4);                \
                            S.sf2 = *(const f32x4*)ROW(p, k0, 32 + sr); S.sf3 = *(const f32x4*)(ROW(p, k0, 32 + sr) + 4); } while (0)
#define SWRITE_KF(bf) do { *(bf16x8*)(K_lds + (bf) * SHM_K + kws) = pack8(S.sf0, S.sf1); *(bf16x8*)(K_lds + (bf) * SHM_K + kws + 32 * 256) = pack8(S.sf2, S.sf3); } while (0)
#define SWRITE_VF(bf) do { *(bf16x8*)(V_lds + (bf) * SHM_V + vst0) = pack8(S.sf0, S.sf1); *(bf16x8*)(V_lds + (bf) * SHM_V + vst1) = pack8(S.sf2, S.sf3); } while (0)
template <class TIn, class TOut>
__device__ __forceinline__ void causal_swa_prime(const BlockRef<TIn, TOut>& cur, int W, char* lds, Seam<TIn>& S) {
    constexpr bool F32 = same_t<TIn, float>::v;
    const int tid = otid(), wid = __builtin_amdgcn_readfirstlane(tid >> 6), lane = tid & 63, r32 = lane & 31, hi = lane >> 5;
    const int sr = tid >> 4, sc = (tid & 15) * 8, kws = KSWZ(sr, sc * 2); char* K_lds = lds + 2 * SHM_V;
    const int kb0 = swa_jlo(cur.P0, W) * KVBLK;
    for (int d0 = 0; d0 < 8; ++d0) S.qr[d0] = load8<TIn>(cur.Q + (size_t)(wid * QBLK + r32) * LDQ + d0 * 16 + hi * 8);
    if constexpr (F32) { SLOAD_F((const float*)cur.K, kb0); VMW(); SWRITE_KF(0); SBAR(); SLOAD_F((const float*)cur.V, kb0); }
    else { SLOAD_H(cur.K, cur.V, cur.C, kb0); VMW(); SWRITE_HK(0); }
    __syncthreads();
}
template <class TIn, class TOut, class RF>
__device__ __forceinline__ void causal_swa_block(int it_cur, int it_nxt, const RF& rf, int skv, int W, char* lds, Seam<TIn>& S) {
    const BlockRef<TIn, TOut> cur = rf(it_cur);
    constexpr bool F32 = same_t<TIn, float>::v;
    const int tid = otid(), wid = __builtin_amdgcn_readfirstlane(tid >> 6), lane = tid & 63, r32 = lane & 31, hi = lane >> 5;
    const int j_lo = swa_jlo(cur.P0, W);
    int j_hi = (cur.P0 + QB - 1) / KVBLK + 1; if (j_hi > skv / KVBLK) j_hi = skv / KVBLK;
    const int NT = j_hi - j_lo;
    const int kbn = 0;
    const int qlo = cur.P0 + wid * QBLK, qm = qlo + r32 - 4 * hi;
    char* V_lds = lds; char* K_lds = lds + 2 * SHM_V;
    float* ws = (float*)(lds + 2 * SHM_V + 2 * SHM_K) + wid * 64; float* li_l = ws, * al_l = ws + 32;
    float m_reg = -1e30f, l_reg = 0; f32x16 o[4] = {};
    const int sr = tid >> 4, sc = (tid & 15) * 8, vst0 = v_st(sr, sc), vst1 = v_st(32 + sr, sc), kws = KSWZ(sr, sc * 2);
    const int vb0 = (int)(uintptr_t)V_lds + v_rd_base(lane);
    const TIn* Kh = cur.K; const TIn* Vh = cur.V; const float* Ch = cur.C;
#define RESC(a) do { if (__any((a) < 1.f)) { if (hi == 0) al_l[r32] = (a); asm volatile("s_waitcnt lgkmcnt(0)" ::: "memory");              \
                     for (int d_ = 0; d_ < 4; ++d_) for (int r = 0; r < 16; ++r) o[d_][r] *= al_l[crow(r, hi)]; } } while (0)
#define KBASE(t) ((j_lo + (t)) * KVBLK)
#define ACT(t) (KBASE(t) <= qlo + QBLK - 1 && KBASE(t) + KVBLK - 1 >= qlo - W + 1)
#define MASKT(P0_, P1_, t) do { const int kb_ = KBASE(t); if ((!SK || ACT(t)) && (kb_ + KVBLK - 1 > qlo || kb_ <= qlo + QBLK - 1 - W)) mask_tile(P0_, P1_, qm - kb_, (unsigned)W); } while (0)
    constexpr int NQL = F32 ? 16 : 8;
    constexpr bool SK = WSKIP && !F32;
#define SEAM_K0() do { VMWN(NQL); if constexpr (F32) { SWRITE_KF(0); SBAR(); SLOAD_F((const float*)nxt.V, kbn); } else { SWRITE_HK(0); } SBAR(); } while (0)
    f32x16 pA0, pA1, pB0, pB1; float mnA, mnB, alA, alB; bf16x8 pa0, pa1, pa2, pa3;
    if constexpr (F32) { VMW(); SWRITE_VF(0); SBAR(); } else { SWRITE_HV(0); SBAR(); }
    if (NT > 1) { if constexpr (F32) SLOAD_F((const float*)Kh, KBASE(1)); else SLOAD_H(Kh, Vh, Ch, KBASE(1)); }
    SBAR(); qkt<0, SK>(pA0, pA1, K_lds, r32, hi, S.qr, ACT(0));
    if constexpr (F32) { if (NT > 1) { VMW(); SWRITE_KF(1); SBAR(); SLOAD_F((const float*)Vh, KBASE(1)); } }
    MASKT(pA0, pA1, 0); partialSM(pA0, pA1, m_reg, mnA, alA);
    if (NT > 1) { VMW(); if constexpr (F32) { SWRITE_VF(1); SBAR(); if (NT > 2) SLOAD_F((const float*)Kh, KBASE(2)); } else SWRITE_H(1); }
    __syncthreads();
#define HALF_STEP(PX0, PX1, mnX, alX, PY0, PY1, alY, t, KB, VB, SB) do {                                                      \
        SBAR(); qkt<KB, SK>(PX0, PX1, K_lds, r32, hi, S.qr, ACT(t));                                             \
        finishSM(PY0, PY1, alY, l_reg, pa0, pa1, pa2, pa3); SBAR();                                                           \
        if ((t) + 1 < NT) { if constexpr (F32) { VMW(); SWRITE_KF(SB); SBAR(); SLOAD_F((const float*)Vh, KBASE((t) + 1)); }  \
                            else { SLOAD_H(Kh, Vh, Ch, KBASE((t) + 1)); } SBAR(); }                                               \
        pv_tile<VB, SK>(o, vb0, pa0, pa1, pa2, pa3, ACT((t) - 1)); MASKT(PX0, PX1, (t)); partialSM(PX0, PX1, m_reg, mnX, alX);                                        \
        __syncthreads();                                                                                                      \
        if ((t) + 1 < NT) { VMW(); if constexpr (F32) { SWRITE_VF(SB); SBAR(); if ((t) + 2 < NT) SLOAD_F((const float*)Kh, KBASE((t) + 2)); } \
                            else { SWRITE_H(SB); } }                                                                          \
        RESC(alX); __syncthreads(); } while (0)
    for (int t = 1; t + 1 < NT; t += 2) {
        HALF_STEP(pB0, pB1, mnB, alB, pA0, pA1, alA, t, 1, 0, 0);
        HALF_STEP(pA0, pA1, mnA, alA, pB0, pB1, alB, t + 1, 0, 1, 1);
    }
    const bool even = (NT & 1) == 0;
    if (even) { SBAR(); qkt<1, SK>(pB0, pB1, K_lds, r32, hi, S.qr, ACT(NT - 1)); SBAR(); }
    int itn_ = it_nxt; asm volatile("; late nxt" : "+s"(itn_)); const BlockRef<TIn, TOut> nxt = rf(itn_);
#define QROW(e) (nxt.Q + (size_t)(wid * QBLK + r32) * LDQ + ((e) >> 1) * 16 + hi * 8 + ((e) & 1) * 4)
    if constexpr (F32) { SLOAD_F((const float*)nxt.K, kbn); SBAR();
#pragma unroll
        for (int e = 0; e < 8; ++e) S.tq[e] = *(const f32x4*)QROW(e); }
    else { SLOAD_H(nxt.K, nxt.V, nxt.C, kbn); SBAR();
#pragma unroll
        for (int d0 = 0; d0 < 8; ++d0) S.qr[d0] = load8<TIn>(nxt.Q + (size_t)(wid * QBLK + r32) * LDQ + d0 * 16 + hi * 8); }
    SBAR();
    finishSM(pA0, pA1, alA, l_reg, pa0, pa1, pa2, pa3); SBAR();
    if constexpr (F32) {
#pragma unroll
        for (int e = 8; e < 16; ++e) S.tq[e] = *(const f32x4*)QROW(e); SBAR(); }
#undef QROW
    pv_tile<0, SK>(o, vb0, pa0, pa1, pa2, pa3, ACT(even ? NT - 2 : NT - 1));
    if (even) { MASKT(pB0, pB1, NT - 1); partialSM(pB0, pB1, m_reg, mnB, alB); __syncthreads(); RESC(alB);
        finishSM(pB0, pB1, alB, l_reg, pa0, pa1, pa2, pa3); SBAR(); pv_tile<1, SK>(o, vb0, pa0, pa1, pa2, pa3, ACT(NT - 1)); }
    SBAR(); SEAM_K0();
    if (hi == 0) li_l[r32] = l_reg; asm volatile("s_waitcnt lgkmcnt(0)" ::: "memory");
    float rli[16];
#pragma unroll
    for (int r = 0; r < 16; ++r) rli[r] = __builtin_amdgcn_rcpf(li_l[crow(r, hi)]);
    int itc_ = it_cur; asm volatile("; late cur" : "+s"(itc_)); TOut* Ow = rf(itc_).O + (size_t)(wid * QBLK) * LDO;
#pragma unroll
    for (int r = 0; r < 16; ++r) { const int orow = crow(r, hi);
#pragma unroll
        for (int d0 = 0; d0 < 4; ++d0) { const float v = o[d0][r] * rli[r];
            if constexpr (same_t<TOut, float>::v) { Ow[(size_t)orow * LDO + d0 * 32 + r32] = v; }
            else { const float vn = __shfl_xor(v, 1);
                   if ((r32 & 1) == 0) *(unsigned*)(Ow + (size_t)orow * LDO + d0 * 32 + r32) = cvtpk(v, vn); } } }
    if constexpr (F32) {
#pragma unroll
        for (int d0 = 0; d0 < 8; ++d0) S.qr[d0] = pack8(S.tq[2 * d0], S.tq[2 * d0 + 1]); }
    __syncthreads();
#undef RESC
#undef KBASE
#undef ACT
#undef MASKT
#undef SEAM_K0
#undef HALF_STEP
}
#undef ROW
#undef VMW
#undef VMWN
#undef SLOAD_H
#undef SWRITE_HK
#undef SWRITE_HV
#undef SWRITE_H
#undef SLOAD_F
#undef SWRITE_KF
#undef SWRITE_VF
}
#define GAS __attribute__((address_space(1)))
#define LAS __attribute__((address_space(3)))
typedef unsigned short bf16_t;
typedef short bf16x8 __attribute__((ext_vector_type(8)));
typedef float f32x4 __attribute__((ext_vector_type(4)));
typedef float f32x2 __attribute__((ext_vector_type(2)));
typedef unsigned u32x4 __attribute__((ext_vector_type(4)));
typedef unsigned u32x2 __attribute__((ext_vector_type(2)));
typedef _Float16 h16x8 __attribute__((ext_vector_type(8)));
typedef GAS unsigned gu32;
typedef GAS unsigned long long gu64;
#define RLX_AGENT __ATOMIC_RELAXED, __HIP_MEMORY_SCOPE_AGENT

constexpr int NB = 4, SEQ = 8192, DM = 2048, DEPTH = 4, DFF = 8192;
constexpr int M = NB * SEQ;
constexpr int PIN = 7046, PINP = 7168;
constexpr int FOXH = 6, RWH = 10, RETH = 5;
constexpr int C_FQ = 0, C_FK = 768, C_FV = 1536, C_RW = 2304  , C_RR = 2304, C_RK = 2944, C_RV = 3584, C_WD = 4224, C_AD = 4288, C_GD = 4352,
              C_TQ = 4480, C_TK = 5120, C_TV = 5760, C_TG = 6400, C_FF = 7040;
constexpr int MIX_FOX = 0, MIX_RW = 768, MIX_RET = 1408;
constexpr float ALPHA = 1.681792830507429f;
constexpr float LN_EPS = 1e-5f, RWKV_GN_EPS = 64e-5f, RET_GN_EPS = 1e-5f;

constexpr size_t MiB = 1u << 20;
constexpr size_t WS_CTL = 0, CTL_BYTES = 1 * MiB;
constexpr size_t WS_CS = WS_CTL + CTL_BYTES;
constexpr size_t WS_FOXC = WS_CS + 4 * MiB;
constexpr size_t WS_BONUS = WS_FOXC + 1 * MiB;
constexpr size_t WS_WIN = WS_BONUS + 2 * MiB;
constexpr size_t WS_WOUT = WS_WIN + 28 * MiB;
constexpr size_t WS_WUP = WS_WOUT + 8 * MiB;
constexpr size_t WS_WDN = WS_WUP + 32 * MiB;
constexpr size_t WS_XB = WS_WDN + 32 * MiB;
constexpr size_t WS_YRAW = WS_XB + 128 * MiB;
constexpr size_t WS_H = WS_YRAW + 80 * MiB;
constexpr size_t WS_SCAN = WS_H + 448 * MiB;
constexpr size_t WS_HID = WS_H;
constexpr size_t WS_END = WS_SCAN + 240 * MiB;
static_assert(WS_HID + 512 * MiB <= WS_END, "hid overlay");

constexpr int CW_BAR = 0;
constexpr int CW_QATT = 4096;

constexpr int LDS_BYTES = 147456;
constexpr int MISC_OFF = LDS_BYTES - 256;
constexpr int NTHR = 512;

__device__ __forceinline__ float bf2f(bf16_t x) { return __uint_as_float(((unsigned)x) << 16); }
__device__ __forceinline__ unsigned f2bf(float f) { unsigned u = __float_as_uint(f); return (u + 0x7fffu + ((u >> 16) & 1u)) >> 16; }
__device__ __forceinline__ unsigned pk2(float lo, float hi) { return f2bf(lo) | (f2bf(hi) << 16); }
__device__ __forceinline__ float wave_sum(float v) {
#pragma unroll
    for (int o = 1; o < 64; o <<= 1) v += __shfl_xor(v, o);
    return v;
}
template <int CTRL> __device__ __forceinline__ float dpp_add(float x) {
    const int y = __builtin_amdgcn_update_dpp(0, __float_as_int(x), CTRL, 0xF, 0xF, true); return x + __int_as_float(y);
}
__device__ __forceinline__ float row16_sum(float x) {
    x = dpp_add<0xB1>(x); x = dpp_add<0x4E>(x); x = dpp_add<0x141>(x); x = dpp_add<0x140>(x); return x;
}

struct Params {
    const float* in[23]; float* out; unsigned char* ws; int ph_lo, ph_hi;
};
typedef const __attribute__((address_space(4))) Params* CP;

__device__ __forceinline__ int win_src(int n) { return n < C_RW ? n : (n < C_FF ? n + 6 : (n < C_FF + 6 ? n - C_FF + 2304 : -1)); }
template <bool MAPPED>
__device__ __forceinline__ void convert_tile(const float* W, int ldw, bf16_t* Wt, int K, int n0, int k0, LAS float* T) {
    const int tid = otid();
#pragma unroll
    for (int i = 0; i < 8; ++i) { const int idx = tid + NTHR * i, r = idx >> 6, c = idx & 63; const int n = n0 + c; const int sn = MAPPED ? win_src(n) : n;
        T[r * 65 + c] = sn >= 0 ? W[(size_t)(k0 + r) * ldw + sn] : 0.f; }
    __syncthreads();
    { const int n = tid >> 3, kq = tid & 7; float v[8];
#pragma unroll
      for (int j = 0; j < 8; ++j) v[j] = T[(kq * 8 + j) * 65 + n];
      u32x4 w; w.x = pk2(v[0], v[1]); w.y = pk2(v[2], v[3]); w.z = pk2(v[4], v[5]); w.w = pk2(v[6], v[7]);
      *(u32x4*)(Wt + (size_t)(n0 + n) * K + k0 + kq * 8) = w; }
    __syncthreads();
}
__device__ __forceinline__ void phase_convert(CP p, int layer, LAS unsigned char* lds) {
    LAS float* T = (LAS float*)lds;
    const float* w_in = p->in[1] + (size_t)layer * DM * PIN; const float* w_out = p->in[16] + (size_t)layer * DM * DM;
    const float* w_up = p->in[19] + (size_t)layer * DM * DFF; const float* w_dn = p->in[20] + (size_t)layer * DFF * DM;
    bf16_t* WinT = (bf16_t*)(p->ws + WS_WIN); bf16_t* WoutT = (bf16_t*)(p->ws + WS_WOUT); bf16_t* WupT = (bf16_t*)(p->ws + WS_WUP); bf16_t* WdnT = (bf16_t*)(p->ws + WS_WDN);
    constexpr int T_IN = (PINP / 64) * (DM / 64), T_OUT = (DM / 64) * (DM / 64), T_UP = (DFF / 64) * (DM / 64), T_DN = (DM / 64) * (DFF / 64);
    for (int t = blockIdx.x; t < T_IN + T_OUT + T_UP + T_DN; t += gridDim.x) {
        if (t < T_IN) { const int kt = t % (DM / 64), nt = t / (DM / 64); convert_tile<true>(w_in, PIN, WinT, DM, nt * 64, kt * 64, T); }
        else if (t < T_IN + T_OUT) { const int u = t - T_IN, kt = u % (DM / 64), nt = u / (DM / 64); convert_tile<false>(w_out, DM, WoutT, DM, nt * 64, kt * 64, T); }
        else if (t < T_IN + T_OUT + T_UP) { const int u = t - T_IN - T_OUT, kt = u % (DM / 64), nt = u / (DM / 64); convert_tile<false>(w_up, DFF, WupT, DM, nt * 64, kt * 64, T); }
        else { const int u = t - T_IN - T_OUT - T_UP, kt = u % (DFF / 64), nt = u / (DFF / 64); convert_tile<false>(w_dn, DM, WdnT, DFF, nt * 64, kt * 64, T); }
    }
}
__device__ __forceinline__ void phase_prologue(CP p) {
    const f32x4* x4 = (const f32x4*)p->in[0]; f32x4* o4 = (f32x4*)p->out; u32x2* xb = (u32x2*)(p->ws + WS_XB);
    const size_t n4 = (size_t)M * DM / 4, stride = (size_t)gridDim.x * NTHR;
    for (size_t i = (size_t)blockIdx.x * NTHR + otid(); i < n4; i += stride) { const f32x4 v = x4[i]; o4[i] = v; u32x2 w; w.x = pk2(v[0], v[1]); w.y = pk2(v[2], v[3]); xb[i] = w; }
    f32x2* cs = (f32x2*)(p->ws + WS_CS);
    for (size_t i = (size_t)blockIdx.x * NTHR + otid(); i < (size_t)SEQ * 64; i += stride) {
        const int pos = (int)(i >> 6), j = (int)(i & 63);
        const float pw = (float)pow(10000.0, (double)((float)j / 64.0f)); const float inv = 1.0f / pw; const float ang = (float)pos * inv;
        cs[i] = (f32x2){(float)cos((double)ang), (float)sin((double)ang)};
    }
}

__device__ __forceinline__ void phase_ln(CP p, const float* g, const float* b) {
    const int lane = otid() & 63, wv = otid() >> 6; float* xf = p->out; bf16_t* xb = (bf16_t*)(p->ws + WS_XB);
    f32x4 gg[8], bb[8];
#pragma unroll
    for (int i = 0; i < 8; ++i) { gg[i] = *(const f32x4*)(g + i * 256 + lane * 4); bb[i] = *(const f32x4*)(b + i * 256 + lane * 4); }
    for (int row = blockIdx.x * 8 + wv; row < M; row += gridDim.x * 8) {
        float* xr = xf + (size_t)row * DM; f32x4 v[8]; float s = 0.f;
#pragma unroll
        for (int i = 0; i < 8; ++i) { v[i] = *(const f32x4*)(xr + i * 256 + lane * 4); s += (v[i][0] + v[i][1]) + (v[i][2] + v[i][3]); }
        const float mean = wave_sum(s) * (1.0f / DM); float q = 0.f;
#pragma unroll
        for (int i = 0; i < 8; ++i) { const f32x4 d = v[i] - mean; q += (d[0] * d[0] + d[1] * d[1]) + (d[2] * d[2] + d[3] * d[3]); }
        const float rstd = 1.0f / sqrtf(wave_sum(q) * (1.0f / DM) + LN_EPS);
#pragma unroll
        for (int i = 0; i < 8; ++i) { const f32x4 o = (v[i] - mean) * rstd * gg[i] + bb[i]; *(f32x4*)(xr + i * 256 + lane * 4) = o;
            u32x2 w; w.x = pk2(o[0], o[1]); w.y = pk2(o[2], o[3]); *(u32x2*)(xb + (size_t)row * DM + i * 256 + lane * 4) = w; }
    }
}

__device__ __forceinline__ float log_sigmoid(float x) { return fminf(x, 0.f) - log1pf(expf(-fabsf(x))); }
__device__ __forceinline__ void fox_scan_unit(CP p, int layer, int bh, LAS unsigned char* lds) {
    const int tid = otid(), lane = tid & 63, wv = tid >> 6, b = bh / FOXH, hh = bh % FOXH;
    const bf16_t* H = (const bf16_t*)(p->ws + WS_H); float* C = (float*)(p->ws + WS_FOXC) + (size_t)bh * SEQ; LAS float* wsum = (LAS float*)lds;
    const float fb = p->in[2][layer * FOXH + hh];
    float v[16]; float run = 0.f;
#pragma unroll
    for (int i = 0; i < 16; ++i) { const int s = tid * 16 + i; run += log_sigmoid(bf2f(H[((size_t)b * SEQ + s) * PINP + C_FF + hh]) + fb); v[i] = run; }
    float inc = run;
#pragma unroll
    for (int o = 1; o < 64; o <<= 1) { const float t = __shfl_up(inc, o); if (lane >= o) inc += t; }
    if (lane == 63) wsum[wv] = inc;
    __syncthreads();
    float base = inc - run;
    for (int w = 0; w < wv; ++w) base += wsum[w];
    __syncthreads();
#pragma unroll
    for (int i = 0; i < 16; ++i) C[tid * 16 + i] = -(base + v[i]) * (1.0f / fox::SCALE);
}
__device__ __forceinline__ float tshift(float cur, float prev, float mu) { return cur + (prev - cur) * mu; }
__device__ __forceinline__ void rwkv_pre_unit(CP p, int layer, int unit, LAS unsigned char* lds) {
    const int tid = otid(), lane = tid & 63, wv = tid >> 6;
    const int tile = unit % (SEQ / 64), hd = (unit / (SEQ / 64)) % RWH, b = unit / ((SEQ / 64) * RWH);
    const bf16_t* H = (const bf16_t*)(p->ws + WS_H); LAS float* TA = (LAS float*)lds;
    const float* mu = p->in[3] + (size_t)layer * 2176;
    const int s0 = tile * 64;
    { const int tt = tid >> 3, j0 = (tid & 7) * 16, s = s0 + tt; const size_t row = (size_t)b * SEQ + s;
      const bf16_t* hc = H + row * PINP + C_WD + j0; const bf16_t* hp = hc - PINP;
      bf16x8 c0 = *(const bf16x8*)hc, c1 = *(const bf16x8*)(hc + 8), p0 = {}, p1 = {};
      if (s > 0) { p0 = *(const bf16x8*)hp; p1 = *(const bf16x8*)(hp + 8); }
#pragma unroll
      for (int i = 0; i < 16; ++i) { const float cu = bf2f((bf16_t)(i < 8 ? c0[i] : c1[i - 8])), pr = bf2f((bf16_t)(i < 8 ? p0[i] : p1[i - 8]));
          const float x = tshift(cu, pr, mu[1920 + j0 + i]); const int j = j0 + i; TA[tt * 128 + j] = j < 64 ? tanhf(x) : x; } }
    __syncthreads();
    const int c = hd * 64 + lane;
    float wup[64], aup[64];
    { const float* wu = p->in[5] + (size_t)layer * 64 * 640 + c; const float* au = p->in[7] + (size_t)layer * 64 * 640 + c;
#pragma unroll
      for (int j = 0; j < 64; ++j) { wup[j] = wu[j * 640]; aup[j] = au[j * 640]; } }
    const float w0 = p->in[4][layer * 640 + c], a0 = p->in[6][layer * 640 + c], kkc = p->in[9][layer * 640 + c], kac = p->in[10][layer * 640 + c], rkc = p->in[11][layer * 640 + c];
    const float mur = mu[c], muk = mu[640 + c], muv = mu[1280 + c];
    _Float16* SC = (_Float16*)(p->ws + WS_SCAN); float* BON = (float*)(p->ws + WS_BONUS);
    for (int i = 0; i < 8; ++i) {
        const int tt = wv * 8 + i, s = s0 + tt; const size_t row = (size_t)b * SEQ + s; const bf16_t* hr = H + row * PINP;
        const float rc = bf2f(hr[C_RR + c]), kc = bf2f(hr[C_RK + c]), vc = bf2f(hr[C_RV + c]);
        float rp = 0.f, kp = 0.f, vp = 0.f; if (s > 0) { rp = bf2f(hr[C_RR + c - PINP]); kp = bf2f(hr[C_RK + c - PINP]); vp = bf2f(hr[C_RV + c - PINP]); }
        const float r = tshift(rc, rp, mur), k = tshift(kc, kp, muk), v = tshift(vc, vp, muv);
        float wl = w0, al = a0;
#pragma unroll
        for (int j = 0; j < 64; j += 4) { const f32x4 tw = *(const LAS f32x4*)(TA + tt * 128 + j), ta = *(const LAS f32x4*)(TA + tt * 128 + 64 + j);
            wl += tw[0] * wup[j] + tw[1] * wup[j + 1] + tw[2] * wup[j + 2] + tw[3] * wup[j + 3]; al += ta[0] * aup[j] + ta[1] * aup[j + 1] + ta[2] * aup[j + 2] + ta[3] * aup[j + 3]; }
        const float nx = -wl; const float sp = fmaxf(nx, 0.f) + log1pf(expf(-fabsf(nx)));
        const float w = -sp - 0.5f; const float w1m = 1.0f - expf(-expf(w));
        const float a = 1.0f / (1.0f + expf(-al));
        const float kk = k * kkc; const float nrm = sqrtf(wave_sum(kk * kk)); const float kkn = kk / fmaxf(nrm, 1e-12f);
        const float k2 = k * (1.0f + (a - 1.0f) * kac);
        const float bon = wave_sum(r * k2 * rkc);
        _Float16* rec = SC + (((size_t)(b * RWH + hd) * SEQ + s) * 6) * 64 + lane;
        rec[0] = (_Float16)r; rec[64] = (_Float16)w1m; rec[128] = (_Float16)k2; rec[192] = (_Float16)(-kkn); rec[256] = (_Float16)(kkn * a); rec[320] = (_Float16)v;
        if (lane == 0) BON[row * 16 + hd] = bon;
    }
    __syncthreads();
}
__device__ __forceinline__ void phase_pre(CP p, int layer, LAS unsigned char* lds) {
    constexpr int NFOX = NB * FOXH, NPRE = NB * RWH * (SEQ / 64);
    for (int u = blockIdx.x; u < NFOX + NPRE; u += gridDim.x) { if (u < NFOX) fox_scan_unit(p, layer, u, lds); else rwkv_pre_unit(p, layer, u - NFOX, lds); }
}

__device__ __forceinline__ void rwkv_post_unit(CP p, int layer, int unit, LAS unsigned char* lds) {
    const int tid = otid(), lane = tid & 63, wv = tid >> 6;
    const int tile = unit % (SEQ / 64), hd = (unit / (SEQ / 64)) % RWH, b = unit / ((SEQ / 64) * RWH);
    const bf16_t* H = (const bf16_t*)(p->ws + WS_H); LAS float* SG = (LAS float*)lds;
    const float* mu = p->in[3] + (size_t)layer * 2176;
    const int s0 = tile * 64;
    { const int tt = tid >> 3, j0 = (tid & 7) * 16, s = s0 + tt; const size_t row = (size_t)b * SEQ + s;
      const bf16_t* hc = H + row * PINP + C_GD + j0; const bf16_t* hp = hc - PINP;
      bf16x8 c0 = *(const bf16x8*)hc, c1 = *(const bf16x8*)(hc + 8), p0 = {}, p1 = {};
      if (s > 0) { p0 = *(const bf16x8*)hp; p1 = *(const bf16x8*)(hp + 8); }
#pragma unroll
      for (int i = 0; i < 16; ++i) { const float cu = bf2f((bf16_t)(i < 8 ? c0[i] : c1[i - 8])), pr = bf2f((bf16_t)(i < 8 ? p0[i] : p1[i - 8]));
          const float x = tshift(cu, pr, mu[2048 + j0 + i]); SG[tt * 128 + j0 + i] = 1.0f / (1.0f + expf(-x)); } }
    __syncthreads();
    const int c = hd * 64 + lane;
    float gup[128];
    { const float* gu = p->in[8] + (size_t)layer * 128 * 640 + c;
#pragma unroll
      for (int j = 0; j < 128; ++j) gup[j] = gu[j * 640]; }
    const float gw = p->in[12][layer * 640 + c], gb = p->in[13][layer * 640 + c];
    const _Float16* SC = (const _Float16*)(p->ws + WS_SCAN); const float* BON = (const float*)(p->ws + WS_BONUS); const float* Y = (const float*)(p->ws + WS_YRAW);
    bf16_t* MIX = (bf16_t*)(p->ws + WS_XB);
    for (int i = 0; i < 8; ++i) {
        const int tt = wv * 8 + i, s = s0 + tt; const size_t row = (size_t)b * SEQ + s;
        const float y = Y[row * 640 + c]; const float mean = wave_sum(y) * (1.0f / 64.0f); const float d = y - mean; const float var = wave_sum(d * d) * (1.0f / 64.0f);
        float yn = d * (1.0f / sqrtf(var + RWKV_GN_EPS)) * gw + gb;
        const float v = (float)SC[(((size_t)(b * RWH + hd) * SEQ + s) * 6 + 5) * 64 + lane];
        yn += BON[row * 16 + hd] * v;
        float g = 0.f;
#pragma unroll
        for (int j = 0; j < 128; j += 4) { const f32x4 sg = *(const LAS f32x4*)(SG + tt * 128 + j); g += sg[0] * gup[j] + sg[1] * gup[j + 1] + sg[2] * gup[j + 2] + sg[3] * gup[j + 3]; }
        MIX[row * DM + MIX_RW + c] = (bf16_t)f2bf(yn * g);
    }
    __syncthreads();
}
__device__ __forceinline__ void phase_post(CP p, int layer, LAS unsigned char* lds) {
    constexpr int NPOST = NB * RWH * (SEQ / 64);
    for (int u = blockIdx.x; u < NPOST; u += gridDim.x) rwkv_post_unit(p, layer, u, lds);
}

__device__ __forceinline__ void rwkv_scan_unit(CP p, int unit, LAS unsigned char* lds) {
    const int tid = otid(), lane = tid & 63, wv = tid >> 6, bh = unit >> 1, half = unit & 1, b = bh / RWH, hd = bh % RWH;
    LAS float* OP = (LAS float*)lds;
    LAS float* VV = (LAS float*)(lds + 81920);
    LAS float* YB = (LAS float*)(lds + 81920 + 8192);
    const h16x8* src = (const h16x8*)(p->ws + WS_SCAN) + (size_t)bh * SEQ * 48;
    float* Y = (float*)(p->ws + WS_YRAW);
    const int rowl = wv * 4 + (lane >> 4), ks = (lane & 15) * 4;
    float S0 = 0.f, S1 = 0.f, S2 = 0.f, S3 = 0.f;
    h16x8 st[6];
#pragma unroll
    for (int j = 0; j < 6; ++j) st[j] = src[tid + NTHR * j];
    for (int blk = 0; blk < SEQ / 64; ++blk) {
#pragma unroll
        for (int j = 0; j < 6; ++j) { const int idx = tid + NTHR * j, tok = idx / 48, wi = idx % 48, op = wi >> 3, c0 = (wi & 7) * 8; float f[8];
#pragma unroll
            for (int e = 0; e < 8; ++e) f[e] = (float)st[j][e];
            if (op == 1) {
#pragma unroll
                for (int e = 0; e < 8; ++e) f[e] = 1.0f - f[e]; }
            if (op < 5) { LAS float* d = OP + (tok * 5 + op) * 64 + c0; *(LAS f32x4*)d = (f32x4){f[0], f[1], f[2], f[3]}; *(LAS f32x4*)(d + 4) = (f32x4){f[4], f[5], f[6], f[7]}; }
            else if ((c0 >> 5) == half) { LAS float* d = VV + tok * 32 + (c0 & 31); *(LAS f32x4*)d = (f32x4){f[0], f[1], f[2], f[3]}; *(LAS f32x4*)(d + 4) = (f32x4){f[4], f[5], f[6], f[7]}; } }
        __syncthreads();
        if (blk + 1 < SEQ / 64) {
#pragma unroll
            for (int j = 0; j < 6; ++j) st[j] = src[(size_t)(blk + 1) * 64 * 48 + tid + NTHR * j]; }
#pragma unroll 4
        for (int t = 0; t < 64; ++t) {
            const LAS float* o = OP + t * 320 + ks;
            const f32x4 r4 = *(const LAS f32x4*)(o), w4 = *(const LAS f32x4*)(o + 64), k4 = *(const LAS f32x4*)(o + 128), a4 = *(const LAS f32x4*)(o + 192), b4 = *(const LAS f32x4*)(o + 256);
            const float vv = VV[t * 32 + rowl];
            float sa = (S0 * a4[0] + S1 * a4[1]) + (S2 * a4[2] + S3 * a4[3]);
            sa = row16_sum(sa);
            S0 = S0 * w4[0] + (sa * b4[0] + vv * k4[0]); S1 = S1 * w4[1] + (sa * b4[1] + vv * k4[1]);
            S2 = S2 * w4[2] + (sa * b4[2] + vv * k4[2]); S3 = S3 * w4[3] + (sa * b4[3] + vv * k4[3]);
            float y = (S0 * r4[0] + S1 * r4[1]) + (S2 * r4[2] + S3 * r4[3]);
            y = row16_sum(y);
            if ((lane & 15) == 0) YB[t * 32 + rowl] = y;
        }
        __syncthreads();
        { const int tt = tid >> 3, r0 = (tid & 7) * 4; const f32x4 yv = *(const LAS f32x4*)(YB + tt * 32 + r0);
          *(f32x4*)(Y + ((size_t)b * SEQ + blk * 64 + tt) * 640 + hd * 64 + half * 32 + r0) = yv; }
    }
    __syncthreads();
}

__device__ __forceinline__ void ret_simple_unit(CP p, int layer, int unit, LAS unsigned char* lds) {
    const int tid = otid(), b = unit / RETH, hh = unit % RETH, e = tid & 127, dq = tid >> 7;
    LAS float* QS = (LAS float*)lds; LAS float* KS = QS + 16 * 128; LAS float* VS = KS + 16 * 128; LAS float* OPS = VS + 16 * 128;
    const bf16_t* H = (const bf16_t*)(p->ws + WS_H); const f32x2* CS = (const f32x2*)(p->ws + WS_CS); bf16_t* MIX = (bf16_t*)(p->ws + WS_XB);
    const float gamma = 1.0f - exp2f(-5.0f - (float)hh);
    float R[32];
#pragma unroll
    for (int i = 0; i < 32; ++i) R[i] = 0.f;
    const float* gnw = p->in[14] + layer * 640 + hh * 128; const float* gnb = p->in[15] + layer * 640 + hh * 128;
    for (int s0 = 0; s0 < SEQ; s0 += 16) {
        { const int tt = tid >> 5, f0 = (tid & 31) * 2, s = s0 + tt; const bf16_t* hr = H + ((size_t)b * SEQ + s) * PINP;
#pragma unroll
          for (int j = 0; j < 2; ++j) { const int f = f0 + j; const f32x2 cs = CS[(size_t)s * 64 + f];
              const float q1 = bf2f(hr[C_TQ + hh * 128 + f]), q2 = bf2f(hr[C_TQ + hh * 128 + 64 + f]), k1 = bf2f(hr[C_TK + hh * 128 + f]), k2 = bf2f(hr[C_TK + hh * 128 + 64 + f]);
              QS[tt * 128 + f] = q1 * cs.x - q2 * cs.y; QS[tt * 128 + 64 + f] = q1 * cs.y + q2 * cs.x;
              KS[tt * 128 + f] = (k1 * cs.x - k2 * cs.y) * 0.08838834764831845f; KS[tt * 128 + 64 + f] = (k1 * cs.y + k2 * cs.x) * 0.08838834764831845f; }
          const int e0 = (tid & 31) * 4;
#pragma unroll
          for (int j = 0; j < 4; ++j) VS[tt * 128 + e0 + j] = bf2f(hr[C_TV + hh * 128 + e0 + j]); }
        __syncthreads();
        for (int t = 0; t < 16; ++t) {
            const float ve = VS[t * 128 + e]; float op = 0.f;
#pragma unroll
            for (int i = 0; i < 32; i += 4) { const f32x4 k4 = *(const LAS f32x4*)(KS + t * 128 + dq * 32 + i), q4 = *(const LAS f32x4*)(QS + t * 128 + dq * 32 + i);
#pragma unroll
                for (int j = 0; j < 4; ++j) { R[i + j] = R[i + j] * gamma + k4[j] * ve; op += q4[j] * R[i + j]; } }
            OPS[(t * 4 + dq) * 128 + e] = op;
        }
        __syncthreads();
        { const int tt = tid >> 5, e0 = (tid & 31) * 4, s = s0 + tt; const size_t row = (size_t)b * SEQ + s;
          f32x4 o = *(const LAS f32x4*)(OPS + (tt * 4 + 0) * 128 + e0) + *(const LAS f32x4*)(OPS + (tt * 4 + 1) * 128 + e0) + *(const LAS f32x4*)(OPS + (tt * 4 + 2) * 128 + e0) + *(const LAS f32x4*)(OPS + (tt * 4 + 3) * 128 + e0);
          float sm = (o[0] + o[1]) + (o[2] + o[3]);
#pragma unroll
          for (int x = 1; x < 32; x <<= 1) sm += __shfl_xor(sm, x);
          const float mean = sm * (1.0f / 128.0f); const f32x4 d = o - mean; float q = (d[0] * d[0] + d[1] * d[1]) + (d[2] * d[2] + d[3] * d[3]);
#pragma unroll
          for (int x = 1; x < 32; x <<= 1) q += __shfl_xor(q, x);
          const float rstd = 1.0f / sqrtf(q * (1.0f / 128.0f) + RET_GN_EPS);
          float r4[4];
#pragma unroll
          for (int j = 0; j < 4; ++j) { const float g = bf2f(H[row * PINP + C_TG + hh * 128 + e0 + j]); const float sil = g / (1.0f + expf(-g));
              r4[j] = (d[j] * rstd * gnw[e0 + j] + gnb[e0 + j]) * sil; }
          u32x2 w; w.x = pk2(r4[0], r4[1]); w.y = pk2(r4[2], r4[3]); *(u32x2*)(MIX + row * DM + MIX_RET + hh * 128 + e0) = w; }
        __syncthreads();
    }
}
#define XB_TMO      128
#define XB_XCNT(j)  (256  + 64 * (j))
#define XB_XSUB(j)  (1280 + 64 * (j))
#define XB_XGEN(j)  (2304 + 64 * (j))
#define XB_TOP      3328
#define XB_TOPGEN   3392
#define XCD_BAR_WORDS 3456
#define XB_SPIN_CAP (1u << 18)

__device__ __forceinline__ unsigned xb_ld(unsigned* p)              { return __hip_atomic_load(p, __ATOMIC_RELAXED, __HIP_MEMORY_SCOPE_AGENT); }
__device__ __forceinline__ unsigned xb_add(unsigned* p, unsigned v) { return __hip_atomic_fetch_add(p, v, __ATOMIC_RELAXED, __HIP_MEMORY_SCOPE_AGENT); }
__device__ __forceinline__ unsigned xb_xcc_id() { return (unsigned)__builtin_amdgcn_s_getreg((3 << 11) | 20) & 0xFu; }
#define XB_SPIN(cond, bar) do { unsigned _sp = 0; while (cond) { __builtin_amdgcn_s_sleep(1); \
    if ((++_sp & 255u) == 0u) { if (xb_ld(&(bar)[XB_TMO])) break; if (_sp > XB_SPIN_CAP) { atomicAdd(&(bar)[XB_TMO], 1u); break; } } } } while (0)

struct XcdBarrier {
    unsigned* bar; unsigned x;
    volatile LAS unsigned* st;
};

__device__ __forceinline__ XcdBarrier xcd_barrier_post(unsigned* bar, volatile LAS unsigned* st) {
    XcdBarrier b; b.bar = bar; b.x = xb_xcc_id(); b.st = st;
    if (threadIdx.x == 0) (void)xb_add(&bar[XB_XCNT(b.x)], 1u);
    return b;
}
__device__ __forceinline__ void xcd_barrier_complete(unsigned* bar, unsigned x, unsigned& nloc, unsigned& nx) {
    const unsigned G = gridDim.x * gridDim.y * gridDim.z;
    unsigned sum, cnt, mine, sp = 0u;
    for (;;) {
        sum = 0u; cnt = 0u; mine = 0u;
#pragma unroll
        for (unsigned j = 0; j < 16; ++j) { const unsigned c = xb_ld(&bar[XB_XCNT(j)]); sum += c; cnt += (c > 0u) ? 1u : 0u; mine = (j == x) ? c : mine; }
        if (sum == G) break;
        __builtin_amdgcn_s_sleep(1);
        if ((++sp & 255u) == 0u) { if (xb_ld(&bar[XB_TMO])) break; if (sp > XB_SPIN_CAP) { atomicAdd(&bar[XB_TMO], 1u); break; } }
    }
    nloc = mine > 0u ? mine : 1u; nx = cnt > 0u ? cnt : 1u;
}

__device__ __forceinline__ void xcd_barrier(const XcdBarrier& b) {
    asm volatile("s_waitcnt vmcnt(0)" ::: "memory");
    __syncthreads();
    if (threadIdx.x == 0) {
        unsigned* bar = b.bar;
        __builtin_amdgcn_s_waitcnt(0);
        unsigned nloc = b.st[0], nx = b.st[1];
        if (nloc == 0u) { xcd_barrier_complete(bar, b.x, nloc, nx); b.st[0] = nloc; b.st[1] = nx; }
        const unsigned old = xb_add(&bar[XB_XSUB(b.x)], 1u);
        const unsigned gen = old / nloc;
        if (old + 1u == (gen + 1u) * nloc) {
            __builtin_amdgcn_fence(__ATOMIC_RELEASE, "agent");
            asm volatile("s_waitcnt vmcnt(0)" ::: "memory");
            const unsigned og = xb_add(&bar[XB_TOP], 1u);
            const unsigned tg = og / nx;
            if (og + 1u == (tg + 1u) * nx) xb_add(&bar[XB_TOPGEN], 1u);
            else XB_SPIN(xb_ld(&bar[XB_TOPGEN]) == tg, bar);
            __builtin_amdgcn_fence(__ATOMIC_ACQUIRE, "agent");
            xb_add(&bar[XB_XGEN(b.x)], 1u);
            asm volatile("s_waitcnt vmcnt(0)" ::: "memory");
        } else {
            XB_SPIN(xb_ld(&bar[XB_XGEN(b.x)]) == gen, bar);
            __builtin_amdgcn_fence(__ATOMIC_ACQUIRE, "agent");
            asm volatile("s_waitcnt vmcnt(0)" ::: "memory");
        }
    }
    __syncthreads();
}
constexpr int N_SCAN_UNITS = NB * RWH * 2, N_RET_UNITS = NB * RETH, N_ATT_ITEMS = NB * FOXH * (SEQ / 256);
typedef fox::BlockRef<fox::bf16, fox::bf16> FoxRef;
__device__ __forceinline__ FoxRef fox_ref(const unsigned char* ws, int it) {
    const int qb = (SEQ / 256 - 1) - it / (NB * FOXH), bh = it % (NB * FOXH), b = bh / FOXH, hh = bh % FOXH;
    const fox::bf16* H = (const fox::bf16*)(ws + WS_H); FoxRef r;
    r.Q = H + ((size_t)b * SEQ + (size_t)qb * 256) * PINP + C_FQ + hh * 128;
    r.K = H + (size_t)b * SEQ * PINP + C_FK + hh * 128; r.V = H + (size_t)b * SEQ * PINP + C_FV + hh * 128;
    r.O = (fox::bf16*)(ws + WS_XB) + ((size_t)b * SEQ + (size_t)qb * 256) * DM + MIX_FOX + hh * 128;
    r.C = (const float*)(ws + WS_FOXC) + (size_t)bh * SEQ; r.P0 = qb * 256;
    return r;
}
__device__ __forceinline__ int att_fetch(unsigned* head, volatile LAS unsigned* slot) {
    if (threadIdx.x == 0) *slot = __hip_atomic_fetch_add(head, 1u, __ATOMIC_RELAXED, __HIP_MEMORY_SCOPE_AGENT);
    __syncthreads();
    return __builtin_amdgcn_readfirstlane((int)*slot);
}
__device__ __forceinline__ void phase_mix(CP p, int layer, unsigned char* lds_g, LAS unsigned char* lds) {
    for (int u = blockIdx.x; u < N_SCAN_UNITS + N_RET_UNITS; u += gridDim.x) {
#ifndef NO_SCAN
        if (u < N_SCAN_UNITS) rwkv_scan_unit(p, u, lds);
#endif
#ifndef NO_RET
        if (u >= N_SCAN_UNITS) ret_simple_unit(p, layer, u - N_SCAN_UNITS, lds);
#endif
    }
    __syncthreads();
    unsigned* head = (unsigned*)(p->ws + WS_CTL) + CW_QATT + 64 * layer;
    volatile LAS unsigned* slot = (volatile LAS unsigned*)(lds + MISC_OFF + 64);
#ifdef NO_ATT
    int it = N_ATT_ITEMS;
#else
    int it = att_fetch(head, slot);
#endif
    if (it < N_ATT_ITEMS) {
        struct RF { CP p; __device__ __forceinline__ FoxRef operator()(int i) const { return fox_ref(p->ws, i); } } rf{p};
        fox::Seam<fox::bf16> S;
        { const FoxRef cur = rf(it); fox::causal_swa_prime<fox::bf16, fox::bf16>(cur, 1 << 30, (char*)lds_g, S); }
        for (;;) {
            const int itn = att_fetch(head, slot); const bool last = itn >= N_ATT_ITEMS;
            fox::causal_swa_block<fox::bf16, fox::bf16, RF>(it, last ? it : itn, rf, SEQ, 1 << 30, (char*)lds_g, S);
            if (last) break;
            it = itn;
        }
    }
}

#ifndef MK_SPLIT
#define MK_SPLIT 0
#endif
constexpr int N_PHASES = DEPTH * 10;
__device__ __forceinline__ CP kargs() { CP q = (CP)__builtin_amdgcn_kernarg_segment_ptr(); asm volatile("; kargs" : "+s"(q)); return q; }
__global__ void __launch_bounds__(NTHR, 2) mk_fwd(Params p_unused) {
    CP p = kargs();
    extern __shared__ __attribute__((aligned(16))) unsigned char lds_raw[];
    LAS unsigned char* lds = (LAS unsigned char*)lds_raw;
    const int tid = threadIdx.x;
    if (tid < 64) ((LAS unsigned*)(lds + MISC_OFF))[tid] = 0u;
    __syncthreads();
    if (!MK_SPLIT) (void)xcd_barrier_post((unsigned*)(p->ws + WS_CTL) + CW_BAR, (volatile LAS unsigned*)(lds + MISC_OFF) + 8);
#if MK_SPLIT
    const int lo = p->ph_lo, hi = p->ph_hi;
#else
    constexpr int lo = 0, hi = N_PHASES;
#endif
#ifndef MK_MASK
#define MK_MASK 0x3ff
#endif
#define IN(q) (((MK_MASK >> (q)) & 1) && lo <= l * 10 + (q) && l * 10 + (q) < hi)
#define SEAM(q) do { if (l * 10 + (q) + 1 < hi) { if (MK_SPLIT) {} else { XcdBarrier bar; bar.bar = (unsigned*)(p->ws + WS_CTL) + CW_BAR; bar.x = xb_xcc_id(); bar.st = (volatile LAS unsigned*)(lds + MISC_OFF) + 8; xcd_barrier(bar); } } } while (0)
#define XB ((bf16_t*)(p->ws + WS_XB))
#define Hb ((bf16_t*)(p->ws + WS_H))
#define HID ((bf16_t*)(p->ws + WS_HID))
#define WinT ((const bf16_t*)(p->ws + WS_WIN))
#define WoutT ((const bf16_t*)(p->ws + WS_WOUT))
#define WupT ((const bf16_t*)(p->ws + WS_WUP))
#define WdnT ((const bf16_t*)(p->ws + WS_WDN))
#define LAYER_BODY(LL) do { constexpr int l = (LL); \
        if (IN(0)) { CP p = kargs(); if (l == 0) phase_prologue(p); phase_convert(p, l, lds); SEAM(0); } \
        if (IN(1)) { CP p = kargs(); \
            pg8::Gemm g{XB, WinT, M, PINP, DM}; pg8::StaticOrder S; S.init(M, PINP, (int)gridDim.x, (int)blockIdx.x); \
            pg8::EpiBf16<0> E{Hb, PINP, nullptr, 0, 0, 1.f}; \
            pg8::gemm_phase<pg8::EpiBf16<0>, pg8::StaticOrder, PG8_ALIGN, PG8_SP2>(lds, g, S, E); \
            SEAM(1); } \
        if (IN(2)) { CP p = kargs(); phase_pre(p, l, lds); SEAM(2); } \
        if (IN(3)) { CP p = kargs(); phase_mix(p, l, lds_raw, lds); SEAM(3); } \
        if (IN(4)) { CP p = kargs(); phase_post(p, l, lds); SEAM(4); } \
        if (IN(5)) { CP p = kargs(); \
            pg8::Gemm g{XB, WoutT, M, DM, DM}; pg8::StaticOrder S; S.init(M, DM, (int)gridDim.x, (int)blockIdx.x); \
            pg8::EpiResid E{p->out, DM, ALPHA}; \
            pg8::gemm_phase<pg8::EpiResid, pg8::StaticOrder, PG8_ALIGN, PG8_SP2>(lds, g, S, E); \
            SEAM(5); } \
        if (IN(6)) { CP p = kargs(); phase_ln(p, p->in[17] + l * DM, p->in[18] + l * DM); SEAM(6); } \
        if (IN(7)) { CP p = kargs(); \
            pg8::Gemm g{XB, WupT, M, DFF, DM}; pg8::StaticOrder S; S.init(M, DFF, (int)gridDim.x, (int)blockIdx.x); \
            pg8::EpiRelu2 E{HID, DFF}; \
            pg8::gemm_phase<pg8::EpiRelu2, pg8::StaticOrder, PG8_ALIGN, PG8_SP2>(lds, g, S, E); \
            SEAM(7); } \
        if (IN(8)) { CP p = kargs(); \
            pg8::Gemm g{HID, WdnT, M, DM, DFF}; pg8::StaticOrder S; S.init(M, DM, (int)gridDim.x, (int)blockIdx.x); \
            pg8::EpiResid E{p->out, DM, ALPHA}; \
            pg8::gemm_phase<pg8::EpiResid, pg8::StaticOrder, PG8_ALIGN, PG8_SP2>(lds, g, S, E); \
            SEAM(8); } \
        if (IN(9)) { CP p = kargs(); phase_ln(p, p->in[21] + l * DM, p->in[22] + l * DM); SEAM(9); } \
    } while (0)
    LAYER_BODY(0); LAYER_BODY(1); LAYER_BODY(2); LAYER_BODY(3);
#undef LAYER_BODY
#undef IN
#undef SEAM
#undef XB
#undef Hb
#undef HID
#undef WinT
#undef WoutT
#undef WupT
#undef WdnT
}

extern "C" void kernel_launch(void* const* d_in, const int* in_sizes, int n_in, void* d_out, int out_size, void* d_ws, size_t ws_size, hipStream_t stream) {
    static int grid = 0;
    if (grid == 0) {
        if (n_in != 23 || out_size != M * DM || ws_size < WS_END) { fprintf(stderr, "kernel_launch: unexpected shapes (n_in %d, out %d, ws %zu, need %zu)\n", n_in, out_size, ws_size, (size_t)WS_END); grid = -1; return; }
        int dev = 0, cus = 0, per_cu = 0;
        if (hipGetDevice(&dev) != hipSuccess || hipDeviceGetAttribute(&cus, hipDeviceAttributeMultiprocessorCount, dev) != hipSuccess) { grid = -1; return; }
        if (hipFuncSetAttribute((const void*)mk_fwd, hipFuncAttributeMaxDynamicSharedMemorySize, LDS_BYTES) != hipSuccess) { fprintf(stderr, "kernel_launch: hipFuncSetAttribute failed\n"); grid = -1; return; }
        if (hipOccupancyMaxActiveBlocksPerMultiprocessor(&per_cu, (const void*)mk_fwd, NTHR, LDS_BYTES) != hipSuccess || per_cu < 1) { fprintf(stderr, "kernel_launch: occupancy query says %d\n", per_cu); }
        (void)hipGetLastError();
        grid = cus;
    }
    if (grid < 0) return;
    (void)hipMemsetAsync((char*)d_ws + WS_CTL, 0, CTL_BYTES, stream);
    Params p{};
    for (int i = 0; i < 23; ++i) p.in[i] = (const float*)d_in[i];
    p.out = (float*)d_out; p.ws = (unsigned char*)d_ws;
#if MK_SPLIT
    for (int g = 0; g < N_PHASES; ++g) { p.ph_lo = g; p.ph_hi = g + 1; hipLaunchKernelGGL(mk_fwd, dim3(grid), dim3(NTHR), LDS_BYTES, stream, p); }
#else
    p.ph_lo = 0; p.ph_hi = N_PHASES; hipLaunchKernelGGL(mk_fwd, dim3(grid), dim3(NTHR), LDS_BYTES, stream, p);
#endif
}
```

```cpp
#include <hip/hip_runtime.h>
#include <hip/hip_bf16.h>
#include <cstdio>
#include <cstdint>
#include <cmath>
__device__ __forceinline__ int otid(int wvs) { int t; asm volatile("v_mbcnt_lo_u32_b32 %0, -1, 0\n\tv_mbcnt_hi_u32_b32 %0, -1, %0\n\tv_lshl_or_b32 %0, %1, 6, %0 ; otid" : "=&v"(t) : "s"(wvs)); return t; }
namespace pg8 {
#define PG8_LAS __attribute__((address_space(3)))
typedef unsigned short bf16_t;
typedef short bf16x8 __attribute__((ext_vector_type(8)));
typedef float f32x4 __attribute__((ext_vector_type(4)));
typedef unsigned u32x4 __attribute__((ext_vector_type(4)));
constexpr int BM = 256, BK = 64, HALF = 128, HTB = HALF * BK * 2  , STAGE_BYTES = 8 * HTB, NXCD = 8, WGM = 4;

__host__ __device__ __forceinline__ int lds_byte(int r, int c) { const int st = (r >> 4) * 2 + (c >> 5), rr = r & 15, cc = c & 31, ob = rr * 64 + cc * 2; return st * 1024 + (ob ^ (((ob >> 9) & 1) << 5)); }
__host__ __device__ __forceinline__ void stage_rc(int b, int& R, int& C) { const int st = b / 1024, sb = b % 1024, swz = sb ^ (((sb >> 9) & 1) << 5); R = (st >> 1) * 16 + swz / 64; C = (st & 1) * 32 + (swz % 64) / 2; }
__host__ __device__ __forceinline__ int perm32(int rho) { const int n = rho >> 4, i = rho & 15; return 8 * (i >> 2) + 4 * n + (i & 3); }

struct Unit { int pm, pn; };
struct Gemm { const bf16_t* A; const bf16_t* Bt; int M, N, K; };

struct StaticOrder {
    int nM, nN, nwg, G, c, wv, wgm = WGM;
    __host__ __device__ void init(int M, int N, int G_, int c_) { nM = M / BM; nN = N / BM; nwg = nM * nN; G = G_; c = c_; }
    __host__ __device__ bool next(int i, Unit& u) const {
        const long L = (long)i * G + c; if (L >= nwg) return false;
        int wgid = (int)L; { const int q = nwg / NXCD, r = nwg % NXCD, xcd = wgid % NXCD, off = wgid / NXCD; wgid = (xcd < r ? xcd * (q + 1) : r * (q + 1) + (xcd - r) * q) + off; }
        const int nig = wgm * nN, gid = wgid / nig, fm = gid * wgm, gsz = (nM - fm) < wgm ? (nM - fm) : wgm;
        u.pm = fm + ((wgid % nig) % gsz); u.pn = (wgid % nig) / gsz; return true;
    }
    __device__ __forceinline__ void a_ready(const Unit&) const {}
    __device__ __forceinline__ void done(const Unit&) const {}
};

__device__ __forceinline__ unsigned cvt_pk_bf16(float lo, float hi) { unsigned r; asm volatile("v_cvt_pk_bf16_f32 %0, %1, %2" : "=v"(r) : "v"(lo), "v"(hi)); return r; }
typedef float f32x2 __attribute__((ext_vector_type(2)));
__device__ __forceinline__ f32x2 gelu_pk(f32x2 v) {
    const f32x2 av = __builtin_elementwise_abs(v), d = av * 0.2316418882f + 1.0f;
    f32x2 t; t.x = __builtin_amdgcn_rcpf(d.x); t.y = __builtin_amdgcn_rcpf(d.y);
    f32x2 q = t * 0.5307027145f + (-0.7265760135f); q = q * t + 0.7107068705f; q = q * t + (-0.142248368f); q = q * t + 0.127414796f; q = q * t;
    const f32x2 s = (v * v) * (-0.72134752044f);
    f32x2 e; e.x = __builtin_amdgcn_exp2f(s.x); e.y = __builtin_amdgcn_exp2f(s.y);
    const f32x2 m = v * (q * e), r = v - m;
    f32x2 o; o.x = v.x < 0.f ? m.x : r.x; o.y = v.y < 0.f ? m.y : r.y; return o;
}

template <int ACT  > struct EpiBf16 {
    static constexpr bool PERM = true, AFTER_DRAIN = false; static_assert(ACT == 0 || ACT == 1, "EpiBf16: ACT is 0 (none) or 1 (gelu_pk)");
    bf16_t* O; int ldc; const float* bias; int split_cols; size_t split_stride; float scale0;
    __device__ __forceinline__ void operator()(const f32x4 (&acc)[2][2][4][2], const Unit& u, int wr, int wc, int fr, int fq) const {
        const int row0 = u.pm * BM + wr * 64 + fr; int colt = u.pn * BM; bf16_t* base = O;
        float sc = 1.f; if (split_cols) { const int t = colt / split_cols; base += (size_t)t * split_stride; colt -= t * split_cols; if (t == 0) sc = scale0; }
        const int col0 = colt + wc * 32 + 8 * fq, bcol0 = u.pn * BM + wc * 32 + 8 * fq;
        f32x4 bv[2][2];
#pragma unroll
        for (int bj = 0; bj < 2; ++bj)
#pragma unroll
            for (int n = 0; n < 2; ++n) bv[bj][n] = bias ? *(const f32x4*)(bias + bcol0 + bj * HALF + 4 * n) : (f32x4){0.f, 0.f, 0.f, 0.f};
#pragma unroll
        for (int ai = 0; ai < 2; ++ai)
#pragma unroll
            for (int m = 0; m < 4; ++m) { bf16_t* rowp = base + (size_t)(row0 + ai * HALF + m * 16) * ldc + col0;
#pragma unroll
                for (int bj = 0; bj < 2; ++bj) { f32x4 v0 = acc[ai][bj][m][0] + bv[bj][0], v1 = acc[ai][bj][m][1] + bv[bj][1];
                    if (ACT == 1) { f32x2 a = gelu_pk((f32x2){v0[0], v0[1]}), b = gelu_pk((f32x2){v0[2], v0[3]}), c = gelu_pk((f32x2){v1[0], v1[1]}), d = gelu_pk((f32x2){v1[2], v1[3]});
                        v0 = (f32x4){a.x, a.y, b.x, b.y}; v1 = (f32x4){c.x, c.y, d.x, d.y}; }
                    v0 = v0 * sc; v1 = v1 * sc; u32x4 w; w.x = cvt_pk_bf16(v0[0], v0[1]); w.y = cvt_pk_bf16(v0[2], v0[3]); w.z = cvt_pk_bf16(v1[0], v1[1]); w.w = cvt_pk_bf16(v1[2], v1[3]);
                    __builtin_nontemporal_store(w, (u32x4*)(rowp + bj * HALF)); } }
    }
};

struct PanelStats {
    unsigned* xbuf;
    unsigned* cnt;
    unsigned* tmo;
    int ntn; float eps;
    unsigned code;
    __device__ __forceinline__ bool run(const f32x4 (&v)[2][2][4][2], const Unit& u, int wr, int wc, int fr, int fq, PG8_LAS unsigned char* lds, int wid, int lane) const {
        typedef float f32x2v __attribute__((ext_vector_type(2)));
        PG8_LAS f32x2v* P = (PG8_LAS f32x2v*)lds;
        PG8_LAS f32x2v* S = (PG8_LAS f32x2v*)(lds + 8192);
        PG8_LAS unsigned* flag = (PG8_LAS unsigned*)(lds + 8192 + 2048);
#pragma unroll
        for (int ai = 0; ai < 2; ++ai)
#pragma unroll
            for (int m = 0; m < 4; ++m) {
                float s = 0.f;
#pragma unroll
                for (int bj = 0; bj < 2; ++bj)
#pragma unroll
                    for (int n = 0; n < 2; ++n) { const f32x4 x = v[ai][bj][m][n]; s += (x[0] + x[1]) + (x[2] + x[3]); }
                s += __shfl_xor(s, 16); s += __shfl_xor(s, 32);
                const float mw = s * (1.0f / 64.0f); float q = 0.f;
#pragma unroll
                for (int bj = 0; bj < 2; ++bj)
#pragma unroll
                    for (int n = 0; n < 2; ++n) { const f32x4 d = v[ai][bj][m][n] - mw; q += (d[0] * d[0] + d[1] * d[1]) + (d[2] * d[2] + d[3] * d[3]); }
                q += __shfl_xor(q, 16); q += __shfl_xor(q, 32);
                if (fq == 0) P[(ai * HALF + wr * 64 + m * 16 + fr) * 4 + wc] = (f32x2v){mw, q};
            }
        asm volatile("s_waitcnt lgkmcnt(0)" ::: "memory"); __builtin_amdgcn_s_barrier(); asm volatile("" ::: "memory");
#if defined(BROKEN_EXCHANGE_NO_WAIT)
#warning BROKEN CONTROL BUILD: the row-statistics exchange does not wait; results are wrong by design
        if (blockIdx.x >= 64) { const long long t0_ = clock64(); while (clock64() - t0_ < 60000) __builtin_amdgcn_s_sleep(8); }
#endif
        const int row = wid * 32 + (lane & 31);
        if (lane < 32) {
            const f32x2v a = P[row * 4 + 0], b = P[row * 4 + 1], c = P[row * 4 + 2], d = P[row * 4 + 3];
            const float mt = (a.x + b.x + c.x + d.x) * 0.25f;
            const float da = a.x - mt, db = b.x - mt, dc = c.x - mt, dd = d.x - mt;
            const float m2 = (a.y + b.y) + (c.y + d.y) + 64.0f * ((da * da + db * db) + (dc * dc + dd * dd));
            unsigned long long* slot = (unsigned long long*)xbuf + ((size_t)(u.pm * BM + row) * 4 + u.pn);
            __hip_atomic_store(slot, ((unsigned long long)__float_as_uint(m2) << 32) | __float_as_uint(mt), __ATOMIC_RELAXED, __HIP_MEMORY_SCOPE_AGENT);
        }
        asm volatile("s_waitcnt vmcnt(0)" ::: "memory");
        if (lane == 0) __hip_atomic_fetch_add(cnt + 64 * u.pm, 1u, __ATOMIC_RELAXED, __HIP_MEMORY_SCOPE_AGENT);
        if (wid == 0) {
            bool dead = false; const unsigned long long t0 = __builtin_amdgcn_s_memrealtime(); const unsigned want = 8u * (unsigned)ntn;
            for (;;) {
#if defined(BROKEN_EXCHANGE_NO_WAIT)
                break;
#endif
                if ((unsigned)__builtin_amdgcn_readfirstlane(__hip_atomic_load(cnt + 64 * u.pm, __ATOMIC_RELAXED, __HIP_MEMORY_SCOPE_AGENT)) >= want) break;
                if (__builtin_amdgcn_s_memrealtime() - t0 > 2000000ull) {
                    if (lane == 0) { unsigned expect = 0u; __hip_atomic_compare_exchange_strong(tmo + 1, &expect, code | (unsigned)(u.pm & 0xff), __ATOMIC_RELAXED, __ATOMIC_RELAXED, __HIP_MEMORY_SCOPE_AGENT);
                                     __hip_atomic_store(tmo, 1u, __ATOMIC_RELAXED, __HIP_MEMORY_SCOPE_AGENT); }
                    dead = true; break; }
                __builtin_amdgcn_s_sleep(2);
            }
            __builtin_amdgcn_fence(__ATOMIC_ACQUIRE, "agent");
            if (lane == 0) flag[0] = dead ? 1u : 0u;
        }
        asm volatile("s_waitcnt vmcnt(0) lgkmcnt(0)" ::: "memory"); __builtin_amdgcn_s_barrier(); asm volatile("" ::: "memory");
        const bool bad = flag[0] != 0u;
        if (lane < 32) {
            const unsigned long long* slot = (const unsigned long long*)xbuf + (size_t)(u.pm * BM + row) * 4; float mt[4], m2[4]; float ms = 0.f;
#pragma unroll
            for (int t = 0; t < 4; ++t) { if (t < ntn) { const unsigned long long w = __hip_atomic_load(slot + t, __ATOMIC_RELAXED, __HIP_MEMORY_SCOPE_AGENT); mt[t] = __uint_as_float((unsigned)w); m2[t] = __uint_as_float((unsigned)(w >> 32)); } else { mt[t] = 0.f; m2[t] = 0.f; } ms += mt[t]; }
            const float mean = ms / (float)ntn; float q = 0.f;
#pragma unroll
            for (int t = 0; t < 4; ++t) if (t < ntn) { const float dm = mt[t] - mean; q += m2[t] + 256.0f * dm * dm; }
            S[row] = (f32x2v){mean, 1.0f / sqrtf(q / (256.0f * (float)ntn) + eps)};
        }
        asm volatile("s_waitcnt lgkmcnt(0)" ::: "memory"); __builtin_amdgcn_s_barrier(); asm volatile("" ::: "memory");
        return bad;
    }
};
struct EpiLnRes {
    static constexpr bool PERM = false, AFTER_DRAIN = true;
    const float* base; float* out; int ldc; const float* bias; PanelStats st; unsigned poison;
    __device__ __forceinline__ void fused(f32x4 (&acc)[2][2][4][2], const Unit& u, int wr, int wc, int fr, int fq, PG8_LAS unsigned char* lds, int wid, int lane) const {
        typedef float f32x2v __attribute__((ext_vector_type(2)));
        const PG8_LAS f32x2v* S = (const PG8_LAS f32x2v*)(lds + 8192);
        const int col0 = u.pn * BM + wc * 32 + 4 * fq;
#pragma unroll
        for (int bj = 0; bj < 2; ++bj)
#pragma unroll
            for (int n = 0; n < 2; ++n) { const f32x4 bv = bias ? *(const f32x4*)(bias + col0 + bj * HALF + n * 16) : (f32x4){0.f, 0.f, 0.f, 0.f};
#pragma unroll
                for (int ai = 0; ai < 2; ++ai)
#pragma unroll
                    for (int m = 0; m < 4; ++m) acc[ai][bj][m][n] += bv; }
        f32x4 pre[4][2][2];
#pragma unroll
        for (int m = 0; m < 4; ++m) { const size_t off = (size_t)(u.pm * BM + wr * 64 + m * 16 + fr) * ldc + col0;
#pragma unroll
            for (int bj = 0; bj < 2; ++bj)
#pragma unroll
                for (int n = 0; n < 2; ++n) pre[m][bj][n] = *(const f32x4*)(base + off + bj * HALF + n * 16); }
        const bool bad = st.run(acc, u, wr, wc, fr, fq, lds, wid, lane) || poison != 0u;
        const float qnan = __builtin_nanf("");
#pragma unroll
        for (int ai = 0; ai < 2; ++ai)
#pragma unroll
            for (int m = 0; m < 4; ++m) { const int r = ai * HALF + wr * 64 + m * 16 + fr; const f32x2v sr = S[r]; const size_t off = (size_t)(u.pm * BM + r) * ldc + col0;
#pragma unroll
                for (int bj = 0; bj < 2; ++bj)
#pragma unroll
                    for (int n = 0; n < 2; ++n) { const f32x4 bs = ai == 0 ? pre[m][bj][n] : *(const f32x4*)(base + off + bj * HALF + n * 16); f32x4 o = bs + (acc[ai][bj][m][n] - sr.x) * sr.y;
                        if (bad) o = (f32x4){qnan, qnan, qnan, qnan}; *(f32x4*)(out + off + bj * HALF + n * 16) = o; }
                if (m & 1) asm volatile("" ::: "memory"); }
    }
};
struct EpiLnResLn {
    static constexpr bool PERM = false, AFTER_DRAIN = true;
    const float* base; float* out; bf16_t* xn; int ldc; const float* bias; PanelStats st1, st2; unsigned poison;
    __device__ __forceinline__ void fused(f32x4 (&acc)[2][2][4][2], const Unit& u, int wr, int wc, int fr, int fq, PG8_LAS unsigned char* lds, int wid, int lane) const {
        typedef float f32x2v __attribute__((ext_vector_type(2))); typedef unsigned u32x2v __attribute__((ext_vector_type(2)));
        const PG8_LAS f32x2v* S = (const PG8_LAS f32x2v*)(lds + 8192);
        const int col0 = u.pn * BM + wc * 32 + 4 * fq;
#pragma unroll
        for (int bj = 0; bj < 2; ++bj)
#pragma unroll
            for (int n = 0; n < 2; ++n) { const f32x4 bv = bias ? *(const f32x4*)(bias + col0 + bj * HALF + n * 16) : (f32x4){0.f, 0.f, 0.f, 0.f};
#pragma unroll
                for (int ai = 0; ai < 2; ++ai)
#pragma unroll
                    for (int m = 0; m < 4; ++m) acc[ai][bj][m][n] += bv; }
        bool bad = st1.run(acc, u, wr, wc, fr, fq, lds, wid, lane) || poison != 0u;
        const float qnan = __builtin_nanf("");
#pragma unroll
        for (int ai = 0; ai < 2; ++ai)
#pragma unroll
            for (int m = 0; m < 4; ++m) { const int r = ai * HALF + wr * 64 + m * 16 + fr; const f32x2v sr = S[r]; const size_t off = (size_t)(u.pm * BM + r) * ldc + col0;
#pragma unroll
                for (int bj = 0; bj < 2; ++bj)
#pragma unroll
                    for (int n = 0; n < 2; ++n) { const f32x4 bs = *(const f32x4*)(base + off + bj * HALF + n * 16); acc[ai][bj][m][n] = bs + (acc[ai][bj][m][n] - sr.x) * sr.y; }
                asm volatile("" : "+v"(acc[ai][0][m][0]), "+v"(acc[ai][0][m][1]), "+v"(acc[ai][1][m][0]), "+v"(acc[ai][1][m][1]));
                if (m & 1) asm volatile("" ::: "memory"); }
        const bool bad1 = bad;
        bad = st2.run(acc, u, wr, wc, fr, fq, lds, wid, lane) || bad;
#pragma unroll
        for (int ai = 0; ai < 2; ++ai)
#pragma unroll
            for (int m = 0; m < 4; ++m) { const int r = ai * HALF + wr * 64 + m * 16 + fr; const f32x2v sr = S[r]; const size_t off = (size_t)(u.pm * BM + r) * ldc + col0;
#pragma unroll
                for (int bj = 0; bj < 2; ++bj)
#pragma unroll
                    for (int n = 0; n < 2; ++n) { const f32x4 x1 = acc[ai][bj][m][n]; *(f32x4*)(out + off + bj * HALF + n * 16) = bad1 ? (f32x4){qnan, qnan, qnan, qnan} : x1;
                        const f32x4 o = (x1 - sr.x) * sr.y; u32x2v w; w.x = cvt_pk_bf16(o[0], o[1]); w.y = cvt_pk_bf16(o[2], o[3]);
                        if (bad) { w.x = 0x7fc07fc0u; w.y = 0x7fc07fc0u; } *(u32x2v*)(xn + off + bj * HALF + n * 16) = w; }
                asm volatile("" ::: "memory"); }
    }
};

template <class Epi, class Sched, bool ALIGN_EPI = false, bool SP2 = false>
__device__ __forceinline__ void gemm_phase(PG8_LAS unsigned char* lds, const Gemm g, const Sched& S, const Epi& E) {
    const int tid = otid(S.wv), wid = __builtin_amdgcn_readfirstlane(tid >> 6), lane = tid & 63, wr = wid >> 2, wc = wid & 3, fr = lane & 15, fq = lane >> 4;
    const int K = g.K, nt = K / BK;
    unsigned voffA[2], voffB[2];
#pragma unroll
    for (int i = 0; i < 2; ++i) { int R, C; stage_rc(tid * 16 + i * 8192, R, C); const int Rb = Epi::PERM ? ((R & ~31) + perm32(R & 31)) : R;
        voffA[i] = (unsigned)(R * K + C) * 2u; voffB[i] = (unsigned)(Rb * K + C) * 2u; }
    const size_t kstep = (size_t)(BK * 2);
    const size_t hstep = (size_t)HALF * K * 2;
    const size_t tstep = 2 * hstep;
    const unsigned ldsw = (unsigned)wid * 1024u;
    const int aoff = lds_byte(wr * 64 + fr, fq * 8), boff = lds_byte(wc * 32 + fr, fq * 8);
#define PG8_SA(b, h) (((b) * 2 + (h)) * HTB)
#define PG8_SB(b, h) ((4 + (b) * 2 + (h)) * HTB)
#define PG8_STAGE(bufoff, gbase, voff) do { _Pragma("unroll") for (int _i = 0; _i < 2; ++_i) \
        __builtin_amdgcn_global_load_lds((const unsigned*)((const char*)(gbase) + (voff)[_i]), (PG8_LAS unsigned*)(lds + (bufoff) + ldsw + _i * 8192), 16, 0, 0); } while (0)
#define PG8_LDA(dst, b, h) do { _Pragma("unroll") for (int m = 0; m < 4; ++m) _Pragma("unroll") for (int k = 0; k < 2; ++k) dst[m][k] = *(const PG8_LAS bf16x8*)(lds + PG8_SA(b, h) + aoff + m * 2048 + k * 1024); } while (0)
#define PG8_LDB(dst, b, h) do { _Pragma("unroll") for (int n = 0; n < 2; ++n) _Pragma("unroll") for (int k = 0; k < 2; ++k) dst[n][k] = *(const PG8_LAS bf16x8*)(lds + PG8_SB(b, h) + boff + n * 2048 + k * 1024); } while (0)
#define PG8_MMA(ai, bj, At, Bt) do { __builtin_amdgcn_s_setprio(1); _Pragma("unroll") for (int m = 0; m < 4; ++m) _Pragma("unroll") for (int n = 0; n < 2; ++n) _Pragma("unroll") for (int k = 0; k < 2; ++k) \
        acc[ai][bj][m][n] = __builtin_amdgcn_mfma_f32_16x16x32_bf16(Bt[n][k], At[m][k], acc[ai][bj][m][n], 0, 0, 0); __builtin_amdgcn_s_setprio(0); } while (0)
#define PG8_WAIT_V(n) asm volatile("s_waitcnt vmcnt(" #n ")" ::: "memory")
#define PG8_WAIT_L(n) asm volatile("s_waitcnt lgkmcnt(" #n ")" ::: "memory")
#define PG8_BAR __builtin_amdgcn_s_barrier()
#define PG8_SCHED __builtin_amdgcn_sched_barrier(0)
    Unit cur, nxt; int ui = 0;
    if (!S.next(0, cur)) return;
    f32x4 acc[2][2][4][2];
#pragma unroll
    for (int a = 0; a < 2; ++a)
#pragma unroll
        for (int b = 0; b < 2; ++b)
#pragma unroll
            for (int m = 0; m < 4; ++m)
#pragma unroll
                for (int n = 0; n < 2; ++n) acc[a][b][m][n] = (f32x4){0.f, 0.f, 0.f, 0.f};
    bf16x8 At[4][2], B0[2][2], B1[2][2];
    const char* cA = (const char*)g.A + (size_t)cur.pm * tstep; const char* cB = (const char*)g.Bt + (size_t)cur.pn * tstep;
    S.a_ready(cur);
    if constexpr (SP2) {
        PG8_STAGE(PG8_SB(0, 0), cB, voffB); PG8_STAGE(PG8_SB(0, 1), cB + hstep, voffB); PG8_STAGE(PG8_SA(0, 0), cA, voffA); PG8_STAGE(PG8_SA(0, 1), cA + hstep, voffA);
        if (wr == 1) PG8_BAR;
        PG8_WAIT_V(2); PG8_BAR;
        PG8_STAGE(PG8_SB(1, 0), cB + kstep, voffB); PG8_STAGE(PG8_SA(1, 0), cA + kstep, voffA); PG8_STAGE(PG8_SB(1, 1), cB + hstep + kstep, voffB);
        PG8_WAIT_V(6); PG8_BAR;
    } else {
        PG8_STAGE(PG8_SB(0, 0), cB, voffB); PG8_STAGE(PG8_SA(0, 0), cA, voffA); PG8_STAGE(PG8_SB(0, 1), cB + hstep, voffB); PG8_STAGE(PG8_SA(0, 1), cA + hstep, voffA);
        if (wr == 1) PG8_BAR;
        PG8_WAIT_V(4); PG8_BAR;
        PG8_STAGE(PG8_SB(1, 0), cB + kstep, voffB); PG8_STAGE(PG8_SA(1, 0), cA + kstep, voffA); PG8_STAGE(PG8_SB(1, 1), cB + hstep + kstep, voffB);
        PG8_WAIT_V(6); PG8_BAR;
    }
    for (;;) {
        const bool has_next = S.next(ui + 1, nxt);
        const char* nA = has_next ? (const char*)g.A + (size_t)nxt.pm * tstep : cA; const char* nB = has_next ? (const char*)g.Bt + (size_t)nxt.pn * tstep : cB;
        for (int t = 0; t < nt; t += 2) {
            const bool last = (t == nt - 2);
            const char* a1 = cA + (size_t)(t + 1) * kstep;
            const char* a2 = last ? nA : cA + (size_t)(t + 2) * kstep; const char* b2 = last ? nB : cB + (size_t)(t + 2) * kstep;
            const char* a3 = a2 + kstep; const char* b3 = b2 + kstep;
            if (last && has_next) S.a_ready(nxt);
            if constexpr (SP2) {
            PG8_LDB(B0, 0, 0); PG8_LDB(B1, 0, 1); PG8_SCHED; PG8_LDA(At, 0, 0); PG8_STAGE(PG8_SA(1, 1), a1 + hstep, voffA);
            PG8_WAIT_V(8); PG8_WAIT_L(0); PG8_BAR; PG8_MMA(0, 0, At, B0); PG8_MMA(0, 1, At, B1); PG8_BAR; PG8_SCHED;
            PG8_LDA(At, 0, 1); PG8_STAGE(PG8_SB(0, 0), b2, voffB); PG8_STAGE(PG8_SB(0, 1), b2 + hstep, voffB); PG8_STAGE(PG8_SA(0, 0), a2, voffA);
            PG8_WAIT_V(8); PG8_WAIT_L(0); PG8_BAR; PG8_MMA(1, 0, At, B0); PG8_MMA(1, 1, At, B1); PG8_BAR; PG8_SCHED;
            PG8_LDB(B0, 1, 0); PG8_LDB(B1, 1, 1); PG8_SCHED; PG8_LDA(At, 1, 0); PG8_STAGE(PG8_SA(0, 1), a2 + hstep, voffA);
            PG8_WAIT_V(8); PG8_WAIT_L(0); PG8_BAR; PG8_MMA(0, 0, At, B0); PG8_MMA(0, 1, At, B1); PG8_BAR; PG8_SCHED;
            PG8_LDA(At, 1, 1); PG8_STAGE(PG8_SB(1, 0), b3, voffB); PG8_STAGE(PG8_SB(1, 1), b3 + hstep, voffB); PG8_STAGE(PG8_SA(1, 0), a3, voffA);
            PG8_WAIT_V(8); PG8_WAIT_L(0); PG8_BAR; PG8_MMA(1, 0, At, B0); PG8_MMA(1, 1, At, B1); PG8_BAR; PG8_SCHED;
            } else {
            PG8_LDB(B0, 0, 0); PG8_SCHED; PG8_LDA(At, 0, 0); PG8_STAGE(PG8_SA(1, 1), a1 + hstep, voffA);
            PG8_WAIT_L(8); PG8_BAR; PG8_WAIT_L(0); PG8_MMA(0, 0, At, B0); PG8_BAR; PG8_SCHED;
            PG8_LDB(B1, 0, 1); PG8_STAGE(PG8_SB(0, 0), b2, voffB);
            PG8_BAR; PG8_WAIT_L(0); PG8_MMA(0, 1, At, B1); PG8_BAR;
            PG8_LDA(At, 0, 1); PG8_STAGE(PG8_SA(0, 0), a2, voffA);
            PG8_BAR; PG8_WAIT_L(0); PG8_MMA(1, 0, At, B0); PG8_BAR; PG8_SCHED;
            PG8_STAGE(PG8_SB(0, 1), b2 + hstep, voffB);
            PG8_WAIT_V(6); PG8_BAR; PG8_MMA(1, 1, At, B1); PG8_BAR;
            PG8_LDB(B0, 1, 0); PG8_SCHED; PG8_LDA(At, 1, 0); PG8_STAGE(PG8_SA(0, 1), a2 + hstep, voffA);
            PG8_WAIT_L(8); PG8_BAR; PG8_WAIT_L(0); PG8_MMA(0, 0, At, B0); PG8_BAR; PG8_SCHED;
            PG8_LDB(B1, 1, 1); PG8_STAGE(PG8_SB(1, 0), b3, voffB);
            PG8_BAR; PG8_WAIT_L(0); PG8_MMA(0, 1, At, B1); PG8_BAR;
            PG8_LDA(At, 1, 1); PG8_STAGE(PG8_SA(1, 0), a3, voffA);
            PG8_BAR; PG8_WAIT_L(0); PG8_MMA(1, 0, At, B0); PG8_BAR; PG8_SCHED;
            PG8_STAGE(PG8_SB(1, 1), b3 + hstep, voffB);
            PG8_WAIT_V(6); PG8_BAR; PG8_MMA(1, 1, At, B1); PG8_BAR;
            }
        }
        if constexpr (ALIGN_EPI) { if (wr == 0) PG8_BAR; }
        if constexpr (!Epi::AFTER_DRAIN) { E(acc, cur, wr, wc, fr, fq); S.done(cur); }
        if (!has_next) break;
#pragma unroll
        for (int a = 0; a < 2; ++a)
#pragma unroll
            for (int b = 0; b < 2; ++b)
#pragma unroll
                for (int m = 0; m < 4; ++m)
#pragma unroll
                    for (int n = 0; n < 2; ++n) acc[a][b][m][n] = (f32x4){0.f, 0.f, 0.f, 0.f};
        cur = nxt; cA = nA; cB = nB; ++ui;
        if constexpr (ALIGN_EPI) { if (wr == 1) PG8_BAR; }
    }
    PG8_WAIT_V(0);
    if constexpr (!ALIGN_EPI) { if (wr == 0) PG8_BAR; }
    PG8_BAR;
    if constexpr (Epi::AFTER_DRAIN) { E.fused(acc, cur, wr, wc, fr, fq, lds, wid, lane); S.done(cur); }
#undef PG8_SA
#undef PG8_SB
#undef PG8_STAGE
#undef PG8_LDA
#undef PG8_LDB
#undef PG8_MMA
#undef PG8_WAIT_V
#undef PG8_WAIT_L
#undef PG8_BAR
#undef PG8_SCHED
}
}
namespace pg8 {
struct EpiRelu2 {
    static constexpr bool PERM = true, AFTER_DRAIN = false;
    bf16_t* O; int ldc;
    __device__ __forceinline__ void operator()(const f32x4 (&acc)[2][2][4][2], const Unit& u, int wr, int wc, int fr, int fq) const {
        const int row0 = u.pm * BM + wr * 64 + fr, col0 = u.pn * BM + wc * 32 + 8 * fq;
#pragma unroll
        for (int ai = 0; ai < 2; ++ai)
#pragma unroll
            for (int m = 0; m < 4; ++m) { bf16_t* rowp = O + (size_t)(row0 + ai * HALF + m * 16) * ldc + col0;
#pragma unroll
                for (int bj = 0; bj < 2; ++bj) { f32x4 v0 = acc[ai][bj][m][0], v1 = acc[ai][bj][m][1];
#pragma unroll
                    for (int j = 0; j < 4; ++j) { const float a = fmaxf(v0[j], 0.f), b = fmaxf(v1[j], 0.f); v0[j] = a * a; v1[j] = b * b; }
                    u32x4 w; w.x = cvt_pk_bf16(v0[0], v0[1]); w.y = cvt_pk_bf16(v0[2], v0[3]); w.z = cvt_pk_bf16(v1[0], v1[1]); w.w = cvt_pk_bf16(v1[2], v1[3]);
                    __builtin_nontemporal_store(w, (u32x4*)(rowp + bj * HALF)); } }
    }
};
struct EpiInProj {
    static constexpr bool PERM = true, AFTER_DRAIN = false;
    bf16_t* O; float* flog;
    __device__ __forceinline__ void operator()(const f32x4 (&acc)[2][2][4][2], const Unit& u, int wr, int wc, int fr, int fq) const {
        constexpr int ldc = 7168; const int row0 = u.pm * BM + wr * 64 + fr, col0 = u.pn * BM + wc * 32 + 8 * fq;
#pragma unroll
        for (int ai = 0; ai < 2; ++ai)
#pragma unroll
            for (int m = 0; m < 4; ++m) { bf16_t* rowp = O + (size_t)(row0 + ai * HALF + m * 16) * ldc + col0;
#pragma unroll
                for (int bj = 0; bj < 2; ++bj) { const f32x4 v0 = acc[ai][bj][m][0], v1 = acc[ai][bj][m][1];
                    u32x4 w; w.x = cvt_pk_bf16(v0[0], v0[1]); w.y = cvt_pk_bf16(v0[2], v0[3]); w.z = cvt_pk_bf16(v1[0], v1[1]); w.w = cvt_pk_bf16(v1[2], v1[3]);
                    __builtin_nontemporal_store(w, (u32x4*)(rowp + bj * HALF));
                    if (bj == 1 && col0 + HALF == 7040) { float* fp = flog + (size_t)(row0 + ai * HALF + m * 16) * 8; *(f32x4*)fp = v0; *(f32x4*)(fp + 4) = v1; } } }
    }
};
struct EpiResid {
    static constexpr bool PERM = false, AFTER_DRAIN = false;
    float* X; const float* Xs; const float* st; const float* g; const float* b; static constexpr int ldc = 2048;     static constexpr float alpha = 1.681792830507429f;
    __device__ __forceinline__ void operator()(const f32x4 (&acc)[2][2][4][2], const Unit& u, int wr, int wc, int fr, int fq) const {
        const int row0 = u.pm * BM + wr * 64 + fr, col0 = u.pn * BM + wc * 32 + 4 * fq;
        f32x4 gv[2][2], bv[2][2];
#pragma unroll
        for (int bj = 0; bj < 2; ++bj)
#pragma unroll
            for (int n = 0; n < 2; ++n) { gv[bj][n] = *(const f32x4*)(g + col0 + bj * HALF + n * 16); bv[bj][n] = *(const f32x4*)(b + col0 + bj * HALF + n * 16); }
#pragma unroll
        for (int ai = 0; ai < 2; ++ai)
#pragma unroll
            for (int m = 0; m < 4; ++m) { const int row = row0 + ai * HALF + m * 16; float* rowp = X + (size_t)row * ldc + col0;
                const f32x2 s2 = *(const f32x2*)(st + 2 * (size_t)row); const float mean = s2.x, rstd = s2.y;
#pragma unroll
                for (int bj = 0; bj < 2; ++bj)
#pragma unroll
                    for (int n = 0; n < 2; ++n) { f32x4* q = (f32x4*)(rowp + bj * HALF + n * 16); const f32x4 xo = __builtin_nontemporal_load((const f32x4*)(Xs + (size_t)row * ldc + col0 + bj * HALF + n * 16)); const f32x4 xn = (xo - mean) * rstd * gv[bj][n] + bv[bj][n]; *q = xn * alpha + acc[ai][bj][m][n]; } }
    }
};
}
#ifndef PG8_SP2
#define PG8_SP2 true
#endif
#ifndef PG8_ALIGN
#define PG8_ALIGN true
#endif
namespace fox {
constexpr int D = 128;
constexpr int LDQ = 7168;
constexpr int LDO = 2048;
constexpr float THR = 8.f;
constexpr bool WSKIP = false;
constexpr float SCALE = 0.08838834764831845f;
constexpr int NW = 8, QBLK = 32, KVBLK = 64, QB = NW * QBLK;
constexpr int SHM_V = KVBLK * D * 2, SHM_K = KVBLK * D * 2;
constexpr int CB_OFF = 2 * SHM_V + 2 * SHM_K + NW * 64 * 4;
constexpr int QL_OFF = 69632;
constexpr int LDS_BYTES = QL_OFF + NW * QBLK * 256;
static_assert(CB_OFF + 2 * 64 * 4 <= QL_OFF, "attention LDS map");
using bf16 = __hip_bfloat16;
typedef short bf16x8 __attribute__((ext_vector_type(8)));
typedef short s16x4 __attribute__((ext_vector_type(4)));
typedef float f32x16 __attribute__((ext_vector_type(16)));
typedef float f32x4 __attribute__((ext_vector_type(4)));
typedef unsigned u32x4 __attribute__((ext_vector_type(4)));
template <class A, class Bt> struct same_t { static constexpr bool v = false; };
template <class A> struct same_t<A, A> { static constexpr bool v = true; };

#define KSWZ(row, colB) ((row) * 256 + ((colB) ^ (((row) & 7) << 4)))
#define SBAR() __builtin_amdgcn_sched_barrier(0)
__device__ __forceinline__ int v_st(int k, int c) { const int kk = (k & ~0xC) | ((k & 4) << 1) | ((k & 8) >> 1); return ((kk >> 3) * 4 + (c >> 5)) * 512 + ((kk & 7) * 32 + (c & 31)) * 2; }
__device__ __forceinline__ int v_rd_base(int lane) { return ((lane & 3) << 3) | (((lane >> 2) & 3) << 6) | (((lane >> 4) & 1) << 5) | (((lane >> 5) & 1) << 8); }
constexpr int v_rd_off(int d0, int ks, int half) { return d0 * 512 + ks * 4096 + half * 2048; }
__device__ __forceinline__ int crow(int r, int hi) { return (r & 3) + 8 * (r >> 2) + 4 * hi; }
__device__ __forceinline__ unsigned cvtpk(float lo, float hi) {
    unsigned r; asm volatile("v_cvt_pk_bf16_f32 %0, %1, %2" : "=v"(r) : "v"(lo), "v"(hi)); return r;
}
__device__ __forceinline__ bf16x8 pack8(f32x4 a, f32x4 b) {
    u32x4 w = {cvtpk(a[0], a[1]), cvtpk(a[2], a[3]), cvtpk(b[0], b[1]), cvtpk(b[2], b[3])};
    return *reinterpret_cast<bf16x8*>(&w);
}
template <class T> __device__ __forceinline__ bf16x8 load8(const T* p) {
    if constexpr (same_t<T, float>::v) { return pack8(*(const f32x4*)p, *(const f32x4*)(p + 4)); }
    else { return *reinterpret_cast<const bf16x8*>(p); }
}
__device__ __forceinline__ void mask_tile(f32x16& p0, f32x16& p1, int dq, unsigned W) {
    const float NEG = -__builtin_inff();
#pragma unroll
    for (int r = 0; r < 16; ++r) {
        const int c = (r & 3) + 8 * (r >> 2);
        if ((unsigned)(dq - c) >= W) p0[r] = NEG;
        if ((unsigned)(dq - c - 32) >= W) p1[r] = NEG;
    }
}
__device__ __forceinline__ void partialSM(f32x16& p0, f32x16& p1, float& m_reg, float& mn, float& alpha) {
    float pmax = p0[0]; for (int r = 1; r < 16; ++r) pmax = fmaxf(pmax, p0[r]); for (int r = 0; r < 16; ++r) pmax = fmaxf(pmax, p1[r]);
    { auto rr = __builtin_amdgcn_permlane32_swap(__float_as_uint(pmax), __float_as_uint(pmax), false, false);
      pmax = fmaxf(__uint_as_float(rr[0]), __uint_as_float(rr[1])); }
    constexpr float C2 = 1.4426950408889634f * SCALE;
    if (__builtin_expect(__all((pmax - m_reg) * SCALE <= THR), 1)) { mn = m_reg; alpha = 1.f; }
    else { mn = fmaxf(m_reg, pmax); alpha = __builtin_amdgcn_exp2f((m_reg - mn) * C2); m_reg = mn; }
    const float mnL = -mn * C2;
    for (int r = 0; r < 16; ++r) p0[r] = fmaf(p0[r], C2, mnL); for (int r = 0; r < 16; ++r) p1[r] = fmaf(p1[r], C2, mnL);
    for (int r = 0; r < 16; ++r) p0[r] = __builtin_amdgcn_exp2f(p0[r]);
}
__device__ __forceinline__ void finishSM(f32x16& p0, f32x16& p1, float alpha, float& l_reg, bf16x8& pa0, bf16x8& pa1, bf16x8& pa2, bf16x8& pa3) {
    for (int r = 0; r < 16; ++r) p1[r] = __builtin_amdgcn_exp2f(p1[r]);
    float ps = 0; for (int r = 0; r < 16; ++r) ps += p0[r]; for (int r = 0; r < 16; ++r) ps += p1[r];
    { auto rr = __builtin_amdgcn_permlane32_swap(__float_as_uint(ps), __float_as_uint(ps), false, false);
      ps = __uint_as_float(rr[0]) + __uint_as_float(rr[1]); }
    l_reg = l_reg * alpha + ps;
#define PK4(P, B_, OUT) do { unsigned a0 = cvtpk(P[B_+0], P[B_+1]), a1 = cvtpk(P[B_+2], P[B_+3]);                          \
        unsigned b0 = cvtpk(P[B_+4], P[B_+5]), b1 = cvtpk(P[B_+6], P[B_+7]);                                             \
        auto r0 = __builtin_amdgcn_permlane32_swap(a0, b0, false, false); auto r1 = __builtin_amdgcn_permlane32_swap(a1, b1, false, false); \
        u32x4 w = {r0[0], r1[0], r0[1], r1[1]}; OUT = *reinterpret_cast<bf16x8*>(&w); } while (0)
    PK4(p0, 0, pa0); PK4(p0, 8, pa1); PK4(p1, 0, pa2); PK4(p1, 8, pa3);
#undef PK4
}
template <int KB, bool SK>
__device__ __forceinline__ void qkt(f32x16& p0, f32x16& p1, const char* K_lds, int r32, int hi, const char* Q_w, bool act) {
    const float* cbp = (const float*)(K_lds + 2 * SHM_K + NW * 64 * 4) + KB * 64;
    if (SK && !act) { const float NEG = -__builtin_inff();
#pragma unroll
        for (int r = 0; r < 16; ++r) { p0[r] = NEG; p1[r] = NEG; } return; }
    {
      const float c0 = cbp[r32], c1 = cbp[32 + r32];
      const unsigned u0 = __float_as_uint(c0), h0 = u0 & 0xffff0000u; const float r0 = c0 - __uint_as_float(h0); const unsigned m0 = __float_as_uint(r0) & 0xffff0000u; const unsigned l0 = __float_as_uint(r0 - __uint_as_float(m0));
      const unsigned u1 = __float_as_uint(c1), h1 = u1 & 0xffff0000u; const float r1 = c1 - __uint_as_float(h1); const unsigned m1 = __float_as_uint(r1) & 0xffff0000u; const unsigned l1 = __float_as_uint(r1 - __uint_as_float(m1));
      const u32x4 a0 = {(h0 >> 16) | m0, l0 >> 16, 0u, 0u}, a1 = {(h1 >> 16) | m1, l1 >> 16, 0u, 0u};
      const unsigned on = hi == 0 ? 0x3f803f80u : 0u; const u32x4 ones = {on, on, 0u, 0u};
      p0 = __builtin_amdgcn_mfma_f32_32x32x16_bf16(*reinterpret_cast<const bf16x8*>(&a0), *reinterpret_cast<const bf16x8*>(&ones), f32x16{}, 0, 0, 0);
      p1 = __builtin_amdgcn_mfma_f32_32x32x16_bf16(*reinterpret_cast<const bf16x8*>(&a1), *reinterpret_cast<const bf16x8*>(&ones), f32x16{}, 0, 0, 0); }
    const char* kb[4]; const char* qb[4];
#pragma unroll
    for (int dd = 0; dd < 4; ++dd) { kb[dd] = K_lds + KB * SHM_K + KSWZ(r32, (dd * 16 + hi * 8) * 2); qb[dd] = Q_w + KSWZ(r32, (dd * 16 + hi * 8) * 2); }
#pragma unroll
    for (int d0 = 0; d0 < 8; ++d0) { const char* a = kb[d0 & 3] + (d0 >> 2) * 128;
        bf16x8 b0 = *reinterpret_cast<const bf16x8*>(a);
        bf16x8 b1 = *reinterpret_cast<const bf16x8*>(a + 32 * 256);
        const bf16x8 qf = *reinterpret_cast<const bf16x8*>(qb[d0 & 3] + (d0 >> 2) * 128);
        p0 = __builtin_amdgcn_mfma_f32_32x32x16_bf16(b0, qf, p0, 0, 0, 0);
        p1 = __builtin_amdgcn_mfma_f32_32x32x16_bf16(b1, qf, p1, 0, 0, 0); }
}
template <int VB, bool SK>
__device__ __forceinline__ void pv_tile(f32x16* o, int vb0, bf16x8 pa0, bf16x8 pa1, bf16x8 pa2, bf16x8 pa3, bool act) {
    if (SK && !act) return;
#define TRRD(dst, off) asm volatile("ds_read_b64_tr_b16 %0, %1 offset:%2" : "=&v"(dst) : "v"(vb0), "i"(off) : "memory")
#define PV_D0(d0) do { s16x4 l0, l1, l2, l3, h0, h1, h2, h3; constexpr int b_ = VB * SHM_V + v_rd_off(d0, 0, 0);     \
        TRRD(l0, b_); TRRD(h0, b_ + 2048); TRRD(l1, b_ + 4096); TRRD(h1, b_ + 6144); TRRD(l2, b_ + 8192); TRRD(h2, b_ + 10240); TRRD(l3, b_ + 12288); TRRD(h3, b_ + 14336); \
        asm volatile("s_waitcnt lgkmcnt(0)" ::: "memory"); SBAR();                 \
        o[d0] = __builtin_amdgcn_mfma_f32_32x32x16_bf16(pa0, (bf16x8){l0[0], l0[1], l0[2], l0[3], h0[0], h0[1], h0[2], h0[3]}, o[d0], 0, 0, 0);   \
        o[d0] = __builtin_amdgcn_mfma_f32_32x32x16_bf16(pa1, (bf16x8){l1[0], l1[1], l1[2], l1[3], h1[0], h1[1], h1[2], h1[3]}, o[d0], 0, 0, 0);   \
        o[d0] = __builtin_amdgcn_mfma_f32_32x32x16_bf16(pa2, (bf16x8){l2[0], l2[1], l2[2], l2[3], h2[0], h2[1], h2[2], h2[3]}, o[d0], 0, 0, 0);   \
        o[d0] = __builtin_amdgcn_mfma_f32_32x32x16_bf16(pa3, (bf16x8){l3[0], l3[1], l3[2], l3[3], h3[0], h3[1], h3[2], h3[3]}, o[d0], 0, 0, 0); } while (0)
    PV_D0(0); PV_D0(1); PV_D0(2); PV_D0(3);
#undef PV_D0
#undef TRRD
}

template <class TIn, class TOut> struct BlockRef { const TIn* Q; const TIn* K; const TIn* V; TOut* O; const float* C; int P0; int JLO; };
template <class TIn> struct Seam {
    bf16x8 qr[8];
    bf16x8 st_v0, st_v1, st_k0, st_k1; f32x4 sf0, sf1, sf2, sf3; float st_c; int wv; int jlo;
    f32x4 tq[16];
};
__device__ __forceinline__ int swa_jlo(int P0, int W) { const int lowk = P0 - W + 1; return lowk > 0 ? lowk / KVBLK : 0; }
#define ROW(p, k0, rr) ((p) + (size_t)((k0) + (rr)) * LDQ + sc)
#define VMW() asm volatile("s_waitcnt vmcnt(0)" ::: "memory")
#define VMWN(n) asm volatile("s_waitcnt vmcnt(%0)" :: "i"(n) : "memory")
#define SLOAD_H(Kp, Vp, Cp, k0) do { S.st_v0 = load8<TIn>(ROW(Vp, k0, sr)); S.st_v1 = load8<TIn>(ROW(Vp, k0, 32 + sr));              \
                         S.st_k0 = load8<TIn>(ROW(Kp, k0, sr)); S.st_k1 = load8<TIn>(ROW(Kp, k0, 32 + sr)); if (tid < 64) S.st_c = (Cp)[(k0) + tid]; } while (0)
#define SWRITE_HK(bf) do { *(bf16x8*)(K_lds + (bf) * SHM_K + kws) = S.st_k0; *(bf16x8*)(K_lds + (bf) * SHM_K + kws + 32 * 256) = S.st_k1; if (tid < 64) ((float*)(lds + CB_OFF))[(bf) * 64 + tid] = S.st_c; } while (0)
#define SWRITE_HV(bf) do { *(bf16x8*)(V_lds + (bf) * SHM_V + vst0) = S.st_v0; *(bf16x8*)(V_lds + (bf) * SHM_V + vst1) = S.st_v1; } while (0)
#define SWRITE_H(bf) do { SWRITE_HV(bf); SWRITE_HK(bf); } while (0)
#define SLOAD_F(p, k0) do { S.sf0 = *(const f32x4*)ROW(p, k0, sr); S.sf1 = *(const f32x4*)(ROW(p, k0, sr) + 4);                \
                            S.sf2 = *(const f32x4*)ROW(p, k0, 32 + sr); S.sf3 = *(const f32x4*)(ROW(p, k0, 32 + sr) + 4); } while (0)
#define SWRITE_KF(bf) do { *(bf16x8*)(K_lds + (bf) * SHM_K + kws) = pack8(S.sf0, S.sf1); *(bf16x8*)(K_lds + (bf) * SHM_K + kws + 32 * 256) = pack8(S.sf2, S.sf3); } while (0)
#define SWRITE_VF(bf) do { *(bf16x8*)(V_lds + (bf) * SHM_V + vst0) = pack8(S.sf0, S.sf1); *(bf16x8*)(V_lds + (bf) * SHM_V + vst1) = pack8(S.sf2, S.sf3); } while (0)
template <class TIn, class TOut>
__device__ __forceinline__ void causal_swa_prime(const BlockRef<TIn, TOut>& cur, int W, char* lds, Seam<TIn>& S) {
    constexpr bool F32 = same_t<TIn, float>::v;
    const int tid = otid(S.wv), wid = __builtin_amdgcn_readfirstlane(tid >> 6), lane = tid & 63, r32 = lane & 31, hi = lane >> 5;
    const int sr = tid >> 4, sc = (tid & 15) * 8, kws = KSWZ(sr, sc * 2); char* K_lds = lds + 2 * SHM_V;
    const int kb0 = cur.JLO * KVBLK; S.jlo = cur.JLO;
    for (int d0 = 0; d0 < 8; ++d0) S.qr[d0] = load8<TIn>(cur.Q + (size_t)(wid * QBLK + r32) * LDQ + d0 * 16 + hi * 8);
    if constexpr (F32) { SLOAD_F((const float*)cur.K, kb0); VMW(); SWRITE_KF(0); SBAR(); SLOAD_F((const float*)cur.V, kb0); }
    else { SLOAD_H(cur.K, cur.V, cur.C, kb0); VMW(); SWRITE_HK(0); }
    __syncthreads();
}
template <class TIn, class TOut, class RF>
__device__ __forceinline__ void causal_swa_block(int it_cur, int it_nxt, const RF& rf, int skv, int W, char* lds, Seam<TIn>& S) {
    const BlockRef<TIn, TOut> cur = rf(it_cur);
    constexpr bool F32 = same_t<TIn, float>::v;
    const int tid = otid(S.wv), wid = __builtin_amdgcn_readfirstlane(tid >> 6), lane = tid & 63, r32 = lane & 31, hi = lane >> 5;
    const int j_lo = S.jlo;
    int j_hi = (cur.P0 + QB - 1) / KVBLK + 1; if (j_hi > skv / KVBLK) j_hi = skv / KVBLK;
    const int NT = j_hi - j_lo;
    const int qlo = cur.P0 + wid * QBLK, qm = qlo + r32 - 4 * hi;
    char* V_lds = lds; char* K_lds = lds + 2 * SHM_V;
    float* ws = (float*)(lds + 2 * SHM_V + 2 * SHM_K) + wid * 64; float* li_l = ws, * al_l = ws + 32;
    float m_reg = -1e30f, l_reg = 0; f32x16 o[4] = {};
    char* Q_w = lds + QL_OFF + wid * (QBLK * 256);
#pragma unroll
    for (int d0 = 0; d0 < 8; ++d0) *reinterpret_cast<bf16x8*>(Q_w + KSWZ(r32, (d0 * 16 + hi * 8) * 2)) = S.qr[d0];
    const int sr = tid >> 4, sc = (tid & 15) * 8, vst0 = v_st(sr, sc), vst1 = v_st(32 + sr, sc), kws = KSWZ(sr, sc * 2);
    const int vb0 = (int)(uintptr_t)V_lds + v_rd_base(lane);
    const TIn* Kh = cur.K; const TIn* Vh = cur.V; const float* Ch = cur.C;
#define RESC(a) do { if (__any((a) < 1.f)) { if (hi == 0) al_l[r32] = (a); asm volatile("s_waitcnt lgkmcnt(0)" ::: "memory");              \
                     for (int d_ = 0; d_ < 4; ++d_) for (int r = 0; r < 16; ++r) o[d_][r] *= al_l[crow(r, hi)]; } } while (0)
#define KBASE(t) ((j_lo + (t)) * KVBLK)
#define ACT(t) (KBASE(t) <= qlo + QBLK - 1 && KBASE(t) + KVBLK - 1 >= qlo - W + 1)
#define MASKT(P0_, P1_, t) do { const int kb_ = KBASE(t); if ((!SK || ACT(t)) && (kb_ + KVBLK - 1 > qlo || kb_ <= qlo + QBLK - 1 - W)) mask_tile(P0_, P1_, qm - kb_, (unsigned)W); } while (0)
    constexpr int NQL = F32 ? 16 : 8;
    constexpr bool SK = WSKIP && !F32;
#define SEAM_K0() do { VMWN(NQL); if constexpr (F32) { SWRITE_KF(0); SBAR(); SLOAD_F((const float*)nxt.V, kbn); } else { SWRITE_HK(0); } SBAR(); } while (0)
    f32x16 pA0, pA1, pB0, pB1; float mnA, mnB, alA, alB; bf16x8 pa0, pa1, pa2, pa3;
    if constexpr (F32) { VMW(); SWRITE_VF(0); SBAR(); } else { SWRITE_HV(0); SBAR(); }
    if (NT > 1) { if constexpr (F32) SLOAD_F((const float*)Kh, KBASE(1)); else SLOAD_H(Kh, Vh, Ch, KBASE(1)); }
    SBAR(); qkt<0, SK>(pA0, pA1, K_lds, r32, hi, Q_w, ACT(0));
    if constexpr (F32) { if (NT > 1) { VMW(); SWRITE_KF(1); SBAR(); SLOAD_F((const float*)Vh, KBASE(1)); } }
    MASKT(pA0, pA1, 0); partialSM(pA0, pA1, m_reg, mnA, alA);
    if (NT > 1) { VMW(); if constexpr (F32) { SWRITE_VF(1); SBAR(); if (NT > 2) SLOAD_F((const float*)Kh, KBASE(2)); } else SWRITE_H(1); }
    __syncthreads();
#define HALF_STEP(PX0, PX1, mnX, alX, PY0, PY1, alY, t, KB, VB, SB) do {                                                      \
        SBAR(); qkt<KB, SK>(PX0, PX1, K_lds, r32, hi, Q_w, ACT(t));                                             \
        finishSM(PY0, PY1, alY, l_reg, pa0, pa1, pa2, pa3); SBAR();                                                           \
        if ((t) + 1 < NT) { if constexpr (F32) { VMW(); SWRITE_KF(SB); SBAR(); SLOAD_F((const float*)Vh, KBASE((t) + 1)); }  \
                            else { SLOAD_H(Kh, Vh, Ch, KBASE((t) + 1)); } SBAR(); }                                               \
        pv_tile<VB, SK>(o, vb0, pa0, pa1, pa2, pa3, ACT((t) - 1)); MASKT(PX0, PX1, (t)); partialSM(PX0, PX1, m_reg, mnX, alX);                                        \
        __syncthreads();                                                                                                      \
        if ((t) + 1 < NT) { VMW(); if constexpr (F32) { SWRITE_VF(SB); SBAR(); if ((t) + 2 < NT) SLOAD_F((const float*)Kh, KBASE((t) + 2)); } \
                            else { SWRITE_H(SB); } }                                                                          \
        RESC(alX); __syncthreads(); } while (0)
    for (int t = 1; t + 1 < NT; t += 2) {
        HALF_STEP(pB0, pB1, mnB, alB, pA0, pA1, alA, t, 1, 0, 0);
        HALF_STEP(pA0, pA1, mnA, alA, pB0, pB1, alB, t + 1, 0, 1, 1);
    }
    const bool even = (NT & 1) == 0;
    if (even) { SBAR(); qkt<1, SK>(pB0, pB1, K_lds, r32, hi, Q_w, ACT(NT - 1)); SBAR(); }
    int itn_ = it_nxt; asm volatile("; late nxt" : "+s"(itn_)); const BlockRef<TIn, TOut> nxt = rf(itn_); const int kbn = nxt.JLO * KVBLK; S.jlo = nxt.JLO;
#define QROW(e) (nxt.Q + (size_t)(wid * QBLK + r32) * LDQ + ((e) >> 1) * 16 + hi * 8 + ((e) & 1) * 4)
    if constexpr (F32) { SLOAD_F((const float*)nxt.K, kbn); SBAR();
#pragma unroll
        for (int e = 0; e < 8; ++e) S.tq[e] = *(const f32x4*)QROW(e); }
    else { SLOAD_H(nxt.K, nxt.V, nxt.C, kbn); SBAR();
#pragma unroll
        for (int d0 = 0; d0 < 8; ++d0) S.qr[d0] = load8<TIn>(nxt.Q + (size_t)(wid * QBLK + r32) * LDQ + d0 * 16 + hi * 8); }
    SBAR();
    finishSM(pA0, pA1, alA, l_reg, pa0, pa1, pa2, pa3); SBAR();
    if constexpr (F32) {
#pragma unroll
        for (int e = 8; e < 16; ++e) S.tq[e] = *(const f32x4*)QROW(e); SBAR(); }
#undef QROW
    pv_tile<0, SK>(o, vb0, pa0, pa1, pa2, pa3, ACT(even ? NT - 2 : NT - 1));
    if (even) { MASKT(pB0, pB1, NT - 1); partialSM(pB0, pB1, m_reg, mnB, alB); __syncthreads(); RESC(alB);
        finishSM(pB0, pB1, alB, l_reg, pa0, pa1, pa2, pa3); SBAR(); pv_tile<1, SK>(o, vb0, pa0, pa1, pa2, pa3, ACT(NT - 1)); }
    SBAR(); SEAM_K0();
    if (hi == 0) li_l[r32] = l_reg; asm volatile("s_waitcnt lgkmcnt(0)" ::: "memory");
    float rli[16];
#pragma unroll
    for (int r = 0; r < 16; ++r) rli[r] = __builtin_amdgcn_rcpf(li_l[crow(r, hi)]);
    int itc_ = it_cur; asm volatile("; late cur" : "+s"(itc_)); TOut* Ow = rf(itc_).O + (size_t)(wid * QBLK) * LDO;
#pragma unroll
    for (int r = 0; r < 16; ++r) { const int orow = crow(r, hi);
#pragma unroll
        for (int d0 = 0; d0 < 4; ++d0) { const float v = o[d0][r] * rli[r];
            if constexpr (same_t<TOut, float>::v) { Ow[(size_t)orow * LDO + d0 * 32 + r32] = v; }
            else { const float vn = __int_as_float(__builtin_amdgcn_update_dpp(0, __float_as_int(v), 0xB1, 0xF, 0xF, true));
                   if ((r32 & 1) == 0) *(unsigned*)(Ow + (size_t)orow * LDO + d0 * 32 + r32) = cvtpk(v, vn); } } }
    if constexpr (F32) {
#pragma unroll
        for (int d0 = 0; d0 < 8; ++d0) S.qr[d0] = pack8(S.tq[2 * d0], S.tq[2 * d0 + 1]); }
    __syncthreads();
#undef RESC
#undef KBASE
#undef ACT
#undef MASKT
#undef SEAM_K0
#undef HALF_STEP
}
#undef ROW
#undef VMW
#undef VMWN
#undef SLOAD_H
#undef SWRITE_HK
#undef SWRITE_HV
#undef SWRITE_H
#undef SLOAD_F
#undef SWRITE_KF
#undef SWRITE_VF
}
#define GAS __attribute__((address_space(1)))
#define LAS __attribute__((address_space(3)))
typedef unsigned short bf16_t;
typedef short bf16x8 __attribute__((ext_vector_type(8)));
typedef float f32x4 __attribute__((ext_vector_type(4)));
typedef float f32x2 __attribute__((ext_vector_type(2)));
typedef unsigned u32x4 __attribute__((ext_vector_type(4)));
typedef unsigned u32x2 __attribute__((ext_vector_type(2)));
typedef _Float16 h16x8 __attribute__((ext_vector_type(8)));
typedef GAS unsigned gu32;
typedef GAS unsigned long long gu64;
#define RLX_AGENT __ATOMIC_RELAXED, __HIP_MEMORY_SCOPE_AGENT

constexpr int NB = 4, SEQ = 8192, DM = 2048, DEPTH = 4, DFF = 8192;
constexpr int M = NB * SEQ;
constexpr int PIN = 7046, PINP = 7168;
constexpr int FOXH = 6, RWH = 10, RETH = 5;
constexpr int C_FQ = 0, C_FK = 768, C_FV = 1536, C_RW = 2304  , C_RR = 2304, C_RK = 2944, C_RV = 3584, C_WD = 4224, C_AD = 4288, C_GD = 4352,
              C_TQ = 4480, C_TK = 5120, C_TV = 5760, C_TG = 6400, C_FF = 7040;
constexpr int MIX_FOX = 0, MIX_RW = 768, MIX_RET = 1408;
constexpr float ALPHA = 1.681792830507429f;
constexpr float LN_EPS = 1e-5f, RWKV_GN_EPS = 64e-5f, RET_GN_EPS = 1e-5f;

constexpr size_t MiB = 1u << 20;
constexpr size_t WS_CTL = 0, CTL_BYTES = 1 * MiB;
constexpr size_t WS_CS = WS_CTL + CTL_BYTES;
constexpr size_t WS_FOXC = WS_CS + 4 * MiB;
constexpr size_t WS_BONUS = WS_FOXC + 1 * MiB;
constexpr size_t WS_WIN = WS_BONUS + 2 * MiB;
constexpr size_t WS_WOUT = WS_WIN + 28 * MiB;
constexpr size_t WS_WUP = WS_WOUT + 8 * MiB;
constexpr size_t WS_WDN = WS_WUP + 32 * MiB;
constexpr size_t WS_XB = WS_WDN + 32 * MiB;
constexpr size_t WS_YRAW = WS_XB + 128 * MiB;
constexpr size_t WS_H = WS_YRAW + 80 * MiB;
constexpr size_t WS_SCAN = WS_H + 448 * MiB;
constexpr size_t WS_HID = WS_H;
constexpr size_t WS_KV = WS_SCAN + 245 * MiB;
constexpr size_t WS_STATS = WS_KV + 40 * MiB;
constexpr size_t WS_FLOG = WS_STATS + 1 * MiB;
constexpr size_t WS_END = WS_FLOG + 1 * MiB;
static_assert(WS_HID + 512 * MiB <= WS_END, "hid overlay");

constexpr int CW_BAR = 0;
constexpr int CW_QATT = 4096;

constexpr int LDS_BYTES = 147456;
constexpr int MISC_OFF = LDS_BYTES - 256;
constexpr int NTHR = 512;

__device__ __forceinline__ float bf2f(bf16_t x) { return __uint_as_float(((unsigned)x) << 16); }
__device__ __forceinline__ unsigned f2bf(float f) { unsigned u = __float_as_uint(f); return (u + 0x7fffu + ((u >> 16) & 1u)) >> 16; }
__device__ __forceinline__ unsigned pk2(float lo, float hi) { return f2bf(lo) | (f2bf(hi) << 16); }
template <int CTRL> __device__ __forceinline__ float dpp_add(float x) {
    const int y = __builtin_amdgcn_update_dpp(0, __float_as_int(x), CTRL, 0xF, 0xF, true); return x + __int_as_float(y);
}
__device__ __forceinline__ float row16_sum(float x) {
    x = dpp_add<0xB1>(x); x = dpp_add<0x4E>(x); x = dpp_add<0x141>(x); x = dpp_add<0x140>(x); return x;
}
__device__ __forceinline__ float rl(float x, int l) { return __int_as_float(__builtin_amdgcn_readlane(__float_as_int(x), l)); }
__device__ __forceinline__ float wave_sum(float v) { v = row16_sum(v); return (rl(v, 0) + rl(v, 16)) + (rl(v, 32) + rl(v, 48)); }
__device__ __forceinline__ float half_sum(float v, int lane) { v = row16_sum(v); const float a = rl(v, 0) + rl(v, 16), b = rl(v, 32) + rl(v, 48); return lane < 32 ? a : b; }
__device__ __forceinline__ float wave_incl_scan(float x, int lane) {
    x = dpp_add<0x111>(x); x = dpp_add<0x112>(x); x = dpp_add<0x114>(x); x = dpp_add<0x118>(x);
    const float r0 = rl(x, 15), r1 = rl(x, 31), r2 = rl(x, 47); const int row = lane >> 4;
    return x + (row > 0 ? r0 : 0.f) + (row > 1 ? r1 : 0.f) + (row > 2 ? r2 : 0.f);
}

#ifndef MK_RWKV_CHUNK
#define MK_RWKV_CHUNK 1
#endif
#ifndef MK_RWKV_SPLIT
#define MK_RWKV_SPLIT 1
#endif
struct Params {
    const float* in[23]; float* out; unsigned char* ws; int ph_lo, ph_hi;
};
typedef const __attribute__((address_space(4))) Params* CP;
struct PX { CP p; int wvs; __device__ __forceinline__ CP operator->() const { return p; } };

__device__ __forceinline__ int win_src(int n) { return n < C_RW ? n : (n < C_FF ? n + 6 : (n < C_FF + 6 ? n - C_FF + 2304 : -1)); }
template <bool MAPPED>
__device__ __forceinline__ void convert_tile(const int wvs, const float* W, int ldw, bf16_t* Wt, int K, int n0, int k0, LAS float* T) {
    const int tid = otid(wvs);
    if (MAPPED) {
#pragma unroll
        for (int i = 0; i < 8; ++i) { const int idx = tid + NTHR * i, r = idx >> 6, c = idx & 63; const int sn = win_src(n0 + c);
            T[r * 65 + c] = W[(size_t)(k0 + r) * ldw + (sn >= 0 ? sn : 0)] * (sn >= 0 ? 1.f : 0.f); }
    } else {
#pragma unroll
        for (int i = 0; i < 2; ++i) { const int idx = tid + NTHR * i, r = idx >> 4, c = (idx & 15) * 4; const f32x4 v = *(const f32x4*)(W + (size_t)(k0 + r) * ldw + n0 + c);
            T[r * 65 + c] = v[0]; T[r * 65 + c + 1] = v[1]; T[r * 65 + c + 2] = v[2]; T[r * 65 + c + 3] = v[3]; }
    }
    __syncthreads();
    { const int n = tid >> 3, kq = tid & 7; float v[8];
#pragma unroll
      for (int j = 0; j < 8; ++j) v[j] = T[(kq * 8 + j) * 65 + n];
      u32x4 w; w.x = pk2(v[0], v[1]); w.y = pk2(v[2], v[3]); w.z = pk2(v[4], v[5]); w.w = pk2(v[6], v[7]);
      *(u32x4*)(Wt + (size_t)(n0 + n) * K + k0 + kq * 8) = w; }
    __syncthreads();
}
template <bool MAPPED>
__device__ __forceinline__ void cv_load(const int tid, const float* W, int ldw, int n0, int k0, f32x4& a, f32x4& b) {
    if (MAPPED) {
        float v[8];
#pragma unroll
        for (int i = 0; i < 8; ++i) { const int idx = tid + NTHR * i, r = idx >> 6, c = idx & 63; const int sn = win_src(n0 + c);
            v[i] = __builtin_nontemporal_load(W + (size_t)(k0 + r) * ldw + (sn >= 0 ? sn : 0)) * (sn >= 0 ? 1.f : 0.f); }
        a = (f32x4){v[0], v[1], v[2], v[3]}; b = (f32x4){v[4], v[5], v[6], v[7]};
    } else {
        { const int r = tid >> 4, c = (tid & 15) * 4; a = __builtin_nontemporal_load((const f32x4*)(W + (size_t)(k0 + r) * ldw + n0 + c)); }
        { const int idx = tid + NTHR, r = idx >> 4, c = (idx & 15) * 4; b = __builtin_nontemporal_load((const f32x4*)(W + (size_t)(k0 + r) * ldw + n0 + c)); }
    }
}
template <bool MAPPED>
__device__ __forceinline__ void cv_stage(const int tid, LAS float* T, const f32x4 a, const f32x4 b) {
    if (MAPPED) {
#pragma unroll
        for (int i = 0; i < 8; ++i) { const int idx = tid + NTHR * i, r = idx >> 6, c = idx & 63; T[r * 65 + c] = i < 4 ? a[i & 3] : b[i & 3]; }
    } else {
        { const int r = tid >> 4, c = (tid & 15) * 4; T[r * 65 + c] = a[0]; T[r * 65 + c + 1] = a[1]; T[r * 65 + c + 2] = a[2]; T[r * 65 + c + 3] = a[3]; }
        { const int idx = tid + NTHR, r = idx >> 4, c = (idx & 15) * 4; T[r * 65 + c] = b[0]; T[r * 65 + c + 1] = b[1]; T[r * 65 + c + 2] = b[2]; T[r * 65 + c + 3] = b[3]; }
    }
}
__device__ __forceinline__ void cv_emit(const int tid, const LAS float* T, bf16_t* Wt, int K, int n0, int k0) {
    const int n = tid >> 3, kq = tid & 7; float v[8];
#pragma unroll
    for (int j = 0; j < 8; ++j) v[j] = T[(kq * 8 + j) * 65 + n];
    u32x4 w; w.x = pk2(v[0], v[1]); w.y = pk2(v[2], v[3]); w.z = pk2(v[4], v[5]); w.w = pk2(v[6], v[7]);
    *(u32x4*)(Wt + (size_t)(n0 + n) * K + k0 + kq * 8) = w;
}
struct CvSeg { const float* W; bf16_t* Wt; int ldw, K, lgk; };
template <bool MAPPED, typename DEC>
__device__ __forceinline__ void cv_run(const int tid, LAS float* T, const int total, DEC dec) {
    const int g = (int)gridDim.x; int u = (int)blockIdx.x;
    if (u >= total) return;
    f32x4 a0, b0, a1, b1;
    { const CvSeg s = dec(u); int uu = u; dec.local(uu); cv_load<MAPPED>(tid, s.W, s.ldw, (uu >> s.lgk) * 64, (uu & ((1 << s.lgk) - 1)) * 64, a0, b0); }
    { const int u1 = min(u + g, total - 1); const CvSeg s = dec(u1); int uu = u1; dec.local(uu); cv_load<MAPPED>(tid, s.W, s.ldw, (uu >> s.lgk) * 64, (uu & ((1 << s.lgk) - 1)) * 64, a1, b1); }
    for (;;) {
        cv_stage<MAPPED>(tid, T, a0, b0);
        { const int u2 = min(u + 2 * g, total - 1); const CvSeg s = dec(u2); int uu = u2; dec.local(uu); cv_load<MAPPED>(tid, s.W, s.ldw, (uu >> s.lgk) * 64, (uu & ((1 << s.lgk) - 1)) * 64, a0, b0); }
        __syncthreads();
        { const CvSeg s = dec(u); int uu = u; dec.local(uu); cv_emit(tid, T, s.Wt, s.K, (uu >> s.lgk) * 64, (uu & ((1 << s.lgk) - 1)) * 64); }
        u += g; if (u >= total) break;
        cv_stage<MAPPED>(tid, T + 64 * 65, a1, b1);
        { const int u2 = min(u + 2 * g, total - 1); const CvSeg s = dec(u2); int uu = u2; dec.local(uu); cv_load<MAPPED>(tid, s.W, s.ldw, (uu >> s.lgk) * 64, (uu & ((1 << s.lgk) - 1)) * 64, a1, b1); }
        __syncthreads();
        { const CvSeg s = dec(u); int uu = u; dec.local(uu); cv_emit(tid, T + 64 * 65, s.Wt, s.K, (uu >> s.lgk) * 64, (uu & ((1 << s.lgk) - 1)) * 64); }
        u += g; if (u >= total) break;
    }
    __syncthreads();
}
__device__ __forceinline__ void phase_convert(PX p, int layer, LAS unsigned char* lds) {
    LAS float* T = (LAS float*)lds; const int tid = otid(p.wvs);
    constexpr int T_IN = (PINP / 64) * (DM / 64), T_OUT = (DM / 64) * (DM / 64), T_UP = (DFF / 64) * (DM / 64), T_DN = (DM / 64) * (DFF / 64);
    { struct D { const float* w; bf16_t* wt;
          __device__ __forceinline__ CvSeg operator()(int) const { return CvSeg{w, wt, PIN, DM, 5}; }
          __device__ __forceinline__ void local(int&) const {} } d{p->in[1] + (size_t)layer * DM * PIN, (bf16_t*)(p->ws + WS_WIN)};
      cv_run<true>(tid, T, T_IN, d); }
    { struct D { const float* w_out; const float* w_up; const float* w_dn; bf16_t* o; bf16_t* u; bf16_t* d;
          __device__ __forceinline__ CvSeg operator()(int t) const { return t < T_OUT ? CvSeg{w_out, o, DM, DM, 5} : (t < T_OUT + T_UP ? CvSeg{w_up, u, DFF, DM, 5} : CvSeg{w_dn, d, DM, DFF, 7}); }
          __device__ __forceinline__ void local(int& t) const { t -= t < T_OUT ? 0 : (t < T_OUT + T_UP ? T_OUT : T_OUT + T_UP); } }
          d{p->in[16] + (size_t)layer * DM * DM, p->in[19] + (size_t)layer * DM * DFF, p->in[20] + (size_t)layer * DFF * DM, (bf16_t*)(p->ws + WS_WOUT), (bf16_t*)(p->ws + WS_WUP), (bf16_t*)(p->ws + WS_WDN)};
      cv_run<false>(tid, T, T_OUT + T_UP + T_DN, d); }
}
__device__ __forceinline__ void phase_prologue(PX p) {
    const f32x4* x4 = (const f32x4*)p->in[0]; f32x4* o4 = (f32x4*)p->out; u32x2* xb = (u32x2*)(p->ws + WS_XB);
    const size_t n4 = (size_t)M * DM / 4, stride = (size_t)gridDim.x * NTHR;
    for (size_t i = (size_t)blockIdx.x * NTHR + otid(p.wvs); i < n4; i += stride) { const f32x4 v = __builtin_nontemporal_load(x4 + i); u32x2 w;     w.x = pk2(v[0], v[1]); w.y = pk2(v[2], v[3]); xb[i] = w; }
    { float* st = (float*)(p->ws + WS_STATS);
      for (size_t i = (size_t)blockIdx.x * NTHR + otid(p.wvs); i < (size_t)M; i += stride) *(f32x2*)(st + 4 * (size_t)M + 2 * i) = (f32x2){0.f, 1.f};
      for (size_t i = (size_t)blockIdx.x * NTHR + otid(p.wvs); i < (size_t)DM; i += stride) { st[6 * (size_t)M + i] = 1.f; st[6 * (size_t)M + DM + i] = 0.f; } }
    f32x2* cs = (f32x2*)(p->ws + WS_CS);
    for (size_t i = (size_t)blockIdx.x * NTHR + otid(p.wvs); i < (size_t)SEQ * 64; i += stride) {
        const int pos = (int)(i >> 6), j = (int)(i & 63);
        const float pw = (float)pow(10000.0, (double)((float)j / 64.0f)); const float inv = 1.0f / pw; const float ang = (float)pos * inv;
        cs[i] = (f32x2){(float)cos((double)ang), (float)sin((double)ang)};
    }
}

template <bool FULL>
__device__ __forceinline__ void phase_ln(PX p, const float* g, const float* b, float* stats) {
    const int tid = otid(p.wvs), lane = tid & 63, wv = tid >> 6; float* xf = p->out; bf16_t* xb = (bf16_t*)(p->ws + WS_XB);
    f32x4 gg[8], bb[8];
#pragma unroll
    for (int i = 0; i < 8; ++i) { gg[i] = *(const f32x4*)(g + i * 256 + lane * 4); bb[i] = *(const f32x4*)(b + i * 256 + lane * 4); }
    for (int row = M - 1 - (blockIdx.x * 8 + wv); row >= 0; row -= gridDim.x * 8) {
        float* xr = xf + (size_t)row * DM; f32x4 v[8]; float s = 0.f;
#pragma unroll
        for (int i = 0; i < 8; ++i) { v[i] = __builtin_nontemporal_load((const f32x4*)(xr + i * 256 + lane * 4)); s += (v[i][0] + v[i][1]) + (v[i][2] + v[i][3]); }
        const float mean = wave_sum(s) * (1.0f / DM); float q = 0.f;
#pragma unroll
        for (int i = 0; i < 8; ++i) { const f32x4 d = v[i] - mean; q += (d[0] * d[0] + d[1] * d[1]) + (d[2] * d[2] + d[3] * d[3]); }
        const float rstd = 1.0f / sqrtf(wave_sum(q) * (1.0f / DM) + LN_EPS);
        if (!FULL && lane == 0) *(f32x2*)(stats + 2 * (size_t)row) = (f32x2){mean, rstd};
#pragma unroll
        for (int i = 0; i < 8; ++i) { const f32x4 o = (v[i] - mean) * rstd * gg[i] + bb[i]; if (FULL) __builtin_nontemporal_store(o, (f32x4*)(xr + i * 256 + lane * 4));
            if (!FULL) { u32x2 w; w.x = pk2(o[0], o[1]); w.y = pk2(o[2], o[3]); *(u32x2*)(xb + (size_t)row * DM + i * 256 + lane * 4) = w; } }
    }
}

__device__ __forceinline__ float log_sigmoid(float x) { return fminf(x, 0.f) - log1pf(expf(-fabsf(x))); }
__device__ __forceinline__ void fox_scan_unit(PX p, int layer, int bh, LAS unsigned char* lds) {
    const int tid = otid(p.wvs), lane = tid & 63, wv = tid >> 6, b = bh / FOXH, hh = bh % FOXH;
    const bf16_t* H = (const bf16_t*)(p->ws + WS_H); float* C = (float*)(p->ws + WS_FOXC) + (size_t)bh * SEQ; LAS float* wsum = (LAS float*)lds;
    const float fb = p->in[2][layer * FOXH + hh];
    float v[16]; float run = 0.f; const float* FL = (const float*)(p->ws + WS_FLOG) + ((size_t)b * SEQ + tid * 16) * 8 + hh;
#pragma unroll
    for (int i = 0; i < 16; ++i) { run += log_sigmoid(FL[i * 8] + fb); v[i] = run; }
    const float inc = wave_incl_scan(run, lane);
    if (lane == 63) wsum[wv] = inc;
    __syncthreads();
    float base = inc - run;
    for (int w = 0; w < wv; ++w) base += wsum[w];
    __syncthreads();
#pragma unroll
    for (int i = 0; i < 16; ++i) C[tid * 16 + i] = -(base + v[i]) * (1.0f / fox::SCALE);
}
constexpr size_t FOX_QN = WS_FOXC + 768 * 1024, FOX_KN = FOX_QN + 4096;
__device__ __forceinline__ float row16_max(float x) {
    x = fmaxf(x, __int_as_float(__builtin_amdgcn_update_dpp(0, __float_as_int(x), 0xB1, 0xF, 0xF, true))); x = fmaxf(x, __int_as_float(__builtin_amdgcn_update_dpp(0, __float_as_int(x), 0x4E, 0xF, 0xF, true)));
    x = fmaxf(x, __int_as_float(__builtin_amdgcn_update_dpp(0, __float_as_int(x), 0x141, 0xF, 0xF, true))); x = fmaxf(x, __int_as_float(__builtin_amdgcn_update_dpp(0, __float_as_int(x), 0x140, 0xF, 0xF, true))); return x;
}
__device__ __forceinline__ void fox_norm_unit(PX p, int unit, LAS unsigned char* lds) {
    const int tid = otid(p.wvs), wv = tid >> 6, bh = unit / (SEQ / 256), qb = unit % (SEQ / 256), b = bh / FOXH, hh = bh % FOXH;
    const bf16_t* H = (const bf16_t*)(p->ws + WS_H); LAS float* red = (LAS float*)lds;
    const bf16_t* qr = H + ((size_t)b * SEQ + qb * 256 + (tid >> 1)) * PINP + C_FQ + hh * 128 + (tid & 1) * 64; const bf16_t* kr = qr + (C_FK - C_FQ);
    float sq = 0.f, sk = 0.f;
#pragma unroll
    for (int i = 0; i < 8; ++i) { const bf16x8 a = *(const bf16x8*)(qr + 8 * i), c = *(const bf16x8*)(kr + 8 * i);
#pragma unroll
        for (int j = 0; j < 8; ++j) { const float x = bf2f((bf16_t)a[j]), y = bf2f((bf16_t)c[j]); sq += x * x; sk += y * y; } }
    sq = dpp_add<0xB1>(sq); sk = dpp_add<0xB1>(sk);
    float mq = row16_max(sq), mk = row16_max(sk);
    mq = fmaxf(fmaxf(rl(mq, 0), rl(mq, 16)), fmaxf(rl(mq, 32), rl(mq, 48))); mk = fmaxf(fmaxf(rl(mk, 0), rl(mk, 16)), fmaxf(rl(mk, 32), rl(mk, 48)));
    __syncthreads();
    if ((tid & 63) == 0) { red[wv] = mq; red[8 + wv] = mk; }
    __syncthreads();
    if (tid == 0) { float a = red[0], c = red[8];
#pragma unroll
        for (int w = 1; w < 8; ++w) { a = fmaxf(a, red[w]); c = fmaxf(c, red[8 + w]); }
        ((float*)(p->ws + FOX_QN))[bh * 32 + qb] = sqrtf(a) * 1.01f; ((float*)(p->ws + FOX_KN))[bh * 32 + qb] = sqrtf(c) * 1.01f; }
}
__device__ __forceinline__ float tshift(float cur, float prev, float mu) { return cur + (prev - cur) * mu; }
__device__ __forceinline__ void rwkv_pre_unit(PX p, int layer, int unit, LAS unsigned char* lds) {
    const int tid = otid(p.wvs), lane = tid & 63, wv = tid >> 6;
    const int tile = unit % (SEQ / 64), hd = (unit / (SEQ / 64)) % RWH, b = unit / ((SEQ / 64) * RWH);
    const bf16_t* H = (const bf16_t*)(p->ws + WS_H); LAS float* TA = (LAS float*)lds;
    const float* mu = p->in[3] + (size_t)layer * 2176;
    const int s0 = tile * 64;
    { const int tt = tid >> 3, j0 = (tid & 7) * 16, s = s0 + tt; const size_t row = (size_t)b * SEQ + s;
      const bf16_t* hc = H + row * PINP + C_WD + j0; const bf16_t* hp = hc - PINP;
      bf16x8 c0 = *(const bf16x8*)hc, c1 = *(const bf16x8*)(hc + 8), p0 = {}, p1 = {};
      if (s > 0) { p0 = *(const bf16x8*)hp; p1 = *(const bf16x8*)(hp + 8); }
#pragma unroll
      for (int i = 0; i < 16; ++i) { const float cu = bf2f((bf16_t)(i < 8 ? c0[i] : c1[i - 8])), pr = bf2f((bf16_t)(i < 8 ? p0[i] : p1[i - 8]));
          const float x = tshift(cu, pr, mu[1920 + j0 + i]); const int j = j0 + i; TA[tt * 128 + j] = j < 64 ? tanhf(x) : x; } }
    __syncthreads();
    const int c = hd * 64 + lane;
    float wup[64], aup[64];
    { const float* wu = p->in[5] + (size_t)layer * 64 * 640 + c; const float* au = p->in[7] + (size_t)layer * 64 * 640 + c;
#pragma unroll
      for (int j = 0; j < 64; ++j) { wup[j] = wu[j * 640]; aup[j] = au[j * 640]; } }
    const float w0 = p->in[4][layer * 640 + c], a0 = p->in[6][layer * 640 + c], kkc = p->in[9][layer * 640 + c], kac = p->in[10][layer * 640 + c], rkc = p->in[11][layer * 640 + c];
    const float mur = mu[c], muk = mu[640 + c], muv = mu[1280 + c];
    _Float16* SC = (_Float16*)(p->ws + WS_SCAN); float* BON = (float*)(p->ws + WS_BONUS);
    for (int i = 0; i < 8; ++i) {
        const int tt = wv * 8 + i, s = s0 + tt; const size_t row = (size_t)b * SEQ + s; const bf16_t* hr = H + row * PINP;
        const float rc = bf2f(hr[C_RR + c]), kc = bf2f(hr[C_RK + c]), vc = bf2f(hr[C_RV + c]);
        float rp = 0.f, kp = 0.f, vp = 0.f; if (s > 0) { rp = bf2f(hr[C_RR + c - PINP]); kp = bf2f(hr[C_RK + c - PINP]); vp = bf2f(hr[C_RV + c - PINP]); }
        const float r = tshift(rc, rp, mur), k = tshift(kc, kp, muk), v = tshift(vc, vp, muv);
        float wl = w0, al = a0;
#pragma unroll
        for (int j = 0; j < 64; j += 4) { const f32x4 tw = *(const LAS f32x4*)(TA + tt * 128 + j), ta = *(const LAS f32x4*)(TA + tt * 128 + 64 + j);
            wl += tw[0] * wup[j] + tw[1] * wup[j + 1] + tw[2] * wup[j + 2] + tw[3] * wup[j + 3]; al += ta[0] * aup[j] + ta[1] * aup[j + 1] + ta[2] * aup[j + 2] + ta[3] * aup[j + 3]; }
        const float nx = -wl; const float sp = fmaxf(nx, 0.f) + log1pf(expf(-fabsf(nx)));
        const float w = -sp - 0.5f;
#if MK_RWKV_CHUNK
        const float w1m = -expf(w);
#else
        const float w1m = 1.0f - expf(-expf(w));
#endif
        const float a = 1.0f / (1.0f + expf(-al));
        const float kk = k * kkc; const float nrm = sqrtf(wave_sum(kk * kk)); const float kkn = kk / fmaxf(nrm, 1e-12f);
        const float k2 = k * (1.0f + (a - 1.0f) * kac);
        const float bon = wave_sum(r * k2 * rkc);
        _Float16* rec = SC + (((size_t)(b * RWH + hd) * SEQ + s) * 6) * 64 + lane;
        rec[0] = (_Float16)r; rec[64] = (_Float16)w1m; rec[128] = (_Float16)k2; rec[192] = (_Float16)(-kkn); rec[256] = (_Float16)(kkn * a); rec[320] = (_Float16)v;
        if (lane == 0) BON[row * 16 + hd] = bon;
    }
    __syncthreads();
}

__device__ __forceinline__ void rwkv_post_unit(PX p, int layer, int unit, LAS unsigned char* lds) {
    typedef float f32x4 __attribute__((ext_vector_type(4)));
    const int tid = otid(p.wvs), lane = tid & 63, wv = __builtin_amdgcn_readfirstlane(tid >> 6), l15 = lane & 15, qq = lane >> 4;
    const int tile = unit % (SEQ / 64), b = unit / (SEQ / 64);
    const bf16_t* H = (const bf16_t*)(p->ws + WS_H);
    LAS bf16_t* SG = (LAS bf16_t*)lds;
    LAS bf16_t* GU = (LAS bf16_t*)(lds + 17408);
    LAS float* GT = (LAS float*)(lds + 34816);
    const float* mu = p->in[3] + (size_t)layer * 2176;
    const int s0 = tile * 64;
    __syncthreads();
    { const int tt = tid >> 3, j0 = (tid & 7) * 16, s = s0 + tt; const size_t row = (size_t)b * SEQ + s;
      const bf16_t* hc = H + row * PINP + C_GD + j0; const bf16_t* hp = hc - PINP;
      const bf16_t* hq = s > 0 ? hp : hc; const float pm = s > 0 ? 1.f : 0.f;
      const bf16x8 c0 = *(const bf16x8*)hc, c1 = *(const bf16x8*)(hc + 8), p0 = *(const bf16x8*)hq, p1 = *(const bf16x8*)(hq + 8);
      float x[16];
#pragma unroll
      for (int i = 0; i < 16; ++i) { const float cu = bf2f((bf16_t)(i < 8 ? c0[i] : c1[i - 8])), pr = pm * bf2f((bf16_t)(i < 8 ? p0[i] : p1[i - 8]));
          x[i] = __builtin_amdgcn_rcpf(1.0f + __expf(-tshift(cu, pr, mu[2048 + j0 + i]))); }
      u32x4 w; w.x = pk2(x[0], x[1]); w.y = pk2(x[2], x[3]); w.z = pk2(x[4], x[5]); w.w = pk2(x[6], x[7]); *(LAS u32x4*)(SG + tt * 136 + j0) = w;
      w.x = pk2(x[8], x[9]); w.y = pk2(x[10], x[11]); w.z = pk2(x[12], x[13]); w.w = pk2(x[14], x[15]); *(LAS u32x4*)(SG + tt * 136 + j0 + 8) = w; }
    const float* BON = (const float*)(p->ws + WS_BONUS); const float* Y = (const float*)(p->ws + WS_YRAW); bf16_t* MIX = (bf16_t*)(p->ws + WS_XB);
    const size_t row0 = (size_t)b * SEQ + s0 + wv * 8;
    float y[8], bon[8], gu[16]; bf16x8 v8;
#define POST_LOAD(hd_) do { const int c_ = (hd_) * 64 + lane; \
        _Pragma("unroll") for (int i = 0; i < 8; ++i) { y[i] = Y[(row0 + i) * 640 + c_]; bon[i] = BON[(row0 + i) * 16 + (hd_)]; } \
        v8 = *(const bf16x8*)(p->ws + WS_SCAN + ((size_t)(b * RWH + (hd_)) * (SEQ / 16) + ((s0 + wv * 8) >> 4)) * 12544 + 10240 + (lane * 16 + 8 * (wv & 1)) * 2); \
        const float* g_ = p->in[8] + (size_t)layer * 128 * 640 + (hd_) * 64; \
        _Pragma("unroll") for (int i = 0; i < 16; ++i) { const int idx = tid + NTHR * i; gu[i] = g_[(idx >> 6) * 640 + (idx & 63)]; } } while (0)
    POST_LOAD(0);
    for (int hd = 0; hd < RWH; ++hd) {
        const int c = hd * 64 + lane;
        const float gw = p->in[12][layer * 640 + c], gb = p->in[13][layer * 640 + c];
        float yc[8], bc[8], vc[8];
#pragma unroll
        for (int i = 0; i < 8; ++i) { yc[i] = y[i]; bc[i] = bon[i]; vc[i] = bf2f((bf16_t)v8[i]); }
#pragma unroll
        for (int i = 0; i < 16; ++i) { const int idx = tid + NTHR * i; GU[(idx & 63) * 136 + (idx >> 6)] = (bf16_t)f2bf(gu[i]); }
        __syncthreads();
        POST_LOAD(hd + 1 < RWH ? hd + 1 : hd);
        { const int mt = wv & 3, nh = wv >> 2;
#pragma unroll
          for (int nn = 0; nn < 2; ++nn) { const int nt = 2 * nh + nn; f32x4 acc = {0.f, 0.f, 0.f, 0.f};
#pragma unroll
              for (int s = 0; s < 4; ++s) acc = __builtin_amdgcn_mfma_f32_16x16x32_bf16(*(const LAS bf16x8*)(SG + (16 * mt + l15) * 136 + 32 * s + 8 * qq), *(const LAS bf16x8*)(GU + (16 * nt + l15) * 136 + 32 * s + 8 * qq), acc, 0, 0, 0);
              *(LAS f32x4*)(GT + (16 * nt + l15) * 68 + 16 * mt + 4 * qq) = acc; } }
        __syncthreads();
        const f32x4 g0 = *(const LAS f32x4*)(GT + lane * 68 + 8 * wv), g1 = *(const LAS f32x4*)(GT + lane * 68 + 8 * wv + 4);
#pragma unroll
        for (int i = 0; i < 8; ++i) {
            const float mean = wave_sum(yc[i]) * (1.0f / 64.0f); const float d = yc[i] - mean; const float var = wave_sum(d * d) * (1.0f / 64.0f);
            float yn = d * __builtin_amdgcn_rsqf(var + RWKV_GN_EPS) * gw + gb;
            yn += bc[i] * vc[i];
            const float g = i < 4 ? g0[i & 3] : g1[i & 3];
            MIX[(row0 + i) * DM + MIX_RW + c] = (bf16_t)f2bf(yn * g);
        }
    }
#undef POST_LOAD
}
__device__ __forceinline__ void phase_post(PX p, int layer, LAS unsigned char* lds) {
    constexpr int NPOST = NB * (SEQ / 64);
    for (int u = blockIdx.x; u < NPOST; u += gridDim.x) rwkv_post_unit(p, layer, u, lds);
}

__device__ __forceinline__ void rwkv_scan_unit(PX p, int unit, LAS unsigned char* lds) {
    const int tid = otid(p.wvs), lane = tid & 63, wv = tid >> 6, bh = unit >> 1, half = unit & 1, b = bh / RWH, hd = bh % RWH;
    LAS float* OP = (LAS float*)lds;
    LAS float* VV = (LAS float*)(lds + 81920);
    LAS float* YB = (LAS float*)(lds + 81920 + 8192);
    const h16x8* src = (const h16x8*)(p->ws + WS_SCAN) + (size_t)bh * SEQ * 48;
    float* Y = (float*)(p->ws + WS_YRAW);
    const int rowl = wv * 4 + (lane >> 4), ks = (lane & 15) * 4;
    float S0 = 0.f, S1 = 0.f, S2 = 0.f, S3 = 0.f;
    h16x8 st[6];
#pragma unroll
    for (int j = 0; j < 6; ++j) st[j] = src[tid + NTHR * j];
    for (int blk = 0; blk < SEQ / 64; ++blk) {
#pragma unroll
        for (int j = 0; j < 6; ++j) { const int idx = tid + NTHR * j, tok = idx / 48, wi = idx % 48, op = wi >> 3, c0 = (wi & 7) * 8; float f[8];
#pragma unroll
            for (int e = 0; e < 8; ++e) f[e] = (float)st[j][e];
            if (op == 1) {
#pragma unroll
                for (int e = 0; e < 8; ++e) f[e] = 1.0f - f[e]; }
            if (op < 5) { LAS float* d = OP + (tok * 5 + op) * 64 + c0; *(LAS f32x4*)d = (f32x4){f[0], f[1], f[2], f[3]}; *(LAS f32x4*)(d + 4) = (f32x4){f[4], f[5], f[6], f[7]}; }
            else if ((c0 >> 5) == half) { LAS float* d = VV + tok * 32 + (c0 & 31); *(LAS f32x4*)d = (f32x4){f[0], f[1], f[2], f[3]}; *(LAS f32x4*)(d + 4) = (f32x4){f[4], f[5], f[6], f[7]}; } }
        __syncthreads();
        if (blk + 1 < SEQ / 64) {
#pragma unroll
            for (int j = 0; j < 6; ++j) st[j] = src[(size_t)(blk + 1) * 64 * 48 + tid + NTHR * j]; }
#pragma unroll 4
        for (int t = 0; t < 64; ++t) {
            const LAS float* o = OP + t * 320 + ks;
            const f32x4 r4 = *(const LAS f32x4*)(o), w4 = *(const LAS f32x4*)(o + 64), k4 = *(const LAS f32x4*)(o + 128), a4 = *(const LAS f32x4*)(o + 192), b4 = *(const LAS f32x4*)(o + 256);
            const float vv = VV[t * 32 + rowl];
            float sa = (S0 * a4[0] + S1 * a4[1]) + (S2 * a4[2] + S3 * a4[3]);
            sa = row16_sum(sa);
            S0 = S0 * w4[0] + (sa * b4[0] + vv * k4[0]); S1 = S1 * w4[1] + (sa * b4[1] + vv * k4[1]);
            S2 = S2 * w4[2] + (sa * b4[2] + vv * k4[2]); S3 = S3 * w4[3] + (sa * b4[3] + vv * k4[3]);
            float y = (S0 * r4[0] + S1 * r4[1]) + (S2 * r4[2] + S3 * r4[3]);
            y = row16_sum(y);
            if ((lane & 15) == 0) YB[t * 32 + rowl] = y;
        }
        __syncthreads();
        { const int tt = tid >> 3, r0 = (tid & 7) * 4; const f32x4 yv = *(const LAS f32x4*)(YB + tt * 32 + r0);
          *(f32x4*)(Y + ((size_t)b * SEQ + blk * 64 + tt) * 640 + hd * 64 + half * 32 + r0) = yv; }
    }
    __syncthreads();
}

__device__ __forceinline__ void ret_simple_unit(PX p, int layer, int unit, LAS unsigned char* lds) {
    const int tid = otid(p.wvs), b = unit / RETH, hh = unit % RETH, e = tid & 127, dq = tid >> 7;
    LAS float* QS = (LAS float*)lds; LAS float* KS = QS + 16 * 128; LAS float* VS = KS + 16 * 128; LAS float* OPS = VS + 16 * 128;
    const bf16_t* H = (const bf16_t*)(p->ws + WS_H); const f32x2* CS = (const f32x2*)(p->ws + WS_CS); bf16_t* MIX = (bf16_t*)(p->ws + WS_XB);
    const float gamma = 1.0f - exp2f(-5.0f - (float)hh);
    float R[32];
#pragma unroll
    for (int i = 0; i < 32; ++i) R[i] = 0.f;
    const float* gnw = p->in[14] + layer * 640 + hh * 128; const float* gnb = p->in[15] + layer * 640 + hh * 128;
    for (int s0 = 0; s0 < SEQ; s0 += 16) {
        { const int tt = tid >> 5, f0 = (tid & 31) * 2, s = s0 + tt; const bf16_t* hr = H + ((size_t)b * SEQ + s) * PINP;
#pragma unroll
          for (int j = 0; j < 2; ++j) { const int f = f0 + j; const f32x2 cs = CS[(size_t)s * 64 + f];
              const float q1 = bf2f(hr[C_TQ + hh * 128 + f]), q2 = bf2f(hr[C_TQ + hh * 128 + 64 + f]), k1 = bf2f(hr[C_TK + hh * 128 + f]), k2 = bf2f(hr[C_TK + hh * 128 + 64 + f]);
              QS[tt * 128 + f] = q1 * cs.x - q2 * cs.y; QS[tt * 128 + 64 + f] = q1 * cs.y + q2 * cs.x;
              KS[tt * 128 + f] = (k1 * cs.x - k2 * cs.y) * 0.08838834764831845f; KS[tt * 128 + 64 + f] = (k1 * cs.y + k2 * cs.x) * 0.08838834764831845f; }
          const int e0 = (tid & 31) * 4;
#pragma unroll
          for (int j = 0; j < 4; ++j) VS[tt * 128 + e0 + j] = bf2f(hr[C_TV + hh * 128 + e0 + j]); }
        __syncthreads();
        for (int t = 0; t < 16; ++t) {
            const float ve = VS[t * 128 + e]; float op = 0.f;
#pragma unroll
            for (int i = 0; i < 32; i += 4) { const f32x4 k4 = *(const LAS f32x4*)(KS + t * 128 + dq * 32 + i), q4 = *(const LAS f32x4*)(QS + t * 128 + dq * 32 + i);
#pragma unroll
                for (int j = 0; j < 4; ++j) { R[i + j] = R[i + j] * gamma + k4[j] * ve; op += q4[j] * R[i + j]; } }
            OPS[(t * 4 + dq) * 128 + e] = op;
        }
        __syncthreads();
        { const int tt = tid >> 5, e0 = (tid & 31) * 4, s = s0 + tt; const size_t row = (size_t)b * SEQ + s;
          f32x4 o = *(const LAS f32x4*)(OPS + (tt * 4 + 0) * 128 + e0) + *(const LAS f32x4*)(OPS + (tt * 4 + 1) * 128 + e0) + *(const LAS f32x4*)(OPS + (tt * 4 + 2) * 128 + e0) + *(const LAS f32x4*)(OPS + (tt * 4 + 3) * 128 + e0);
          float sm = half_sum((o[0] + o[1]) + (o[2] + o[3]), tid & 63);
          const float mean = sm * (1.0f / 128.0f); const f32x4 d = o - mean; float q = half_sum((d[0] * d[0] + d[1] * d[1]) + (d[2] * d[2] + d[3] * d[3]), tid & 63);
          const float rstd = 1.0f / sqrtf(q * (1.0f / 128.0f) + RET_GN_EPS);
          float r4[4];
#pragma unroll
          for (int j = 0; j < 4; ++j) { const float g = bf2f(H[row * PINP + C_TG + hh * 128 + e0 + j]); const float sil = g / (1.0f + expf(-g));
              r4[j] = (d[j] * rstd * gnw[e0 + j] + gnb[e0 + j]) * sil; }
          u32x2 w; w.x = pk2(r4[0], r4[1]); w.y = pk2(r4[2], r4[3]); *(u32x2*)(MIX + row * DM + MIX_RET + hh * 128 + e0) = w; }
        __syncthreads();
    }
}
constexpr int RS = 136;
__device__ __forceinline__ int crow32(int r, int hi) { return (r & 3) + 8 * (r >> 2) + 4 * hi; }
constexpr int RET_G = 8, RET_CPG = (SEQ / 128) / RET_G;
typedef float f32x16r __attribute__((ext_vector_type(16)));
template <bool WANT_KB, bool WANT_KDT>
__device__ __forceinline__ void ret_stage_kv(const bf16_t* H, const f32x2* CS, int tid, size_t rowbase, int c, int hh, float lg2, LAS bf16_t* KB, LAS bf16_t* KDT, LAS bf16_t* VT) {
    const int kp = tid >> 3, part = tid & 7, f0 = part * 8;
    float y1[2][8], y2[2][8];
#pragma unroll
    for (int kk = 0; kk < 2; ++kk) { const int key = 2 * kp + kk; const bf16_t* hr = H + (rowbase + key) * PINP + C_TK + hh * 128 + f0;
        const bf16x8 x1 = *(const bf16x8*)hr, x2 = *(const bf16x8*)(hr + 64); const f32x4* cp = (const f32x4*)(CS + (size_t)(c * 128 + key) * 64 + f0);
        const f32x4 c0 = cp[0], c1 = cp[1], c2 = cp[2], c3 = cp[3]; const float cs[16] = {c0[0], c0[1], c0[2], c0[3], c1[0], c1[1], c1[2], c1[3], c2[0], c2[1], c2[2], c2[3], c3[0], c3[1], c3[2], c3[3]};
#pragma unroll
        for (int j = 0; j < 8; ++j) { const float a = bf2f((bf16_t)x1[j]), bb = bf2f((bf16_t)x2[j]), co = cs[2 * j], si = cs[2 * j + 1];
            y1[kk][j] = (a * co - bb * si) * 0.08838834764831845f; y2[kk][j] = (a * si + bb * co) * 0.08838834764831845f; }
        if (WANT_KB) { u32x4 w1, w2; w1.x = pk2(y1[kk][0], y1[kk][1]); w1.y = pk2(y1[kk][2], y1[kk][3]); w1.z = pk2(y1[kk][4], y1[kk][5]); w1.w = pk2(y1[kk][6], y1[kk][7]);
            w2.x = pk2(y2[kk][0], y2[kk][1]); w2.y = pk2(y2[kk][2], y2[kk][3]); w2.z = pk2(y2[kk][4], y2[kk][5]); w2.w = pk2(y2[kk][6], y2[kk][7]);
            *(LAS u32x4*)(KB + key * RS + f0) = w1; *(LAS u32x4*)(KB + key * RS + 64 + f0) = w2; } }
    if (WANT_KDT) { const float kd0 = __builtin_amdgcn_exp2f((float)(127 - 2 * kp) * lg2), kd1 = __builtin_amdgcn_exp2f((float)(126 - 2 * kp) * lg2);
#pragma unroll
        for (int j = 0; j < 8; ++j) { *(LAS unsigned*)(KDT + (f0 + j) * RS + 2 * kp) = pk2(y1[0][j] * kd0, y1[1][j] * kd1); *(LAS unsigned*)(KDT + (64 + f0 + j) * RS + 2 * kp) = pk2(y2[0][j] * kd0, y2[1][j] * kd1); } }
    const int e0 = part * 16; const bf16_t* v0p = H + (rowbase + 2 * kp) * PINP + C_TV + hh * 128 + e0; const bf16_t* v1p = v0p + PINP;
    const bf16x8 va0 = *(const bf16x8*)v0p, va1 = *(const bf16x8*)(v0p + 8), vb0 = *(const bf16x8*)v1p, vb1 = *(const bf16x8*)(v1p + 8);
#pragma unroll
    for (int j = 0; j < 8; ++j) { *(LAS unsigned*)(VT + (e0 + j) * RS + 2 * kp) = (unsigned)(unsigned short)va0[j] | ((unsigned)(unsigned short)vb0[j] << 16);
                                  *(LAS unsigned*)(VT + (e0 + 8 + j) * RS + 2 * kp) = (unsigned)(unsigned short)va1[j] | ((unsigned)(unsigned short)vb1[j] << 16); }
}
__device__ __forceinline__ void ret_kv_unit(PX p, int unit, LAS unsigned char* lds) {
    const int tid = otid(p.wvs), lane = tid & 63, wv = __builtin_amdgcn_readfirstlane(tid >> 6), r = lane & 31, hi = lane >> 5, wr = wv >> 1, wc = wv & 1;
    const int c = unit % (SEQ / 128), bhh = unit / (SEQ / 128), b = bhh / RETH, hh = bhh % RETH;
    LAS bf16_t* KDT = (LAS bf16_t*)(lds + 34816); LAS bf16_t* VT = (LAS bf16_t*)(lds + 69632);
    const bf16_t* H = (const bf16_t*)(p->ws + WS_H); const f32x2* CS = (const f32x2*)(p->ws + WS_CS);
    const float lg2 = log2f(1.0f - exp2f(-5.0f - (float)hh));
    const size_t rowbase = (size_t)b * SEQ + (size_t)c * 128;
    __syncthreads();
    ret_stage_kv<false, true>(H, CS, tid, rowbase, c, hh, lg2, nullptr, KDT, VT);
    __syncthreads();
    const LAS bf16_t* xv = VT + (32 * wr + r) * RS + 8 * hi; bf16x8 vf[8];
#pragma unroll
    for (int s = 0; s < 8; ++s) vf[s] = *(const LAS bf16x8*)(xv + 16 * s);
    u32x4* dst = (u32x4*)(p->ws + WS_KV) + ((size_t)unit * NTHR + tid) * 4;
#pragma unroll
    for (int n = 0; n < 2; ++n) { f32x16r rt = {}; const LAS bf16_t* yk = KDT + (64 * wc + 32 * n + r) * RS + 8 * hi;
#pragma unroll
        for (int s = 0; s < 8; ++s) rt = __builtin_amdgcn_mfma_f32_32x32x16_bf16(vf[s], *(const LAS bf16x8*)(yk + 16 * s), rt, 0, 0, 0);
        u32x4 w0, w1; w0.x = pk2(rt[0], rt[1]); w0.y = pk2(rt[2], rt[3]); w0.z = pk2(rt[4], rt[5]); w0.w = pk2(rt[6], rt[7]);
        w1.x = pk2(rt[8], rt[9]); w1.y = pk2(rt[10], rt[11]); w1.z = pk2(rt[12], rt[13]); w1.w = pk2(rt[14], rt[15]);
        dst[2 * n] = w0; dst[2 * n + 1] = w1; }
}
__device__ __forceinline__ void ret_kv_add(f32x16r (&RTacc)[2], const u32x4* src, float cdec) {
#pragma unroll
    for (int n = 0; n < 2; ++n) { const u32x4 w0 = src[2 * n], w1 = src[2 * n + 1]; const unsigned ww[8] = {w0.x, w0.y, w0.z, w0.w, w1.x, w1.y, w1.z, w1.w};
#pragma unroll
        for (int i = 0; i < 8; ++i) { RTacc[n][2 * i] = RTacc[n][2 * i] * cdec + __uint_as_float(ww[i] << 16); RTacc[n][2 * i + 1] = RTacc[n][2 * i + 1] * cdec + __uint_as_float(ww[i] & 0xffff0000u); } }
}
__device__ __forceinline__ void ret_mfma_unit(PX p, int layer, int unit, LAS unsigned char* lds) {
    typedef f32x16r f32x16;
    const int tid = otid(p.wvs), lane = tid & 63, wv = __builtin_amdgcn_readfirstlane(tid >> 6), r = lane & 31, hi = lane >> 5, wr = wv >> 1, wc = wv & 1;
    const int grp = unit % RET_G, bhh = unit / RET_G, b = bhh / RETH, hh = bhh % RETH;
    LAS bf16_t* KB = (LAS bf16_t*)lds; LAS bf16_t* KDT = (LAS bf16_t*)(lds + 34816); LAS bf16_t* VT = (LAS bf16_t*)(lds + 69632); LAS bf16_t* RT = (LAS bf16_t*)(lds + 104448);
    LAS float* OB = (LAS float*)lds;
    const bf16_t* H = (const bf16_t*)(p->ws + WS_H); const f32x2* CS = (const f32x2*)(p->ws + WS_CS); bf16_t* MIX = (bf16_t*)(p->ws + WS_XB);
    const float lg2 = log2f(1.0f - exp2f(-5.0f - (float)hh));
    const float* gnw = p->in[14] + layer * 640 + hh * 128; const float* gnb = p->in[15] + layer * 640 + hh * 128;
    f32x16 RTacc[2];
#pragma unroll
    for (int n = 0; n < 2; ++n)
#pragma unroll
        for (int i = 0; i < 16; ++i) RTacc[n][i] = 0.f;
    const float cdec = __builtin_amdgcn_exp2f(128.0f * lg2);
    const u32x4* kvsrc = (const u32x4*)(p->ws + WS_KV) + ((size_t)bhh * (SEQ / 128) * NTHR + tid) * 4;
    for (int cp = 0; cp < grp * RET_CPG; cp += 4) {
        u32x4 t[4][4];
#pragma unroll
        for (int j = 0; j < 4; ++j)
#pragma unroll
            for (int i = 0; i < 4; ++i) t[j][i] = kvsrc[(size_t)(cp + j) * NTHR * 4 + i];
#pragma unroll
        for (int j = 0; j < 4; ++j) { const float w = __builtin_amdgcn_exp2f((float)(grp * RET_CPG - 1 - cp - j) * 128.0f * lg2);
#pragma unroll
            for (int n = 0; n < 2; ++n) { const unsigned ww[8] = {t[j][2 * n].x, t[j][2 * n].y, t[j][2 * n].z, t[j][2 * n].w, t[j][2 * n + 1].x, t[j][2 * n + 1].y, t[j][2 * n + 1].z, t[j][2 * n + 1].w};
#pragma unroll
                for (int i = 0; i < 8; ++i) { RTacc[n][2 * i] += w * __uint_as_float(ww[i] << 16); RTacc[n][2 * i + 1] += w * __uint_as_float(ww[i] & 0xffff0000u); } } }
    }
    __syncthreads();
#pragma unroll
    for (int n = 0; n < 2; ++n)
#pragma unroll
        for (int i = 0; i < 16; ++i) RT[(32 * wr + crow32(i, hi)) * RS + 64 * wc + 32 * n + r] = (bf16_t)f2bf(RTacc[n][i]);
    for (int c = grp * RET_CPG; c < (grp + 1) * RET_CPG; ++c) {
        const size_t rowbase = (size_t)b * SEQ + (size_t)c * 128;
        int tl = tid; asm volatile("; per-chunk tid" : "+v"(tl));
        const int r_ = tl & 31, hi_ = (tl >> 5) & 1;
        __syncthreads();
        ret_stage_kv<true, false>(H, CS, tl, rowbase, c, hh, lg2, KB, KDT, VT);
        bf16x8 qf[8];
        {
            const int q = 32 * wr + r_; const bf16_t* hr = H + (rowbase + q) * PINP + C_TQ + hh * 128 + 8 * hi_; const f32x4* cp = (const f32x4*)(CS + (size_t)(c * 128 + q) * 64 + 8 * hi_);
#pragma unroll
            for (int s = 0; s < 4; ++s) { const bf16x8 x1 = *(const bf16x8*)(hr + 16 * s), x2 = *(const bf16x8*)(hr + 64 + 16 * s);
                const f32x4 c0 = cp[8 * s], c1 = cp[8 * s + 1], c2 = cp[8 * s + 2], c3 = cp[8 * s + 3]; const float cs[16] = {c0[0], c0[1], c0[2], c0[3], c1[0], c1[1], c1[2], c1[3], c2[0], c2[1], c2[2], c2[3], c3[0], c3[1], c3[2], c3[3]};
                float y1[8], y2[8];
#pragma unroll
                for (int j = 0; j < 8; ++j) { const float a = bf2f((bf16_t)x1[j]), bb = bf2f((bf16_t)x2[j]), co = cs[2 * j], si = cs[2 * j + 1]; y1[j] = a * co - bb * si; y2[j] = a * si + bb * co; }
                u32x4 w1, w2; w1.x = pk2(y1[0], y1[1]); w1.y = pk2(y1[2], y1[3]); w1.z = pk2(y1[4], y1[5]); w1.w = pk2(y1[6], y1[7]);
                w2.x = pk2(y2[0], y2[1]); w2.y = pk2(y2[2], y2[3]); w2.z = pk2(y2[4], y2[5]); w2.w = pk2(y2[6], y2[7]);
                qf[s] = *reinterpret_cast<bf16x8*>(&w1); qf[s + 4] = *reinterpret_cast<bf16x8*>(&w2); }
        }
        __syncthreads();
        const u32x4* kvc = (const u32x4*)(p->ws + WS_KV) + ((size_t)(bhh * (SEQ / 128) + c) * NTHR + tl) * 4; const u32x4 kv0 = kvc[0], kv1 = kvc[1], kv2 = kvc[2], kv3 = kvc[3];
        f32x16 O[2], S[2];
#pragma unroll
        for (int n = 0; n < 2; ++n) {
            f32x16 o = {}, sc = {};
            const LAS bf16_t* yr = RT + (64 * wc + 32 * n + r) * RS + 8 * hi; const LAS bf16_t* yk = KB + (64 * wc + 32 * n + r) * RS + 8 * hi;
#pragma unroll
            for (int s = 0; s < 8; ++s) { o = __builtin_amdgcn_mfma_f32_32x32x16_bf16(qf[s], *(const LAS bf16x8*)(yr + 16 * s), o, 0, 0, 0);
                                          sc = __builtin_amdgcn_mfma_f32_32x32x16_bf16(qf[s], *(const LAS bf16x8*)(yk + 16 * s), sc, 0, 0, 0); }
            O[n] = o; S[n] = sc;
        }
#pragma unroll
        for (int i = 0; i < 16; ++i) { const int q = 32 * wr + crow32(i, hi); const float qd = __builtin_amdgcn_exp2f((float)(q + 1) * lg2);
#pragma unroll
            for (int n = 0; n < 2; ++n) { O[n][i] *= qd; const int key = 64 * wc + 32 * n + r; S[n][i] = q >= key ? S[n][i] * __builtin_amdgcn_exp2f((float)(q - key) * lg2) : 0.f; } }
        __syncthreads();
#pragma unroll
        for (int n = 0; n < 2; ++n)
#pragma unroll
            for (int i = 0; i < 16; ++i) KB[(32 * wr + crow32(i, hi)) * RS + 64 * wc + 32 * n + r] = (bf16_t)f2bf(S[n][i]);
        __syncthreads();
        {
            const LAS bf16_t* xp = KB + (32 * wr + r) * RS + 8 * hi;
            bf16x8 pf[8];
#pragma unroll
            for (int s = 0; s < 8; ++s) pf[s] = *(const LAS bf16x8*)(xp + 16 * s);
#pragma unroll
            for (int n = 0; n < 2; ++n) { f32x16 o = O[n]; const LAS bf16_t* yv = VT + (64 * wc + 32 * n + r) * RS + 8 * hi;
#pragma unroll
                for (int s = 0; s < 8; ++s) o = __builtin_amdgcn_mfma_f32_32x32x16_bf16(pf[s], *(const LAS bf16x8*)(yv + 16 * s), o, 0, 0, 0);
                O[n] = o; }
            { const u32x4 kvv[4] = {kv0, kv1, kv2, kv3}; ret_kv_add(RTacc, kvv, cdec); }
        }
        __syncthreads();
#pragma unroll
        for (int n = 0; n < 2; ++n)
#pragma unroll
            for (int i = 0; i < 16; ++i) { const int row = 32 * wr + crow32(i, hi), col = 64 * wc + 32 * n + r; RT[row * RS + col] = (bf16_t)f2bf(RTacc[n][i]); OB[row * 132 + col] = O[n][i]; }
        __syncthreads();
        {
            const int q = tl >> 2, qu = tl & 3; const size_t row = rowbase + q; const LAS float* ob = OB + q * 132 + 32 * qu;
            f32x4 v[8]; float sm = 0.f;
#pragma unroll
            for (int i = 0; i < 8; ++i) { v[i] = *(const LAS f32x4*)(ob + 4 * i); sm += (v[i][0] + v[i][1]) + (v[i][2] + v[i][3]); }
            sm = dpp_add<0xB1>(sm); sm = dpp_add<0x4E>(sm);
            const float mean = sm * (1.0f / 128.0f); float qq = 0.f;
#pragma unroll
            for (int i = 0; i < 8; ++i) { const f32x4 d = v[i] - mean; qq += (d[0] * d[0] + d[1] * d[1]) + (d[2] * d[2] + d[3] * d[3]); }
            qq = dpp_add<0xB1>(qq); qq = dpp_add<0x4E>(qq);
            const float rstd = 1.0f / sqrtf(qq * (1.0f / 128.0f) + RET_GN_EPS);
            const bf16_t* gp = H + row * PINP + C_TG + hh * 128 + 32 * qu; bf16_t* mp = MIX + row * DM + MIX_RET + hh * 128 + 32 * qu;
#pragma unroll
            for (int i = 0; i < 4; ++i) { const bf16x8 g8 = *(const bf16x8*)(gp + 8 * i); float o8[8];
#pragma unroll
                for (int j = 0; j < 8; ++j) { const int e = 8 * i + j; const float x = v[e >> 2][e & 3]; const float g = bf2f((bf16_t)g8[j]); const float sil = g / (1.0f + __expf(-g));
                    o8[j] = ((x - mean) * rstd * gnw[32 * qu + e] + gnb[32 * qu + e]) * sil; }
                u32x4 w; w.x = pk2(o8[0], o8[1]); w.y = pk2(o8[2], o8[3]); w.z = pk2(o8[4], o8[5]); w.w = pk2(o8[6], o8[7]); *(u32x4*)(mp + 8 * i) = w; }
        }
    }
    __syncthreads();
}
namespace rk {
constexpr int AT = 0, BT = 2304, KT = 4608, RM = 6912, WT = 10240, ATT = 13568, KBH = 18688, PVT = 23808, E15 = 28928, NAB = 29184, NKT = 30464, TT = 31744, CHB = 33024;
constexpr int SB = 4 * CHB, HS = SB + 4 * 2304, LDS_END = HS + 2048;
static_assert(LDS_END <= MISC_OFF, "rwkv chunk LDS map");
typedef float f32x4 __attribute__((ext_vector_type(4)));
__device__ __forceinline__ f32x4 mm16(const LAS bf16_t* A, int lda, const LAS bf16_t* B, int ldb, int nks, f32x4 acc, int l15, int qq) {
    for (int s = 0; s < nks; ++s) { const bf16x8 a = *(const LAS bf16x8*)(A + l15 * lda + 32 * s + 8 * qq), b = *(const LAS bf16x8*)(B + l15 * ldb + 32 * s + 8 * qq);
        acc = __builtin_amdgcn_mfma_f32_16x16x32_bf16(a, b, acc, 0, 0, 0); }
    return acc;
}
__device__ __forceinline__ void store_t(LAS bf16_t* D, f32x4 c) { u32x2 w; w.x = pk2(c[0], c[1]); w.y = pk2(c[2], c[3]); *(LAS u32x2*)D = w; }
}
__device__ __forceinline__ void rwkv_chunk_unit(PX p, int bh, LAS unsigned char* lds) {
    using namespace rk;
    const int tid = otid(p.wvs), lane = tid & 63, wv = __builtin_amdgcn_readfirstlane(tid >> 6), l15 = lane & 15, qq = lane >> 4, b = bh / RWH, hd = bh % RWH;
    const int cq = wv >> 1, ch = wv & 1;
    for (int i = tid; i < LDS_END / 4; i += NTHR) ((LAS unsigned*)lds)[i] = 0u;
    const _Float16* src = (const _Float16*)(p->ws + WS_SCAN) + (size_t)bh * SEQ * 384 + lane;
    float* Y = (float*)(p->ws + WS_YRAW);
    LAS unsigned char* cb = lds + cq * CHB;
    LAS float* hs = (LAS float*)(lds + HS);
    f32x4 ST[4];
#pragma unroll
    for (int m = 0; m < 4; ++m) ST[m] = (f32x4){0.f, 0.f, 0.f, 0.f};
    _Float16 in[8][6];
#pragma unroll
    for (int n = 0; n < 8; ++n)
#pragma unroll
        for (int o = 0; o < 6; ++o) in[n][o] = src[(size_t)(wv * 8 + n) * 384 + o * 64];
    __syncthreads();
    for (int sc = 0; sc < SEQ / 64; ++sc) {
        float ld[8], clv[8], run = 0.f;
#pragma unroll
        for (int n = 0; n < 8; ++n) { ld[n] = (float)in[n][1]; run += ld[n]; clv[n] = run; }
        hs[wv * 64 + lane] = run;
        __syncthreads();
        const float other = hs[(wv ^ 1) * 64 + lane]; const float pre = ch ? other : 0.f, tot = run + other;
        {
            float va[8], vb[8], vk[8], vkh[8], vbh[8];
            LAS bf16_t* at = (LAS bf16_t*)(cb + AT); LAS bf16_t* bt = (LAS bf16_t*)(cb + BT); LAS bf16_t* kt = (LAS bf16_t*)(cb + KT); LAS bf16_t* rm = (LAS bf16_t*)(cb + RM);
#pragma unroll
            for (int n = 0; n < 8; ++n) { const int i = 8 * ch + n; const float cl = pre + clv[n]; const float E = __expf(cl), Eex = __expf(cl - ld[n]), Einv = __expf(-cl), Eh = __expf(tot - cl);
                const float r = (float)in[n][0], k = (float)in[n][2], a = (float)in[n][3], bb = (float)in[n][4];
                va[n] = a * Eex; vb[n] = bb * Einv; vk[n] = k * Einv; vkh[n] = k * Eh; vbh[n] = bb * Eh;
                at[i * 72 + lane] = (bf16_t)f2bf(va[n]); bt[i * 72 + lane] = (bf16_t)f2bf(vb[n]); kt[i * 72 + lane] = (bf16_t)f2bf(vk[n]); rm[i * 104 + lane] = (bf16_t)f2bf(r * E); }
            u32x4 w;
            w.x = pk2(va[0], va[1]); w.y = pk2(va[2], va[3]); w.z = pk2(va[4], va[5]); w.w = pk2(va[6], va[7]); *(LAS u32x4*)((LAS bf16_t*)(cb + ATT) + lane * 40 + 8 * ch) = w;
            w.x = pk2(vkh[0], vkh[1]); w.y = pk2(vkh[2], vkh[3]); w.z = pk2(vkh[4], vkh[5]); w.w = pk2(vkh[6], vkh[7]); *(LAS u32x4*)((LAS bf16_t*)(cb + KBH) + lane * 40 + 8 * ch) = w;
            w.x = pk2(vbh[0], vbh[1]); w.y = pk2(vbh[2], vbh[3]); w.z = pk2(vbh[4], vbh[5]); w.w = pk2(vbh[6], vbh[7]); *(LAS u32x4*)((LAS bf16_t*)(cb + KBH) + lane * 40 + 16 + 8 * ch) = w;
            w.x = pk2((float)in[0][5], (float)in[1][5]); w.y = pk2((float)in[2][5], (float)in[3][5]); w.z = pk2((float)in[4][5], (float)in[5][5]); w.w = pk2((float)in[6][5], (float)in[7][5]);
            *(LAS u32x4*)((LAS bf16_t*)(cb + PVT) + lane * 40 + 8 * ch) = w;
            if (ch == 0) ((LAS float*)(cb + E15))[lane] = __expf(tot);
        }
        __syncthreads();
        if (sc + 1 < SEQ / 64) {
#pragma unroll
            for (int n = 0; n < 8; ++n)
#pragma unroll
                for (int o = 0; o < 6; ++o) in[n][o] = src[(size_t)((sc + 1) * 64 + wv * 8 + n) * 384 + o * 64]; }
        {
            const LAS bf16_t* at = (const LAS bf16_t*)(cb + AT); const LAS bf16_t* bt = (const LAS bf16_t*)(cb + BT); const LAS bf16_t* kt = (const LAS bf16_t*)(cb + KT); LAS bf16_t* rm = (LAS bf16_t*)(cb + RM);
            const f32x4 z = {0.f, 0.f, 0.f, 0.f};
            if (ch == 0) {
                f32x4 nab = mm16(at, 72, bt, 72, 2, z, l15, qq), nak = mm16(at, 72, kt, 72, 2, z, l15, qq);
#pragma unroll
                for (int g = 0; g < 4; ++g) { const bool ok = l15 < 4 * qq + g; ((LAS float*)(cb + NAB))[(4 * qq + g) * 20 + l15] = ok ? nab[g] : 0.f; nak[g] = ok ? nak[g] : 0.f; }
                store_t((LAS bf16_t*)(cb + NKT) + l15 * 40 + 4 * qq, nak);
            } else {
                f32x4 mrk = mm16(kt, 72, rm, 104, 2, z, l15, qq), mrb = mm16(bt, 72, rm, 104, 2, z, l15, qq);
#pragma unroll
                for (int g = 0; g < 4; ++g) { const bool ok = 4 * qq + g <= l15; mrk[g] = ok ? mrk[g] : 0.f; mrb[g] = ok ? mrb[g] : 0.f; }
                store_t(rm + l15 * 104 + 64 + 4 * qq, mrk); store_t(rm + l15 * 104 + 80 + 4 * qq, mrb);
            }
        }
        __syncthreads();
        if (wv == 0) {
            const LAS float* nab = (const LAS float*)(lds + qq * CHB + NAB); LAS bf16_t* tt = (LAS bf16_t*)(lds + qq * CHB + TT);
            float tc[16];
#pragma unroll
            for (int i = 0; i < 16; ++i) { float acc = (i == l15) ? 1.f : 0.f;
#pragma unroll
                for (int j4 = 0; j4 < 16; j4 += 4) { if (j4 < i) { const f32x4 nr = *(const LAS f32x4*)(nab + i * 20 + j4);
#pragma unroll
                        for (int j = 0; j < 4; ++j) if (j4 + j < i) acc += nr[j] * tc[j4 + j]; } }
                tc[i] = acc; tt[i * 40 + l15] = (bf16_t)f2bf(acc); }
        }
        __syncthreads();
        {
            const LAS bf16_t* att = (const LAS bf16_t*)(cb + ATT); const LAS bf16_t* tt = (const LAS bf16_t*)(cb + TT); LAS bf16_t* wt = (LAS bf16_t*)(cb + WT);
            const f32x4 z = {0.f, 0.f, 0.f, 0.f};
#pragma unroll
            for (int mm = 0; mm < 2; ++mm) { const int mt = 2 * ch + mm; const f32x4 c = mm16(att + 16 * mt * 40, 40, tt, 40, 1, z, l15, qq);
                store_t(wt + l15 * 104 + 16 * mt + 4 * qq, c); }
            if (ch == 0) { const f32x4 c = mm16((const LAS bf16_t*)(cb + NKT), 40, tt, 40, 1, z, l15, qq); store_t(wt + l15 * 104 + 64 + 4 * qq, c); }
        }
        __syncthreads();
        if (wv < 4) {
            LAS bf16_t* sb = (LAS bf16_t*)(lds + SB + wv * 2304);
            for (int q = 0; q < 4; ++q) {
                LAS unsigned char* cc = lds + q * CHB; const LAS bf16_t* wt = (const LAS bf16_t*)(cc + WT); const LAS bf16_t* rm = (const LAS bf16_t*)(cc + RM);
                LAS bf16_t* pvt = (LAS bf16_t*)(cc + PVT) + (16 * wv) * 40; const LAS bf16_t* kbh = (const LAS bf16_t*)(cc + KBH);
                const bf16x8 s0 = *(const LAS bf16x8*)(sb + l15 * 72 + 8 * qq), s1 = *(const LAS bf16x8*)(sb + l15 * 72 + 32 + 8 * qq);
                bf16x8 pv = *(const LAS bf16x8*)(pvt + l15 * 40 + 8 * qq);
                f32x4 P = {0.f, 0.f, 0.f, 0.f};
                P = __builtin_amdgcn_mfma_f32_16x16x32_bf16(*(const LAS bf16x8*)(wt + l15 * 104 + 8 * qq), s0, P, 0, 0, 0);
                P = __builtin_amdgcn_mfma_f32_16x16x32_bf16(*(const LAS bf16x8*)(wt + l15 * 104 + 32 + 8 * qq), s1, P, 0, 0, 0);
                P = __builtin_amdgcn_mfma_f32_16x16x32_bf16(*(const LAS bf16x8*)(wt + l15 * 104 + 64 + 8 * qq), pv, P, 0, 0, 0);
                store_t(pvt + l15 * 40 + 16 + 4 * qq, P);
                pv = *(const LAS bf16x8*)(pvt + l15 * 40 + 8 * qq);
                f32x4 Yc = {0.f, 0.f, 0.f, 0.f};
                Yc = __builtin_amdgcn_mfma_f32_16x16x32_bf16(*(const LAS bf16x8*)(rm + l15 * 104 + 8 * qq), s0, Yc, 0, 0, 0);
                Yc = __builtin_amdgcn_mfma_f32_16x16x32_bf16(*(const LAS bf16x8*)(rm + l15 * 104 + 32 + 8 * qq), s1, Yc, 0, 0, 0);
                Yc = __builtin_amdgcn_mfma_f32_16x16x32_bf16(*(const LAS bf16x8*)(rm + l15 * 104 + 64 + 8 * qq), pv, Yc, 0, 0, 0);
                const LAS float* e15 = (const LAS float*)(cc + E15);
#pragma unroll
                for (int m = 0; m < 4; ++m) { const f32x4 e = *(const LAS f32x4*)(e15 + 16 * m + 4 * qq);
                    ST[m] = __builtin_amdgcn_mfma_f32_16x16x32_bf16(*(const LAS bf16x8*)(kbh + (16 * m + l15) * 40 + 8 * qq), pv, ST[m] * e, 0, 0, 0);
                    store_t(sb + l15 * 72 + 16 * m + 4 * qq, ST[m]); }
                float* yo = Y + ((size_t)b * SEQ + (size_t)sc * 64 + 16 * q + 4 * qq) * 640 + hd * 64 + 16 * wv + l15;
#pragma unroll
                for (int g = 0; g < 4; ++g) yo[(size_t)g * 640] = Yc[g];
            }
        }
        __syncthreads();
    }
}
namespace rk2 {
constexpr int P_WT = 0, P_RM = 3072, P_KBH = 6144, P_VT = 10240, P_E15 = 12288, P_SZ = 12544;
constexpr int XW = 0, XA = 9216, WUP = 18432, AUP = 27648, WLT = 40960, ALT = 58368;
static_assert(ALT + 17408 <= 4 * rk::CHB && (size_t)NB * RWH * (SEQ / 16) * P_SZ <= 245 * MiB, "rwkv packet / staging map");
}
__device__ __forceinline__ void rwkv_prep_unit(PX p, int layer, int unit, LAS unsigned char* lds) {
    using namespace rk;
    const int tid = otid(p.wvs), lane = tid & 63, wv = __builtin_amdgcn_readfirstlane(tid >> 6), l15 = lane & 15, qq = lane >> 4;
    const int tile = unit % (SEQ / 64), b = unit / (SEQ / 64);
    const int cq = wv >> 1, ch = wv & 1, s0 = tile * 64;
    const bf16_t* H = (const bf16_t*)(p->ws + WS_H); const float* mu = p->in[3] + (size_t)layer * 2176;
    LAS unsigned char* cb = lds + cq * CHB; LAS float* hs = (LAS float*)(lds + HS);
    u32x4 xin0, xin1; const int xtt = tid >> 3, xj0 = (tid & 7) * 16;
    {
        const int s = s0 + xtt; const size_t row = (size_t)b * SEQ + s;
        const bf16_t* hc = H + row * PINP + C_WD + xj0; const bf16_t* hp = hc - PINP;
        const bf16_t* hq = s > 0 ? hp : hc; const float pm = s > 0 ? 1.f : 0.f;
        const bf16x8 c0 = *(const bf16x8*)hc, c1 = *(const bf16x8*)(hc + 8), p0 = *(const bf16x8*)hq, p1 = *(const bf16x8*)(hq + 8);
        float x[16];
#pragma unroll
        for (int i = 0; i < 16; ++i) { const float cu = bf2f((bf16_t)(i < 8 ? c0[i] : c1[i - 8])), pr = pm * bf2f((bf16_t)(i < 8 ? p0[i] : p1[i - 8]));
            x[i] = tshift(cu, pr, mu[1920 + xj0 + i]); if (xj0 < 64) x[i] = 1.0f - 2.0f * __builtin_amdgcn_rcpf(1.0f + __expf(2.0f * x[i])); }
        xin0.x = pk2(x[0], x[1]); xin0.y = pk2(x[2], x[3]); xin0.z = pk2(x[4], x[5]); xin0.w = pk2(x[6], x[7]);
        xin1.x = pk2(x[8], x[9]); xin1.y = pk2(x[10], x[11]); xin1.z = pk2(x[12], x[13]); xin1.w = pk2(x[14], x[15]);
    }
    const bf16_t* hr = H + ((size_t)b * SEQ + s0 + wv * 8) * PINP; const bool hasp = s0 + wv * 8 > 0; const bf16_t* hqr = hasp ? hr - PINP : hr; const float pmr = hasp ? 1.f : 0.f;
    float wgt[16]; bf16_t raw[27];
#define PREP_LOAD(hd_) do { const float* wu_ = p->in[5] + (size_t)layer * 64 * 640 + (hd_) * 64; const float* au_ = p->in[7] + (size_t)layer * 64 * 640 + (hd_) * 64; \
        _Pragma("unroll") for (int i = 0; i < 8; ++i) { const int idx = tid + NTHR * i, j = idx >> 6, cc = idx & 63; wgt[i] = wu_[j * 640 + cc]; wgt[8 + i] = au_[j * 640 + cc]; } \
        const int c_ = (hd_) * 64 + lane; raw[0] = hqr[C_RR + c_]; raw[1] = hqr[C_RK + c_]; raw[2] = hqr[C_RV + c_]; \
        _Pragma("unroll") for (int n = 0; n < 8; ++n) { raw[3 + 3 * n] = hr[(size_t)n * PINP + C_RR + c_]; raw[4 + 3 * n] = hr[(size_t)n * PINP + C_RK + c_]; raw[5 + 3 * n] = hr[(size_t)n * PINP + C_RV + c_]; } } while (0)
    PREP_LOAD(0);
  for (int hd = 0; hd < RWH; ++hd) {
    const int bh = b * RWH + hd, c = hd * 64 + lane;
    __syncthreads();
    {
        LAS bf16_t* dst = (LAS bf16_t*)(lds + (xj0 < 64 ? rk2::XW : rk2::XA)) + xtt * 72 + (xj0 & 63);
        *(LAS u32x4*)dst = xin0; *(LAS u32x4*)(dst + 8) = xin1;
#pragma unroll
        for (int i = 0; i < 8; ++i) { const int idx = tid + NTHR * i, j = idx >> 6, cc = idx & 63;
            ((LAS bf16_t*)(lds + rk2::WUP))[cc * 72 + j] = (bf16_t)f2bf(wgt[i]); ((LAS bf16_t*)(lds + rk2::AUP))[cc * 72 + j] = (bf16_t)f2bf(wgt[8 + i]); }
    }
    float rr[8], kk_[8], vv[8];
    { const float mur = mu[c], muk = mu[640 + c], muv = mu[1280 + c];
      float rp = pmr * bf2f(raw[0]), kp = pmr * bf2f(raw[1]), vp = pmr * bf2f(raw[2]);
#pragma unroll
      for (int n = 0; n < 8; ++n) { const float rc = bf2f(raw[3 + 3 * n]), kc = bf2f(raw[4 + 3 * n]), vc = bf2f(raw[5 + 3 * n]);
          rr[n] = tshift(rc, rp, mur); kk_[n] = tshift(kc, kp, muk); vv[n] = tshift(vc, vp, muv); rp = rc; kp = kc; vp = vc; } }
    PREP_LOAD(hd + 1 < RWH ? hd + 1 : hd);
    __syncthreads();
    {
        const int mat = wv >> 2, mt = wv & 3; const LAS bf16_t* X = (const LAS bf16_t*)(lds + (mat ? rk2::XA : rk2::XW)) + 16 * mt * 72;
        const LAS bf16_t* W = (const LAS bf16_t*)(lds + (mat ? rk2::AUP : rk2::WUP)); LAS float* O = (LAS float*)(lds + (mat ? rk2::ALT : rk2::WLT));
        const f32x4 z = {0.f, 0.f, 0.f, 0.f};
#pragma unroll
        for (int nt = 0; nt < 4; ++nt) { const f32x4 cc = mm16(X, 72, W + 16 * nt * 72, 72, 2, z, l15, qq);
            *(LAS f32x4*)(O + (16 * nt + l15) * 68 + 16 * mt + 4 * qq) = cc; }
    }
    __syncthreads();
    float wl[8], al[8];
    { const f32x4 a0 = *(const LAS f32x4*)((LAS float*)(lds + rk2::WLT) + lane * 68 + 8 * wv), a1 = *(const LAS f32x4*)((LAS float*)(lds + rk2::WLT) + lane * 68 + 8 * wv + 4);
      const f32x4 b0 = *(const LAS f32x4*)((LAS float*)(lds + rk2::ALT) + lane * 68 + 8 * wv), b1 = *(const LAS f32x4*)((LAS float*)(lds + rk2::ALT) + lane * 68 + 8 * wv + 4);
#pragma unroll
      for (int n = 0; n < 4; ++n) { wl[n] = a0[n]; wl[n + 4] = a1[n]; al[n] = b0[n]; al[n + 4] = b1[n]; } }
    __syncthreads();
    const float w0 = p->in[4][layer * 640 + c], a0c = p->in[6][layer * 640 + c], kkc = p->in[9][layer * 640 + c], kac = p->in[10][layer * 640 + c], rkc = p->in[11][layer * 640 + c];
    float* BON = (float*)(p->ws + WS_BONUS);
    float ld[8], clv[8], k2[8], av[8], bv[8], run = 0.f;
#pragma unroll
    for (int n = 0; n < 8; ++n) {
        const float nx = -(w0 + wl[n]); const float sp = fmaxf(nx, 0.f) + __logf(1.0f + __expf(-fabsf(nx)));
        ld[n] = -__expf(-sp - 0.5f); run += ld[n]; clv[n] = run;
        const float a = __builtin_amdgcn_rcpf(1.0f + __expf(-(a0c + al[n])));
        const float kk = kk_[n] * kkc; const float nrm = __builtin_amdgcn_sqrtf(wave_sum(kk * kk)); const float kkn = kk * __builtin_amdgcn_rcpf(fmaxf(nrm, 1e-12f));
        k2[n] = kk_[n] * (1.0f + (a - 1.0f) * kac); av[n] = -kkn; bv[n] = kkn * a;
        const float bon = wave_sum(rr[n] * k2[n] * rkc);
        if (lane == 0) BON[((size_t)b * SEQ + s0 + wv * 8 + n) * 16 + hd] = bon;
    }
    hs[wv * 64 + lane] = run;
    __syncthreads();
    const float other = hs[(wv ^ 1) * 64 + lane]; const float pre = ch ? other : 0.f, tot = run + other;
    {
        float va[8], vb[8], vk[8], vkh[8], vbh[8];
        LAS bf16_t* at = (LAS bf16_t*)(cb + AT); LAS bf16_t* bt = (LAS bf16_t*)(cb + BT); LAS bf16_t* kt = (LAS bf16_t*)(cb + KT); LAS bf16_t* rm = (LAS bf16_t*)(cb + RM);
#pragma unroll
        for (int n = 0; n < 8; ++n) { const int i = 8 * ch + n; const float cl = pre + clv[n]; const float E = __expf(cl), Eex = __expf(cl - ld[n]), Einv = __expf(-cl), Eh = __expf(tot - cl);
            va[n] = av[n] * Eex; vb[n] = bv[n] * Einv; vk[n] = k2[n] * Einv; vkh[n] = k2[n] * Eh; vbh[n] = bv[n] * Eh;
            at[i * 72 + lane] = (bf16_t)f2bf(va[n]); bt[i * 72 + lane] = (bf16_t)f2bf(vb[n]); kt[i * 72 + lane] = (bf16_t)f2bf(vk[n]); rm[i * 104 + lane] = (bf16_t)f2bf(rr[n] * E); }
        u32x4 w;
        w.x = pk2(va[0], va[1]); w.y = pk2(va[2], va[3]); w.z = pk2(va[4], va[5]); w.w = pk2(va[6], va[7]); *(LAS u32x4*)((LAS bf16_t*)(cb + ATT) + lane * 40 + 8 * ch) = w;
        w.x = pk2(vkh[0], vkh[1]); w.y = pk2(vkh[2], vkh[3]); w.z = pk2(vkh[4], vkh[5]); w.w = pk2(vkh[6], vkh[7]); *(LAS u32x4*)((LAS bf16_t*)(cb + KBH) + lane * 40 + 8 * ch) = w;
        w.x = pk2(vbh[0], vbh[1]); w.y = pk2(vbh[2], vbh[3]); w.z = pk2(vbh[4], vbh[5]); w.w = pk2(vbh[6], vbh[7]); *(LAS u32x4*)((LAS bf16_t*)(cb + KBH) + lane * 40 + 16 + 8 * ch) = w;
        w.x = pk2(vv[0], vv[1]); w.y = pk2(vv[2], vv[3]); w.z = pk2(vv[4], vv[5]); w.w = pk2(vv[6], vv[7]); *(LAS u32x4*)((LAS bf16_t*)(cb + PVT) + lane * 40 + 8 * ch) = w;
        const u32x4 zz = {0u, 0u, 0u, 0u};
        *(LAS u32x4*)((LAS bf16_t*)(cb + ATT) + lane * 40 + 16 + 8 * ch) = zz;
        if (lane < 16) { *(LAS u32x4*)((LAS bf16_t*)(cb + NKT) + lane * 40 + 16 + 8 * ch) = zz; *(LAS u32x4*)((LAS bf16_t*)(cb + TT) + lane * 40 + 16 + 8 * ch) = zz; *(LAS u32x4*)((LAS bf16_t*)(cb + WT) + lane * 104 + 80 + 8 * ch) = zz; }
        if (ch == 0) ((LAS float*)(cb + E15))[lane] = __expf(tot);
    }
    __syncthreads();
    {
        const LAS bf16_t* at = (const LAS bf16_t*)(cb + AT); const LAS bf16_t* bt = (const LAS bf16_t*)(cb + BT); const LAS bf16_t* kt = (const LAS bf16_t*)(cb + KT); LAS bf16_t* rm = (LAS bf16_t*)(cb + RM);
        const f32x4 z = {0.f, 0.f, 0.f, 0.f};
        if (ch == 0) {
            f32x4 nab = mm16(at, 72, bt, 72, 2, z, l15, qq), nak = mm16(at, 72, kt, 72, 2, z, l15, qq);
#pragma unroll
            for (int g = 0; g < 4; ++g) { const bool ok = l15 < 4 * qq + g; ((LAS float*)(cb + NAB))[(4 * qq + g) * 20 + l15] = ok ? nab[g] : 0.f; nak[g] = ok ? nak[g] : 0.f; }
            store_t((LAS bf16_t*)(cb + NKT) + l15 * 40 + 4 * qq, nak);
            asm volatile("s_waitcnt lgkmcnt(0)" ::: "memory");
            if (lane < 16) {
                const LAS float* nabr = (const LAS float*)(cb + NAB); LAS bf16_t* tt = (LAS bf16_t*)(cb + TT);
                float tc[16];
#pragma unroll
                for (int i = 0; i < 16; ++i) { float acc = (i == lane) ? 1.f : 0.f;
#pragma unroll
                    for (int j4 = 0; j4 < 16; j4 += 4) { if (j4 < i) { const f32x4 nr = *(const LAS f32x4*)(nabr + i * 20 + j4);
#pragma unroll
                            for (int j = 0; j < 4; ++j) if (j4 + j < i) acc += nr[j] * tc[j4 + j]; } }
                    tc[i] = acc; tt[i * 40 + lane] = (bf16_t)f2bf(acc); }
            }
        } else {
            f32x4 mrk = mm16(kt, 72, rm, 104, 2, z, l15, qq), mrb = mm16(bt, 72, rm, 104, 2, z, l15, qq);
#pragma unroll
            for (int g = 0; g < 4; ++g) { const bool ok = 4 * qq + g <= l15; mrk[g] = ok ? mrk[g] : 0.f; mrb[g] = ok ? mrb[g] : 0.f; }
            store_t(rm + l15 * 104 + 64 + 4 * qq, mrk); store_t(rm + l15 * 104 + 80 + 4 * qq, mrb);
        }
    }
    __syncthreads();
    {
        const LAS bf16_t* att = (const LAS bf16_t*)(cb + ATT); const LAS bf16_t* tt = (const LAS bf16_t*)(cb + TT); LAS bf16_t* wt = (LAS bf16_t*)(cb + WT);
        const f32x4 z = {0.f, 0.f, 0.f, 0.f};
#pragma unroll
        for (int mm = 0; mm < 2; ++mm) { const int mt = 2 * ch + mm; const f32x4 cc = mm16(att + 16 * mt * 40, 40, tt, 40, 1, z, l15, qq); store_t(wt + l15 * 104 + 16 * mt + 4 * qq, cc); }
        if (ch == 0) { const f32x4 cc = mm16((const LAS bf16_t*)(cb + NKT), 40, tt, 40, 1, z, l15, qq); store_t(wt + l15 * 104 + 64 + 4 * qq, cc); }
    }
    __syncthreads();
    {
        unsigned char* pk = p->ws + WS_SCAN + ((size_t)bh * (SEQ / 16) + (size_t)tile * 4) * rk2::P_SZ;
        for (int idx = tid; idx < 4 * 192; idx += NTHR) { const int q = idx / 192, rem = idx % 192, row = rem / 12, pc = rem % 12;
            *(u32x4*)(pk + (size_t)q * rk2::P_SZ + rk2::P_WT + (row * 96 + pc * 8) * 2) = *(const LAS u32x4*)((const LAS bf16_t*)(lds + q * CHB + WT) + row * 104 + pc * 8);
            *(u32x4*)(pk + (size_t)q * rk2::P_SZ + rk2::P_RM + (row * 96 + pc * 8) * 2) = *(const LAS u32x4*)((const LAS bf16_t*)(lds + q * CHB + RM) + row * 104 + pc * 8); }
        for (int idx = tid; idx < 4 * 256; idx += NTHR) { const int q = idx >> 8, rem = idx & 255, row = rem >> 2, pc = rem & 3;
            *(u32x4*)(pk + (size_t)q * rk2::P_SZ + rk2::P_KBH + (row * 32 + pc * 8) * 2) = *(const LAS u32x4*)((const LAS bf16_t*)(lds + q * CHB + KBH) + row * 40 + pc * 8); }
        { const int q = tid >> 7, rem = tid & 127, row = rem >> 1, pc = rem & 1;
          *(u32x4*)(pk + (size_t)q * rk2::P_SZ + rk2::P_VT + (row * 16 + pc * 8) * 2) = *(const LAS u32x4*)((const LAS bf16_t*)(lds + q * CHB + PVT) + row * 40 + pc * 8); }
        if (tid < 64) { const int q = tid >> 4, pc = tid & 15; *(u32x4*)(pk + (size_t)q * rk2::P_SZ + rk2::P_E15 + pc * 16) = *(const LAS u32x4*)(lds + q * CHB + E15 + pc * 16); }
    }
  }
#undef PREP_LOAD
}
namespace rk3 {
constexpr int L_WT = 0, L_RM = 3328, L_KBH = 6656, L_VT = 11776, L_E15 = 14848, L_SZ = 15104, NBATCH = 4, BUF0 = 16384, BUFB = NBATCH * L_SZ;
static_assert(BUF0 + 2 * BUFB <= MISC_OFF, "rwkv chain LDS map");
typedef float f32x2_ __attribute__((ext_vector_type(2))); typedef __bf16 bf16x2_ __attribute__((ext_vector_type(2)));
__device__ __forceinline__ unsigned cvt2(float a, float b) { const f32x2_ v = {a, b}; const bf16x2_ r = __builtin_convertvector(v, bf16x2_); return __builtin_bit_cast(unsigned, r); }
constexpr int NPIECE = 784;
__device__ __forceinline__ int lds_off(int r) {
    const int a0 = L_WT + (r / 12) * 208 + (r % 12) * 16; const int x1 = r - 192, a1 = L_RM + (x1 / 12) * 208 + (x1 % 12) * 16;
    const int x2 = r - 384, a2 = L_KBH + (x2 >> 2) * 80 + (x2 & 3) * 16; const int x3 = r - 640, a3 = L_VT + (x3 >> 1) * 48 + (x3 & 1) * 16; const int a4 = L_E15 + (r - 768) * 16;
    return r < 192 ? a0 : (r < 384 ? a1 : (r < 640 ? a2 : (r < 768 ? a3 : a4)));
}
}
__device__ __forceinline__ void rwkv_chain_unit(PX p, int bh, LAS unsigned char* lds) {
    using namespace rk;
    const int tid = otid(p.wvs), lane = tid & 63, wv = __builtin_amdgcn_readfirstlane(tid >> 6), l15 = lane & 15, qq = lane >> 4, b = bh / RWH, hd = bh % RWH;
    const unsigned char* pk = p->ws + WS_SCAN + (size_t)bh * (SEQ / 16) * rk2::P_SZ;
    constexpr int NB_ = (SEQ / 16) / rk3::NBATCH, PPB = rk3::NBATCH * rk3::NPIECE;
    __syncthreads();
    if (wv >= 4) {
        const int lt = tid - 256; u32x4 sa[13], sb_[13];
#define RK_LD(st, bi) do { const unsigned char* g_ = pk + (size_t)((bi) < NB_ ? (bi) : NB_ - 1) * rk3::NBATCH * rk2::P_SZ; \
        _Pragma("unroll") for (int i = 0; i < 13; ++i) { int x = lt + 256 * i; x = x < PPB ? x : PPB - 1; st[i] = __builtin_nontemporal_load((const u32x4*)(g_ + (size_t)x * 16)); } } while (0)
#define RK_ST(st, bi) do { LAS unsigned char* d_ = lds + rk3::BUF0 + ((bi) & 1) * rk3::BUFB; \
        _Pragma("unroll") for (int i = 0; i < 13; ++i) { int x = lt + 256 * i; x = x < PPB ? x : PPB - 1; const int q = x / rk3::NPIECE, r = x % rk3::NPIECE; *(LAS u32x4*)(d_ + q * rk3::L_SZ + rk3::lds_off(r)) = st[i]; } } while (0)
        asm volatile("; RKLOADER begin");
        RK_LD(sa, 0); RK_LD(sb_, 1); RK_ST(sa, 0); RK_LD(sa, 2);
        __syncthreads();
        for (int bi = 0; bi < NB_; bi += 2) {
            RK_ST(sb_, bi + 1); RK_LD(sb_, bi + 3); __syncthreads();
            RK_ST(sa, bi + 2); RK_LD(sa, bi + 4); __syncthreads();
        }
#undef RK_LD
#undef RK_ST
        return;
    }
    float* Y = (float*)(p->ws + WS_YRAW) + (size_t)b * SEQ * 640 + hd * 64 + 16 * wv + l15;
    f32x4 ST[4];
#pragma unroll
    for (int m = 0; m < 4; ++m) ST[m] = (f32x4){0.f, 0.f, 0.f, 0.f};
    __syncthreads();
#define RK_PK(v) rk3::cvt2((v)[0], (v)[1]), rk3::cvt2((v)[2], (v)[3])
#define RK_F8(lo, hi) ({ const u32x4 w_ = {(lo).x, (lo).y, (hi).x, (hi).y}; *reinterpret_cast<const bf16x8*>(&w_); })
    for (int bi = 0; bi < NB_; ++bi) {
#pragma unroll
        for (int q = 0; q < rk3::NBATCH; ++q) {
            const LAS unsigned char* cc = lds + rk3::BUF0 + (bi & 1) * rk3::BUFB + q * rk3::L_SZ;
            const LAS bf16_t* wt = (const LAS bf16_t*)(cc + rk3::L_WT) + l15 * 104 + 4 * qq; const LAS bf16_t* rm = (const LAS bf16_t*)(cc + rk3::L_RM) + l15 * 104 + 4 * qq;
            const LAS bf16_t* kbh = (const LAS bf16_t*)(cc + rk3::L_KBH) + l15 * 40 + 4 * qq; const LAS float* e15 = (const LAS float*)(cc + rk3::L_E15) + 4 * qq;
            const u32x2 vtf = *(const LAS u32x2*)((const LAS bf16_t*)(cc + rk3::L_VT) + (16 * wv + l15) * 24 + 4 * qq);
            const u32x2 w00 = *(const LAS u32x2*)(wt), w01 = *(const LAS u32x2*)(wt + 16), w10 = *(const LAS u32x2*)(wt + 32), w11 = *(const LAS u32x2*)(wt + 48), wtn = *(const LAS u32x2*)(wt + 64);
            const u32x2 r00 = *(const LAS u32x2*)(rm), r01 = *(const LAS u32x2*)(rm + 16), r10 = *(const LAS u32x2*)(rm + 32), r11 = *(const LAS u32x2*)(rm + 48), rmk = *(const LAS u32x2*)(rm + 64), rmb = *(const LAS u32x2*)(rm + 80);
            const u32x2 zz = {0u, 0u};
            const u32x2 s00 = {RK_PK(ST[0])}, s01 = {RK_PK(ST[1])}, s10 = {RK_PK(ST[2])}, s11 = {RK_PK(ST[3])};
            const bf16x8 sf0 = RK_F8(s00, s01), sf1 = RK_F8(s10, s11);
            f32x4 P = {0.f, 0.f, 0.f, 0.f};
            P = __builtin_amdgcn_mfma_f32_16x16x32_bf16(RK_F8(w00, w01), sf0, P, 0, 0, 0);
            P = __builtin_amdgcn_mfma_f32_16x16x32_bf16(RK_F8(w10, w11), sf1, P, 0, 0, 0);
            P = __builtin_amdgcn_mfma_f32_16x16x32_bf16(RK_F8(wtn, zz), RK_F8(vtf, zz), P, 0, 0, 0);
            const u32x2 pp = {RK_PK(P)};
            const bf16x8 pvf = RK_F8(vtf, pp);
            f32x4 Yc = {0.f, 0.f, 0.f, 0.f};
            Yc = __builtin_amdgcn_mfma_f32_16x16x32_bf16(RK_F8(r00, r01), sf0, Yc, 0, 0, 0);
            Yc = __builtin_amdgcn_mfma_f32_16x16x32_bf16(RK_F8(r10, r11), sf1, Yc, 0, 0, 0);
            Yc = __builtin_amdgcn_mfma_f32_16x16x32_bf16(RK_F8(rmk, rmb), pvf, Yc, 0, 0, 0);
#pragma unroll
            for (int m = 0; m < 4; ++m) { const u32x2 k0 = *(const LAS u32x2*)(kbh + 16 * m * 40), k1 = *(const LAS u32x2*)(kbh + 16 * m * 40 + 16);
                ST[m] = __builtin_amdgcn_mfma_f32_16x16x32_bf16(RK_F8(k0, k1), pvf, ST[m] * *(const LAS f32x4*)(e15 + 16 * m), 0, 0, 0); }
            float* yo = Y + ((size_t)(bi * rk3::NBATCH + q) * 16 + 4 * qq) * 640;
#pragma unroll
            for (int g = 0; g < 4; ++g) yo[(size_t)g * 640] = Yc[g];
        }
        __syncthreads();
    }
#undef RK_PK
#undef RK_F8
}
#define XB_TMO      128
#define XB_XCNT(j)  (256  + 64 * (j))
#define XB_XSUB(j)  (1280 + 64 * (j))
#define XB_XGEN(j)  (2304 + 64 * (j))
#define XB_TOP      3328
#define XB_TOPGEN   3392
#define XCD_BAR_WORDS 3456
#define XB_SPIN_CAP (1u << 18)

__device__ __forceinline__ unsigned xb_ld(unsigned* p)              { return __hip_atomic_load(p, __ATOMIC_RELAXED, __HIP_MEMORY_SCOPE_AGENT); }
__device__ __forceinline__ unsigned xb_add(unsigned* p, unsigned v) { return __hip_atomic_fetch_add(p, v, __ATOMIC_RELAXED, __HIP_MEMORY_SCOPE_AGENT); }
__device__ __forceinline__ unsigned xb_xcc_id() { return (unsigned)__builtin_amdgcn_s_getreg((3 << 11) | 20) & 0xFu; }
#define XB_SPIN(cond, bar) do { unsigned _sp = 0; while (cond) { __builtin_amdgcn_s_sleep(1); \
    if ((++_sp & 255u) == 0u) { if (xb_ld(&(bar)[XB_TMO])) break; if (_sp > XB_SPIN_CAP) { atomicAdd(&(bar)[XB_TMO], 1u); break; } } } } while (0)

struct XcdBarrier {
    bool lead;
    unsigned* bar; unsigned x;
    volatile LAS unsigned* st;
};

__device__ __forceinline__ XcdBarrier xcd_barrier_post(unsigned* bar, volatile LAS unsigned* st) {
    XcdBarrier b; b.bar = bar; b.x = xb_xcc_id(); b.st = st;
    if (threadIdx.x == 0) (void)xb_add(&bar[XB_XCNT(b.x)], 1u);
    return b;
}
__device__ __forceinline__ void xcd_barrier_complete(unsigned* bar, unsigned x, unsigned& nloc, unsigned& nx) {
    const unsigned G = gridDim.x * gridDim.y * gridDim.z;
    unsigned sum, cnt, mine, sp = 0u;
    for (;;) {
        sum = 0u; cnt = 0u; mine = 0u;
#pragma unroll
        for (unsigned j = 0; j < 16; ++j) { const unsigned c = xb_ld(&bar[XB_XCNT(j)]); sum += c; cnt += (c > 0u) ? 1u : 0u; mine = (j == x) ? c : mine; }
        if (sum == G) break;
        __builtin_amdgcn_s_sleep(1);
        if ((++sp & 255u) == 0u) { if (xb_ld(&bar[XB_TMO])) break; if (sp > XB_SPIN_CAP) { atomicAdd(&bar[XB_TMO], 1u); break; } }
    }
    nloc = mine > 0u ? mine : 1u; nx = cnt > 0u ? cnt : 1u;
}

__device__ __forceinline__ void xcd_barrier(const XcdBarrier& b) {
    asm volatile("s_waitcnt vmcnt(0)" ::: "memory");
    __syncthreads();
    if (b.lead) {
        unsigned* bar = b.bar;
        __builtin_amdgcn_s_waitcnt(0);
        unsigned nloc = b.st[0], nx = b.st[1];
        if (nloc == 0u) { xcd_barrier_complete(bar, b.x, nloc, nx); b.st[0] = nloc; b.st[1] = nx; }
        const unsigned old = xb_add(&bar[XB_XSUB(b.x)], 1u);
        const unsigned gen = old / nloc;
        if (old + 1u == (gen + 1u) * nloc) {
            __builtin_amdgcn_fence(__ATOMIC_RELEASE, "agent");
            asm volatile("s_waitcnt vmcnt(0)" ::: "memory");
            const unsigned og = xb_add(&bar[XB_TOP], 1u);
            const unsigned tg = og / nx;
            if (og + 1u == (tg + 1u) * nx) xb_add(&bar[XB_TOPGEN], 1u);
            else XB_SPIN(xb_ld(&bar[XB_TOPGEN]) == tg, bar);
            __builtin_amdgcn_fence(__ATOMIC_ACQUIRE, "agent");
            xb_add(&bar[XB_XGEN(b.x)], 1u);
            asm volatile("s_waitcnt vmcnt(0)" ::: "memory");
        } else {
            XB_SPIN(xb_ld(&bar[XB_XGEN(b.x)]) == gen, bar);
            __builtin_amdgcn_fence(__ATOMIC_ACQUIRE, "agent");
            asm volatile("s_waitcnt vmcnt(0)" ::: "memory");
        }
    }
    __syncthreads();
}
#ifndef MK_WGM_IN
#define MK_WGM_IN 8
#endif
#ifndef MK_WGM_OUT
#define MK_WGM_OUT 4
#endif
#ifndef MK_WGM_UP
#define MK_WGM_UP 4
#endif
#ifndef MK_WGM_DN
#define MK_WGM_DN 4
#endif
#ifndef MK_RET_SIMPLE
#define MK_RET_SIMPLE 0
#endif
constexpr int N_SCAN_UNITS = MK_RWKV_CHUNK ? NB * RWH : NB * RWH * 2, N_RET_UNITS = NB * RETH * RET_G, N_ATT_ITEMS = NB * FOXH * (SEQ / 256);
__device__ __forceinline__ void phase_pre(PX p, int layer, LAS unsigned char* lds) {
    constexpr int NFOX = NB * FOXH, NNRM = NB * FOXH * (SEQ / 256), NKV = NB * RETH * (SEQ / 128) + NNRM, NPRE = MK_RWKV_SPLIT ? NB * (SEQ / 64) : NB * RWH * (SEQ / 64);
    for (int u = blockIdx.x; u < NFOX + NKV + NPRE; u += gridDim.x) { if (u < NFOX) fox_scan_unit(p, layer, u, lds); else if (u < NFOX + NNRM) fox_norm_unit(p, u - NFOX, lds); else if (u < NFOX + NKV) ret_kv_unit(p, u - NFOX - NNRM, lds); else {
#if MK_RWKV_SPLIT
            rwkv_prep_unit(p, layer, u - NFOX - NKV, lds);
#else
            rwkv_pre_unit(p, layer, u - NFOX - NKV, lds);
#endif
        } }
}
typedef fox::BlockRef<fox::bf16, fox::bf16> FoxRef;
__device__ __forceinline__ int fox_jlo(const unsigned char* ws, int bh, int qb) {
    const float* C = (const float*)(ws + WS_FOXC) + (size_t)bh * SEQ; const int P0 = qb * 256;
    const float* qn = (const float*)(ws + FOX_QN) + bh * 32; const float* kn = (const float*)(ws + FOX_KN) + bh * 32; float kmax = 0.f;
    for (int j = 0; j <= qb; ++j) kmax = fmaxf(kmax, kn[j]);
    const float thr = C[P0] - (110.0f * (1.0f / fox::SCALE) + 2.0f * qn[qb] * kmax);
    int lo = 0, hi = P0 / 64;
    while (lo < hi) { const int mid = (lo + hi) >> 1; if (C[64 * mid + 63] >= thr) hi = mid; else lo = mid + 1; }
    return lo;
}
__device__ __forceinline__ FoxRef fox_ref(const unsigned char* ws, int ent) {
    const int it = ent & 1023, qb = (SEQ / 256 - 1) - it / (NB * FOXH), bh = it % (NB * FOXH), b = bh / FOXH, hh = bh % FOXH;
    const fox::bf16* H = (const fox::bf16*)(ws + WS_H); FoxRef r;
    r.Q = H + ((size_t)b * SEQ + (size_t)qb * 256) * PINP + C_FQ + hh * 128;
    r.K = H + (size_t)b * SEQ * PINP + C_FK + hh * 128; r.V = H + (size_t)b * SEQ * PINP + C_FV + hh * 128;
    r.O = (fox::bf16*)(ws + WS_XB) + ((size_t)b * SEQ + (size_t)qb * 256) * DM + MIX_FOX + hh * 128;
    r.C = (const float*)(ws + WS_FOXC) + (size_t)bh * SEQ; r.P0 = qb * 256; r.JLO = (ent >> 10) & 255;
    return r;
}
constexpr int ATT_TAB = 140288;
__device__ __forceinline__ void att_build_order(PX p, LAS unsigned char* lds) {
    const int tid = otid(p.wvs); LAS unsigned* tab = (LAS unsigned*)(lds + ATT_TAB);
    LAS float* CE = (LAS float*)lds;
    LAS float* KMP = CE + 24 * 128;
    const float* Cg = (const float*)(p->ws + WS_FOXC); const float* kn = (const float*)(p->ws + FOX_KN);
#pragma unroll
    for (int i = 0; i < 6; ++i) { const int e = tid + NTHR * i, bh = e >> 7, j = e & 127; CE[e] = Cg[(size_t)bh * SEQ + 64 * j + 63]; }
    if (tid < 24) { float m = 0.f;
        for (int j = 0; j < 32; ++j) { m = fmaxf(m, kn[tid * 32 + j]); KMP[tid * 32 + j] = m; } }
    __syncthreads();
#pragma unroll
    for (int e2 = 0; e2 < 2; ++e2) { const int it = tid + NTHR * e2; unsigned key = 0u;
        if (it < N_ATT_ITEMS) { const int qb = (SEQ / 256 - 1) - it / (NB * FOXH), bh = it % (NB * FOXH), P0 = qb * 256;
            const float thr = Cg[(size_t)bh * SEQ + P0] - (110.0f * (1.0f / fox::SCALE) + 2.0f * ((const float*)(p->ws + FOX_QN))[bh * 32 + qb] * KMP[bh * 32 + qb]);
            int lo = 0, hi = P0 / 64;
            while (lo < hi) { const int mid = (lo + hi) >> 1; if (CE[bh * 128 + mid] >= thr) hi = mid; else lo = mid + 1; }
            key = ((unsigned)(4 * (qb + 1) - lo) << 18) | ((unsigned)lo << 10) | (unsigned)it; }
        tab[it] = key; }
    __syncthreads();
    for (int kk = 2; kk <= 1024; kk <<= 1)
        for (int j = kk >> 1; j > 0; j >>= 1) {
            if (j >= 128) __syncthreads();
            const int i = ((tid / j) * 2 * j) + (tid % j), l = i + j; const unsigned a = tab[i], c = tab[l]; const bool desc = (i & kk) == 0;
            if (desc ? (a < c) : (a > c)) { tab[i] = c; tab[l] = a; }
            if (j >= 128) __syncthreads(); else asm volatile("s_waitcnt lgkmcnt(0)" ::: "memory");
        }
    __syncthreads();
}
__device__ __forceinline__ int att_fetch(bool lead, unsigned* head, volatile LAS unsigned* slot) {
    if (lead) *slot = __hip_atomic_fetch_add(head, 1u, __ATOMIC_RELAXED, __HIP_MEMORY_SCOPE_AGENT);
    __syncthreads();
    return __builtin_amdgcn_readfirstlane((int)*slot);
}
__device__ __forceinline__ void phase_mix(PX p, int qslot, int layer, unsigned char* lds_g, LAS unsigned char* lds) {
    att_build_order(p, lds);
    for (int u = blockIdx.x; u < N_SCAN_UNITS + N_RET_UNITS; u += gridDim.x) {
#ifndef NO_SCAN
        if (u < N_SCAN_UNITS) {
#if MK_RWKV_SPLIT
            rwkv_chain_unit(p, u, lds);
#elif MK_RWKV_CHUNK
            rwkv_chunk_unit(p, u, lds);
#else
            rwkv_scan_unit(p, u, lds);
#endif
#ifdef MK_SCAN2
            __syncthreads(); rwkv_chain_unit(p, u, lds);
#endif
        }
#endif
#ifndef NO_RET
#if MK_RET_SIMPLE
        if (u >= N_SCAN_UNITS) ret_simple_unit(p, layer, u - N_SCAN_UNITS, lds);
#else
        if (u >= N_SCAN_UNITS) { ret_mfma_unit(p, layer, u - N_SCAN_UNITS, lds);
#ifdef MK_RET2
            ret_mfma_unit(p, layer, u - N_SCAN_UNITS, lds);
#endif
        }
#endif
#endif
    }
    __syncthreads();
#ifdef MK_ATT2
    for (int arep = 0; arep < 2; ++arep) { const int qslot_ = qslot + 8 * arep;
#else
    { const int qslot_ = qslot;
#endif
    unsigned* head = (unsigned*)(p->ws + WS_CTL) + CW_QATT + 64 * qslot_;
    volatile LAS unsigned* slot = (volatile LAS unsigned*)(lds + MISC_OFF + 64);
#ifdef NO_ATT
    int it = N_ATT_ITEMS;
#else
    const bool lead = otid(p.wvs) == 0;
    int it = att_fetch(lead, head, slot);
#endif
    const LAS unsigned* tab = (const LAS unsigned*)(lds + ATT_TAB);
    if (it < N_ATT_ITEMS) {
        struct RF { CP p; __device__ __forceinline__ FoxRef operator()(int i) const { return fox_ref(p->ws, i); } } rf{p.p};
        fox::Seam<fox::bf16> S; S.wv = p.wvs;
        int ent = __builtin_amdgcn_readfirstlane((int)tab[it]);
        { const FoxRef cur = rf(ent); fox::causal_swa_prime<fox::bf16, fox::bf16>(cur, 1 << 30, (char*)lds_g, S); }
        for (;;) {
            const int itn = att_fetch(lead, head, slot); const bool last = itn >= N_ATT_ITEMS; const int entn = last ? ent : __builtin_amdgcn_readfirstlane((int)tab[itn]);
            fox::causal_swa_block<fox::bf16, fox::bf16, RF>(ent, entn, rf, SEQ, 1 << 30, (char*)lds_g, S);
            if (last) break;
            ent = entn;
        }
    }
    }
}

#ifndef MK_SPLIT
#define MK_SPLIT 0
#endif
constexpr int N_PHASES = DEPTH * 10;
__device__ __forceinline__ CP kargs() { CP q = (CP)__builtin_amdgcn_kernarg_segment_ptr(); asm volatile("; kargs" : "+s"(q)); return q; }
__global__ void __launch_bounds__(NTHR, 2) mk_fwd(Params p_unused) {
    extern __shared__ __attribute__((aligned(16))) unsigned char lds_raw[];
    LAS unsigned char* lds = (LAS unsigned char*)lds_raw;
    const int tid = threadIdx.x; const int wvs = __builtin_amdgcn_readfirstlane(tid >> 6);
    const PX p{kargs(), wvs};
    if (tid < 64) ((LAS unsigned*)(lds + MISC_OFF))[tid] = 0u;
    __syncthreads();
    if (!MK_SPLIT) (void)xcd_barrier_post((unsigned*)(p->ws + WS_CTL) + CW_BAR, (volatile LAS unsigned*)(lds + MISC_OFF) + 8);
#if MK_SPLIT
    const int lo = p->ph_lo, hi = p->ph_hi;
#else
    constexpr int lo = 0, hi = N_PHASES;
#endif
#ifndef MK_MASK
#define MK_MASK 0x3ff
#endif
#define IN(q) (((MK_MASK >> (q)) & 1) && lo <= l * 10 + (q) && l * 10 + (q) < hi)
#define SEAM(q) do { if (l * 10 + (q) + 1 < hi) { if (MK_SPLIT) {} else { XcdBarrier bar; bar.lead = otid(wvs) == 0; bar.bar = (unsigned*)(p->ws + WS_CTL) + CW_BAR; bar.x = xb_xcc_id(); bar.st = (volatile LAS unsigned*)(lds + MISC_OFF) + 8; xcd_barrier(bar); } } } while (0)
#define XB ((bf16_t*)(p->ws + WS_XB))
#define Hb ((bf16_t*)(p->ws + WS_H))
#define HID ((bf16_t*)(p->ws + WS_HID))
#define WinT ((const bf16_t*)(p->ws + WS_WIN))
#define WoutT ((const bf16_t*)(p->ws + WS_WOUT))
#define WupT ((const bf16_t*)(p->ws + WS_WUP))
#define WdnT ((const bf16_t*)(p->ws + WS_WDN))
#ifndef MK_REP
#define MK_REP 0
#endif
#define REPS(q) ((((MK_REP) >> (q)) & 1) ? 2 : 1)
#define LAYER_BODY(LL) do { constexpr int l = (LL); \
        if (l == 0 && IN(0)) for (int rep = 0; rep < REPS(0); ++rep) { const PX p{kargs(), wvs}; phase_prologue(p); phase_convert(p, l, lds); SEAM(0); }     \
        if (IN(1)) for (int rep = 0; rep < REPS(1); ++rep) { const PX p{kargs(), wvs}; \
            pg8::Gemm g{XB, WinT, M, PINP, DM}; pg8::StaticOrder S; S.init(M, PINP, (int)gridDim.x, (int)blockIdx.x); S.wv = wvs; S.wgm = MK_WGM_IN; \
            pg8::EpiInProj E{Hb, (float*)(p->ws + WS_FLOG)}; \
            pg8::gemm_phase<pg8::EpiInProj, pg8::StaticOrder, PG8_ALIGN, PG8_SP2>(lds, g, S, E); \
            SEAM(1); } \
        if (IN(2)) for (int rep = 0; rep < REPS(2); ++rep) { const PX p{kargs(), wvs}; phase_pre(p, l, lds); SEAM(2); } \
        if (IN(3)) for (int rep = 0; rep < REPS(3); ++rep) { const PX p{kargs(), wvs}; phase_mix(p, l + 4 * rep, l, lds_raw, lds); SEAM(3); } \
        if (IN(4)) for (int rep = 0; rep < REPS(4); ++rep) { const PX p{kargs(), wvs}; phase_post(p, l, lds); SEAM(4); } \
        if (IN(5)) for (int rep = 0; rep < REPS(5); ++rep) { const PX p{kargs(), wvs}; \
            pg8::Gemm g{XB, WoutT, M, DM, DM}; pg8::StaticOrder S; S.init(M, DM, (int)gridDim.x, (int)blockIdx.x); S.wv = wvs; S.wgm = MK_WGM_OUT; \
            pg8::EpiResid E{p->out, l > 0 ? (const float*)p->out : p->in[0], (const float*)(p->ws + WS_STATS) + (l > 0 ? 2 * M : 4 * M), l > 0 ? p->in[21] + (l - 1) * DM : (const float*)(p->ws + WS_STATS) + 6 * M, l > 0 ? p->in[22] + (l - 1) * DM : (const float*)(p->ws + WS_STATS) + 6 * M + DM}; \
            pg8::gemm_phase<pg8::EpiResid, pg8::StaticOrder, PG8_ALIGN, PG8_SP2>(lds, g, S, E); \
            SEAM(5); } \
        if (IN(6)) for (int rep = 0; rep < REPS(6); ++rep) { const PX p{kargs(), wvs}; phase_ln<false>(p, p->in[17] + l * DM, p->in[18] + l * DM, (float*)(p->ws + WS_STATS)); SEAM(6); } \
        if (IN(7)) for (int rep = 0; rep < REPS(7); ++rep) { const PX p{kargs(), wvs}; \
            pg8::Gemm g{XB, WupT, M, DFF, DM}; pg8::StaticOrder S; S.init(M, DFF, (int)gridDim.x, (int)blockIdx.x); S.wv = wvs; S.wgm = MK_WGM_UP; \
            pg8::EpiRelu2 E{HID, DFF}; \
            pg8::gemm_phase<pg8::EpiRelu2, pg8::StaticOrder, PG8_ALIGN, PG8_SP2>(lds, g, S, E); \
            SEAM(7); } \
        if (IN(8)) for (int rep = 0; rep < REPS(8); ++rep) { const PX p{kargs(), wvs}; \
            pg8::Gemm g{HID, WdnT, M, DM, DFF}; pg8::StaticOrder S; S.init(M, DM, (int)gridDim.x, (int)blockIdx.x); S.wv = wvs; S.wgm = MK_WGM_DN; \
            pg8::EpiResid E{p->out, (const float*)p->out, (const float*)(p->ws + WS_STATS), p->in[17] + l * DM, p->in[18] + l * DM}; \
            pg8::gemm_phase<pg8::EpiResid, pg8::StaticOrder, PG8_ALIGN, PG8_SP2>(lds, g, S, E); \
            SEAM(8); } \
        if (IN(9)) for (int rep = 0; rep < REPS(9); ++rep) { const PX p{kargs(), wvs}; if (l == DEPTH - 1) phase_ln<true>(p, p->in[21] + l * DM, p->in[22] + l * DM, nullptr); else { phase_ln<false>(p, p->in[21] + l * DM, p->in[22] + l * DM, (float*)(p->ws + WS_STATS) + 2 * M); phase_convert(p, l + 1, lds); } SEAM(9); } \
    } while (0)
    LAYER_BODY(0); LAYER_BODY(1); LAYER_BODY(2); LAYER_BODY(3);
#undef LAYER_BODY
#undef IN
#undef SEAM
#undef XB
#undef Hb
#undef HID
#undef WinT
#undef WoutT
#undef WupT
#undef WdnT
}

extern "C" void kernel_launch(void* const* d_in, const int* in_sizes, int n_in, void* d_out, int out_size, void* d_ws, size_t ws_size, hipStream_t stream) {
    static int grid = 0;
    if (grid == 0) {
        if (n_in != 23 || out_size != M * DM || ws_size < WS_END) { fprintf(stderr, "kernel_launch: unexpected shapes (n_in %d, out %d, ws %zu, need %zu)\n", n_in, out_size, ws_size, (size_t)WS_END); grid = -1; return; }
        int dev = 0, cus = 0, per_cu = 0;
        if (hipGetDevice(&dev) != hipSuccess || hipDeviceGetAttribute(&cus, hipDeviceAttributeMultiprocessorCount, dev) != hipSuccess) { grid = -1; return; }
        if (hipFuncSetAttribute((const void*)mk_fwd, hipFuncAttributeMaxDynamicSharedMemorySize, LDS_BYTES) != hipSuccess) { fprintf(stderr, "kernel_launch: hipFuncSetAttribute failed\n"); grid = -1; return; }
        if (hipOccupancyMaxActiveBlocksPerMultiprocessor(&per_cu, (const void*)mk_fwd, NTHR, LDS_BYTES) != hipSuccess || per_cu < 1) { fprintf(stderr, "kernel_launch: occupancy query says %d\n", per_cu); }
        (void)hipGetLastError();
        grid = cus;
    }
    if (grid < 0) return;
    (void)hipMemsetAsync((char*)d_ws + WS_CTL, 0, CTL_BYTES, stream);
    Params p{};
    for (int i = 0; i < 23; ++i) p.in[i] = (const float*)d_in[i];
    p.out = (float*)d_out; p.ws = (unsigned char*)d_ws;
#if MK_SPLIT
    for (int g = 0; g < N_PHASES; ++g) { p.ph_lo = g; p.ph_hi = g + 1; hipLaunchKernelGGL(mk_fwd, dim3(grid), dim3(NTHR), LDS_BYTES, stream, p); }
#else
    p.ph_lo = 0; p.ph_hi = N_PHASES; hipLaunchKernelGGL(mk_fwd, dim3(grid), dim3(NTHR), LDS_BYTES, stream, p);
#endif
}
```

```cpp
#include <hip/hip_runtime.h>
#include <hip/hip_bf16.h>
#include <cstdio>
#include <cstdint>
#include <cmath>
__device__ __forceinline__ int otid(int wvs) { int t; asm volatile("v_mbcnt_lo_u32_b32 %0, -1, 0\n\tv_mbcnt_hi_u32_b32 %0, -1, %0\n\tv_lshl_or_b32 %0, %1, 6, %0 ; otid" : "=&v"(t) : "s"(wvs)); return t; }
namespace pg8 {
#define PG8_LAS __attribute__((address_space(3)))
typedef unsigned short bf16_t;
typedef short bf16x8 __attribute__((ext_vector_type(8)));
typedef float f32x4 __attribute__((ext_vector_type(4)));
typedef unsigned u32x4 __attribute__((ext_vector_type(4)));
constexpr int BM = 256, BK = 64, HALF = 128, HTB = HALF * BK * 2  , STAGE_BYTES = 8 * HTB, NXCD = 8, WGM = 4;

__host__ __device__ __forceinline__ int lds_byte(int r, int c) { const int st = (r >> 4) * 2 + (c >> 5), rr = r & 15, cc = c & 31, ob = rr * 64 + cc * 2; return st * 1024 + (ob ^ (((ob >> 9) & 1) << 5)); }
__host__ __device__ __forceinline__ void stage_rc(int b, int& R, int& C) { const int st = b / 1024, sb = b % 1024, swz = sb ^ (((sb >> 9) & 1) << 5); R = (st >> 1) * 16 + swz / 64; C = (st & 1) * 32 + (swz % 64) / 2; }
__host__ __device__ __forceinline__ int perm32(int rho) { const int n = rho >> 4, i = rho & 15; return 8 * (i >> 2) + 4 * n + (i & 3); }

struct Unit { int pm, pn; };
struct Gemm { const bf16_t* A; const bf16_t* Bt; int M, N, K; };

struct StaticOrder {
    int nM, nN, nwg, G, c, wv, wgm = WGM;
    __host__ __device__ void init(int M, int N, int G_, int c_) { nM = M / BM; nN = N / BM; nwg = nM * nN; G = G_; c = c_; }
    __host__ __device__ bool next(int i, Unit& u) const {
        const long L = (long)i * G + c; if (L >= nwg) return false;
        int wgid = (int)L; { const int q = nwg / NXCD, r = nwg % NXCD, xcd = wgid % NXCD, off = wgid / NXCD; wgid = (xcd < r ? xcd * (q + 1) : r * (q + 1) + (xcd - r) * q) + off; }
        const int nig = wgm * nN, gid = wgid / nig, fm = gid * wgm, gsz = (nM - fm) < wgm ? (nM - fm) : wgm;
        u.pm = fm + ((wgid % nig) % gsz); u.pn = (wgid % nig) / gsz; return true;
    }
    __device__ __forceinline__ void a_ready(const Unit&) const {}
    __device__ __forceinline__ void done(const Unit&) const {}
};

__device__ __forceinline__ unsigned cvt_pk_bf16(float lo, float hi) { unsigned r; asm volatile("v_cvt_pk_bf16_f32 %0, %1, %2" : "=v"(r) : "v"(lo), "v"(hi)); return r; }
typedef float f32x2 __attribute__((ext_vector_type(2)));
__device__ __forceinline__ f32x2 gelu_pk(f32x2 v) {
    const f32x2 av = __builtin_elementwise_abs(v), d = av * 0.2316418882f + 1.0f;
    f32x2 t; t.x = __builtin_amdgcn_rcpf(d.x); t.y = __builtin_amdgcn_rcpf(d.y);
    f32x2 q = t * 0.5307027145f + (-0.7265760135f); q = q * t + 0.7107068705f; q = q * t + (-0.142248368f); q = q * t + 0.127414796f; q = q * t;
    const f32x2 s = (v * v) * (-0.72134752044f);
    f32x2 e; e.x = __builtin_amdgcn_exp2f(s.x); e.y = __builtin_amdgcn_exp2f(s.y);
    const f32x2 m = v * (q * e), r = v - m;
    f32x2 o; o.x = v.x < 0.f ? m.x : r.x; o.y = v.y < 0.f ? m.y : r.y; return o;
}

template <int ACT  > struct EpiBf16 {
    static constexpr bool PERM = true, AFTER_DRAIN = false; static_assert(ACT == 0 || ACT == 1, "EpiBf16: ACT is 0 (none) or 1 (gelu_pk)");
    bf16_t* O; int ldc; const float* bias; int split_cols; size_t split_stride; float scale0;
    __device__ __forceinline__ void operator()(const f32x4 (&acc)[2][2][4][2], const Unit& u, int wr, int wc, int fr, int fq) const {
        const int row0 = u.pm * BM + wr * 64 + fr; int colt = u.pn * BM; bf16_t* base = O;
        float sc = 1.f; if (split_cols) { const int t = colt / split_cols; base += (size_t)t * split_stride; colt -= t * split_cols; if (t == 0) sc = scale0; }
        const int col0 = colt + wc * 32 + 8 * fq, bcol0 = u.pn * BM + wc * 32 + 8 * fq;
        f32x4 bv[2][2];
#pragma unroll
        for (int bj = 0; bj < 2; ++bj)
#pragma unroll
            for (int n = 0; n < 2; ++n) bv[bj][n] = bias ? *(const f32x4*)(bias + bcol0 + bj * HALF + 4 * n) : (f32x4){0.f, 0.f, 0.f, 0.f};
#pragma unroll
        for (int ai = 0; ai < 2; ++ai)
#pragma unroll
            for (int m = 0; m < 4; ++m) { bf16_t* rowp = base + (size_t)(row0 + ai * HALF + m * 16) * ldc + col0;
#pragma unroll
                for (int bj = 0; bj < 2; ++bj) { f32x4 v0 = acc[ai][bj][m][0] + bv[bj][0], v1 = acc[ai][bj][m][1] + bv[bj][1];
                    if (ACT == 1) { f32x2 a = gelu_pk((f32x2){v0[0], v0[1]}), b = gelu_pk((f32x2){v0[2], v0[3]}), c = gelu_pk((f32x2){v1[0], v1[1]}), d = gelu_pk((f32x2){v1[2], v1[3]});
                        v0 = (f32x4){a.x, a.y, b.x, b.y}; v1 = (f32x4){c.x, c.y, d.x, d.y}; }
                    v0 = v0 * sc; v1 = v1 * sc; u32x4 w; w.x = cvt_pk_bf16(v0[0], v0[1]); w.y = cvt_pk_bf16(v0[2], v0[3]); w.z = cvt_pk_bf16(v1[0], v1[1]); w.w = cvt_pk_bf16(v1[2], v1[3]);
                    __builtin_nontemporal_store(w, (u32x4*)(rowp + bj * HALF)); } }
    }
};

struct PanelStats {
    unsigned* xbuf;
    unsigned* cnt;
    unsigned* tmo;
    int ntn; float eps;
    unsigned code;
    __device__ __forceinline__ bool run(const f32x4 (&v)[2][2][4][2], const Unit& u, int wr, int wc, int fr, int fq, PG8_LAS unsigned char* lds, int wid, int lane) const {
        typedef float f32x2v __attribute__((ext_vector_type(2)));
        PG8_LAS f32x2v* P = (PG8_LAS f32x2v*)lds;
        PG8_LAS f32x2v* S = (PG8_LAS f32x2v*)(lds + 8192);
        PG8_LAS unsigned* flag = (PG8_LAS unsigned*)(lds + 8192 + 2048);
#pragma unroll
        for (int ai = 0; ai < 2; ++ai)
#pragma unroll
            for (int m = 0; m < 4; ++m) {
                float s = 0.f;
#pragma unroll
                for (int bj = 0; bj < 2; ++bj)
#pragma unroll
                    for (int n = 0; n < 2; ++n) { const f32x4 x = v[ai][bj][m][n]; s += (x[0] + x[1]) + (x[2] + x[3]); }
                s += __shfl_xor(s, 16); s += __shfl_xor(s, 32);
                const float mw = s * (1.0f / 64.0f); float q = 0.f;
#pragma unroll
                for (int bj = 0; bj < 2; ++bj)
#pragma unroll
                    for (int n = 0; n < 2; ++n) { const f32x4 d = v[ai][bj][m][n] - mw; q += (d[0] * d[0] + d[1] * d[1]) + (d[2] * d[2] + d[3] * d[3]); }
                q += __shfl_xor(q, 16); q += __shfl_xor(q, 32);
                if (fq == 0) P[(ai * HALF + wr * 64 + m * 16 + fr) * 4 + wc] = (f32x2v){mw, q};
            }
        asm volatile("s_waitcnt lgkmcnt(0)" ::: "memory"); __builtin_amdgcn_s_barrier(); asm volatile("" ::: "memory");
#if defined(BROKEN_EXCHANGE_NO_WAIT)
#warning BROKEN CONTROL BUILD: the row-statistics exchange does not wait; results are wrong by design
        if (blockIdx.x >= 64) { const long long t0_ = clock64(); while (clock64() - t0_ < 60000) __builtin_amdgcn_s_sleep(8); }
#endif
        const int row = wid * 32 + (lane & 31);
        if (lane < 32) {
            const f32x2v a = P[row * 4 + 0], b = P[row * 4 + 1], c = P[row * 4 + 2], d = P[row * 4 + 3];
            const float mt = (a.x + b.x + c.x + d.x) * 0.25f;
            const float da = a.x - mt, db = b.x - mt, dc = c.x - mt, dd = d.x - mt;
            const float m2 = (a.y + b.y) + (c.y + d.y) + 64.0f * ((da * da + db * db) + (dc * dc + dd * dd));
            unsigned long long* slot = (unsigned long long*)xbuf + ((size_t)(u.pm * BM + row) * 4 + u.pn);
            __hip_atomic_store(slot, ((unsigned long long)__float_as_uint(m2) << 32) | __float_as_uint(mt), __ATOMIC_RELAXED, __HIP_MEMORY_SCOPE_AGENT);
        }
        asm volatile("s_waitcnt vmcnt(0)" ::: "memory");
        if (lane == 0) __hip_atomic_fetch_add(cnt + 64 * u.pm, 1u, __ATOMIC_RELAXED, __HIP_MEMORY_SCOPE_AGENT);
        if (wid == 0) {
            bool dead = false; const unsigned long long t0 = __builtin_amdgcn_s_memrealtime(); const unsigned want = 8u * (unsigned)ntn;
            for (;;) {
#if defined(BROKEN_EXCHANGE_NO_WAIT)
                break;
#endif
                if ((unsigned)__builtin_amdgcn_readfirstlane(__hip_atomic_load(cnt + 64 * u.pm, __ATOMIC_RELAXED, __HIP_MEMORY_SCOPE_AGENT)) >= want) break;
                if (__builtin_amdgcn_s_memrealtime() - t0 > 2000000ull) {
                    if (lane == 0) { unsigned expect = 0u; __hip_atomic_compare_exchange_strong(tmo + 1, &expect, code | (unsigned)(u.pm & 0xff), __ATOMIC_RELAXED, __ATOMIC_RELAXED, __HIP_MEMORY_SCOPE_AGENT);
                                     __hip_atomic_store(tmo, 1u, __ATOMIC_RELAXED, __HIP_MEMORY_SCOPE_AGENT); }
                    dead = true; break; }
                __builtin_amdgcn_s_sleep(2);
            }
            __builtin_amdgcn_fence(__ATOMIC_ACQUIRE, "agent");
            if (lane == 0) flag[0] = dead ? 1u : 0u;
        }
        asm volatile("s_waitcnt vmcnt(0) lgkmcnt(0)" ::: "memory"); __builtin_amdgcn_s_barrier(); asm volatile("" ::: "memory");
        const bool bad = flag[0] != 0u;
        if (lane < 32) {
            const unsigned long long* slot = (const unsigned long long*)xbuf + (size_t)(u.pm * BM + row) * 4; float mt[4], m2[4]; float ms = 0.f;
#pragma unroll
            for (int t = 0; t < 4; ++t) { if (t < ntn) { const unsigned long long w = __hip_atomic_load(slot + t, __ATOMIC_RELAXED, __HIP_MEMORY_SCOPE_AGENT); mt[t] = __uint_as_float((unsigned)w); m2[t] = __uint_as_float((unsigned)(w >> 32)); } else { mt[t] = 0.f; m2[t] = 0.f; } ms += mt[t]; }
            const float mean = ms / (float)ntn; float q = 0.f;
#pragma unroll
            for (int t = 0; t < 4; ++t) if (t < ntn) { const float dm = mt[t] - mean; q += m2[t] + 256.0f * dm * dm; }
            S[row] = (f32x2v){mean, 1.0f / sqrtf(q / (256.0f * (float)ntn) + eps)};
        }
        asm volatile("s_waitcnt lgkmcnt(0)" ::: "memory"); __builtin_amdgcn_s_barrier(); asm volatile("" ::: "memory");
        return bad;
    }
};
struct EpiLnRes {
    static constexpr bool PERM = false, AFTER_DRAIN = true;
    const float* base; float* out; int ldc; const float* bias; PanelStats st; unsigned poison;
    __device__ __forceinline__ void fused(f32x4 (&acc)[2][2][4][2], const Unit& u, int wr, int wc, int fr, int fq, PG8_LAS unsigned char* lds, int wid, int lane) const {
        typedef float f32x2v __attribute__((ext_vector_type(2)));
        const PG8_LAS f32x2v* S = (const PG8_LAS f32x2v*)(lds + 8192);
        const int col0 = u.pn * BM + wc * 32 + 4 * fq;
#pragma unroll
        for (int bj = 0; bj < 2; ++bj)
#pragma unroll
            for (int n = 0; n < 2; ++n) { const f32x4 bv = bias ? *(const f32x4*)(bias + col0 + bj * HALF + n * 16) : (f32x4){0.f, 0.f, 0.f, 0.f};
#pragma unroll
                for (int ai = 0; ai < 2; ++ai)
#pragma unroll
                    for (int m = 0; m < 4; ++m) acc[ai][bj][m][n] += bv; }
        f32x4 pre[4][2][2];
#pragma unroll
        for (int m = 0; m < 4; ++m) { const size_t off = (size_t)(u.pm * BM + wr * 64 + m * 16 + fr) * ldc + col0;
#pragma unroll
            for (int bj = 0; bj < 2; ++bj)
#pragma unroll
                for (int n = 0; n < 2; ++n) pre[m][bj][n] = *(const f32x4*)(base + off + bj * HALF + n * 16); }
        const bool bad = st.run(acc, u, wr, wc, fr, fq, lds, wid, lane) || poison != 0u;
        const float qnan = __builtin_nanf("");
#pragma unroll
        for (int ai = 0; ai < 2; ++ai)
#pragma unroll
            for (int m = 0; m < 4; ++m) { const int r = ai * HALF + wr * 64 + m * 16 + fr; const f32x2v sr = S[r]; const size_t off = (size_t)(u.pm * BM + r) * ldc + col0;
#pragma unroll
                for (int bj = 0; bj < 2; ++bj)
#pragma unroll
                    for (int n = 0; n < 2; ++n) { const f32x4 bs = ai == 0 ? pre[m][bj][n] : *(const f32x4*)(base + off + bj * HALF + n * 16); f32x4 o = bs + (acc[ai][bj][m][n] - sr.x) * sr.y;
                        if (bad) o = (f32x4){qnan, qnan, qnan, qnan}; *(f32x4*)(out + off + bj * HALF + n * 16) = o; }
                if (m & 1) asm volatile("" ::: "memory"); }
    }
};
struct EpiLnResLn {
    static constexpr bool PERM = false, AFTER_DRAIN = true;
    const float* base; float* out; bf16_t* xn; int ldc; const float* bias; PanelStats st1, st2; unsigned poison;
    __device__ __forceinline__ void fused(f32x4 (&acc)[2][2][4][2], const Unit& u, int wr, int wc, int fr, int fq, PG8_LAS unsigned char* lds, int wid, int lane) const {
        typedef float f32x2v __attribute__((ext_vector_type(2))); typedef unsigned u32x2v __attribute__((ext_vector_type(2)));
        const PG8_LAS f32x2v* S = (const PG8_LAS f32x2v*)(lds + 8192);
        const int col0 = u.pn * BM + wc * 32 + 4 * fq;
#pragma unroll
        for (int bj = 0; bj < 2; ++bj)
#pragma unroll
            for (int n = 0; n < 2; ++n) { const f32x4 bv = bias ? *(const f32x4*)(bias + col0 + bj * HALF + n * 16) : (f32x4){0.f, 0.f, 0.f, 0.f};
#pragma unroll
                for (int ai = 0; ai < 2; ++ai)
#pragma unroll
                    for (int m = 0; m < 4; ++m) acc[ai][bj][m][n] += bv; }
        bool bad = st1.run(acc, u, wr, wc, fr, fq, lds, wid, lane) || poison != 0u;
        const float qnan = __builtin_nanf("");
#pragma unroll
        for (int ai = 0; ai < 2; ++ai)
#pragma unroll
            for (int m = 0; m < 4; ++m) { const int r = ai * HALF + wr * 64 + m * 16 + fr; const f32x2v sr = S[r]; const size_t off = (size_t)(u.pm * BM + r) * ldc + col0;
#pragma unroll
                for (int bj = 0; bj < 2; ++bj)
#pragma unroll
                    for (int n = 0; n < 2; ++n) { const f32x4 bs = *(const f32x4*)(base + off + bj * HALF + n * 16); acc[ai][bj][m][n] = bs + (acc[ai][bj][m][n] - sr.x) * sr.y; }
                asm volatile("" : "+v"(acc[ai][0][m][0]), "+v"(acc[ai][0][m][1]), "+v"(acc[ai][1][m][0]), "+v"(acc[ai][1][m][1]));
                if (m & 1) asm volatile("" ::: "memory"); }
        const bool bad1 = bad;
        bad = st2.run(acc, u, wr, wc, fr, fq, lds, wid, lane) || bad;
#pragma unroll
        for (int ai = 0; ai < 2; ++ai)
#pragma unroll
            for (int m = 0; m < 4; ++m) { const int r = ai * HALF + wr * 64 + m * 16 + fr; const f32x2v sr = S[r]; const size_t off = (size_t)(u.pm * BM + r) * ldc + col0;
#pragma unroll
                for (int bj = 0; bj < 2; ++bj)
#pragma unroll
                    for (int n = 0; n < 2; ++n) { const f32x4 x1 = acc[ai][bj][m][n]; *(f32x4*)(out + off + bj * HALF + n * 16) = bad1 ? (f32x4){qnan, qnan, qnan, qnan} : x1;
                        const f32x4 o = (x1 - sr.x) * sr.y; u32x2v w; w.x = cvt_pk_bf16(o[0], o[1]); w.y = cvt_pk_bf16(o[2], o[3]);
                        if (bad) { w.x = 0x7fc07fc0u; w.y = 0x7fc07fc0u; } *(u32x2v*)(xn + off + bj * HALF + n * 16) = w; }
                asm volatile("" ::: "memory"); }
    }
};

template <class Epi, class Sched, bool ALIGN_EPI = false, bool SP2 = false>
__device__ __forceinline__ void gemm_phase(PG8_LAS unsigned char* lds, const Gemm g, const Sched& S, const Epi& E) {
    const int tid = otid(S.wv), wid = __builtin_amdgcn_readfirstlane(tid >> 6), lane = tid & 63, wr = wid >> 2, wc = wid & 3, fr = lane & 15, fq = lane >> 4;
    const int K = g.K, nt = K / BK;
    unsigned voffA[2], voffB[2];
#pragma unroll
    for (int i = 0; i < 2; ++i) { int R, C; stage_rc(tid * 16 + i * 8192, R, C); const int Rb = Epi::PERM ? ((R & ~31) + perm32(R & 31)) : R;
        voffA[i] = (unsigned)(R * K + C) * 2u; voffB[i] = (unsigned)(Rb * K + C) * 2u; }
    const size_t kstep = (size_t)(BK * 2);
    const size_t hstep = (size_t)HALF * K * 2;
    const size_t tstep = 2 * hstep;
    const unsigned ldsw = (unsigned)wid * 1024u;
    const int aoff = lds_byte(wr * 64 + fr, fq * 8), boff = lds_byte(wc * 32 + fr, fq * 8);
#define PG8_SA(b, h) (((b) * 2 + (h)) * HTB)
#define PG8_SB(b, h) ((4 + (b) * 2 + (h)) * HTB)
#define PG8_STAGE(bufoff, gbase, voff) do { _Pragma("unroll") for (int _i = 0; _i < 2; ++_i) \
        __builtin_amdgcn_global_load_lds((const unsigned*)((const char*)(gbase) + (voff)[_i]), (PG8_LAS unsigned*)(lds + (bufoff) + ldsw + _i * 8192), 16, 0, 0); } while (0)
#define PG8_LDA(dst, b, h) do { _Pragma("unroll") for (int m = 0; m < 4; ++m) _Pragma("unroll") for (int k = 0; k < 2; ++k) dst[m][k] = *(const PG8_LAS bf16x8*)(lds + PG8_SA(b, h) + aoff + m * 2048 + k * 1024); } while (0)
#define PG8_LDB(dst, b, h) do { _Pragma("unroll") for (int n = 0; n < 2; ++n) _Pragma("unroll") for (int k = 0; k < 2; ++k) dst[n][k] = *(const PG8_LAS bf16x8*)(lds + PG8_SB(b, h) + boff + n * 2048 + k * 1024); } while (0)
#define PG8_MMA(ai, bj, At, Bt) do { __builtin_amdgcn_s_setprio(1); _Pragma("unroll") for (int m = 0; m < 4; ++m) _Pragma("unroll") for (int n = 0; n < 2; ++n) _Pragma("unroll") for (int k = 0; k < 2; ++k) \
        acc[ai][bj][m][n] = __builtin_amdgcn_mfma_f32_16x16x32_bf16(Bt[n][k], At[m][k], acc[ai][bj][m][n], 0, 0, 0); __builtin_amdgcn_s_setprio(0); } while (0)
#define PG8_WAIT_V(n) asm volatile("s_waitcnt vmcnt(" #n ")" ::: "memory")
#define PG8_WAIT_L(n) asm volatile("s_waitcnt lgkmcnt(" #n ")" ::: "memory")
#define PG8_BAR __builtin_amdgcn_s_barrier()
#define PG8_SCHED __builtin_amdgcn_sched_barrier(0)
    Unit cur, nxt; int ui = 0;
    if (!S.next(0, cur)) return;
    f32x4 acc[2][2][4][2];
#pragma unroll
    for (int a = 0; a < 2; ++a)
#pragma unroll
        for (int b = 0; b < 2; ++b)
#pragma unroll
            for (int m = 0; m < 4; ++m)
#pragma unroll
                for (int n = 0; n < 2; ++n) acc[a][b][m][n] = (f32x4){0.f, 0.f, 0.f, 0.f};
    bf16x8 At[4][2], B0[2][2], B1[2][2];
    const char* cA = (const char*)g.A + (size_t)cur.pm * tstep; const char* cB = (const char*)g.Bt + (size_t)cur.pn * tstep;
    S.a_ready(cur);
    if constexpr (SP2) {
        PG8_STAGE(PG8_SB(0, 0), cB, voffB); PG8_STAGE(PG8_SB(0, 1), cB + hstep, voffB); PG8_STAGE(PG8_SA(0, 0), cA, voffA); PG8_STAGE(PG8_SA(0, 1), cA + hstep, voffA);
        if (wr == 1) PG8_BAR;
        PG8_WAIT_V(2); PG8_BAR;
        PG8_STAGE(PG8_SB(1, 0), cB + kstep, voffB); PG8_STAGE(PG8_SA(1, 0), cA + kstep, voffA); PG8_STAGE(PG8_SB(1, 1), cB + hstep + kstep, voffB);
        PG8_WAIT_V(6); PG8_BAR;
    } else {
        PG8_STAGE(PG8_SB(0, 0), cB, voffB); PG8_STAGE(PG8_SA(0, 0), cA, voffA); PG8_STAGE(PG8_SB(0, 1), cB + hstep, voffB); PG8_STAGE(PG8_SA(0, 1), cA + hstep, voffA);
        if (wr == 1) PG8_BAR;
        PG8_WAIT_V(4); PG8_BAR;
        PG8_STAGE(PG8_SB(1, 0), cB + kstep, voffB); PG8_STAGE(PG8_SA(1, 0), cA + kstep, voffA); PG8_STAGE(PG8_SB(1, 1), cB + hstep + kstep, voffB);
        PG8_WAIT_V(6); PG8_BAR;
    }
    for (;;) {
        const bool has_next = S.next(ui + 1, nxt);
        const char* nA = has_next ? (const char*)g.A + (size_t)nxt.pm * tstep : cA; const char* nB = has_next ? (const char*)g.Bt + (size_t)nxt.pn * tstep : cB;
        for (int t = 0; t < nt; t += 2) {
            const bool last = (t == nt - 2);
            const char* a1 = cA + (size_t)(t + 1) * kstep;
            const char* a2 = last ? nA : cA + (size_t)(t + 2) * kstep; const char* b2 = last ? nB : cB + (size_t)(t + 2) * kstep;
            const char* a3 = a2 + kstep; const char* b3 = b2 + kstep;
            if (last && has_next) S.a_ready(nxt);
            if constexpr (SP2) {
            PG8_LDB(B0, 0, 0); PG8_LDB(B1, 0, 1); PG8_SCHED; PG8_LDA(At, 0, 0); PG8_STAGE(PG8_SA(1, 1), a1 + hstep, voffA);
            PG8_WAIT_V(8); PG8_WAIT_L(0); PG8_BAR; PG8_MMA(0, 0, At, B0); PG8_MMA(0, 1, At, B1); PG8_BAR; PG8_SCHED;
            PG8_LDA(At, 0, 1); PG8_STAGE(PG8_SB(0, 0), b2, voffB); PG8_STAGE(PG8_SB(0, 1), b2 + hstep, voffB); PG8_STAGE(PG8_SA(0, 0), a2, voffA);
            PG8_WAIT_V(8); PG8_WAIT_L(0); PG8_BAR; PG8_MMA(1, 0, At, B0); PG8_MMA(1, 1, At, B1); PG8_BAR; PG8_SCHED;
            PG8_LDB(B0, 1, 0); PG8_LDB(B1, 1, 1); PG8_SCHED; PG8_LDA(At, 1, 0); PG8_STAGE(PG8_SA(0, 1), a2 + hstep, voffA);
            PG8_WAIT_V(8); PG8_WAIT_L(0); PG8_BAR; PG8_MMA(0, 0, At, B0); PG8_MMA(0, 1, At, B1); PG8_BAR; PG8_SCHED;
            PG8_LDA(At, 1, 1); PG8_STAGE(PG8_SB(1, 0), b3, voffB); PG8_STAGE(PG8_SB(1, 1), b3 + hstep, voffB); PG8_STAGE(PG8_SA(1, 0), a3, voffA);
            PG8_WAIT_V(8); PG8_WAIT_L(0); PG8_BAR; PG8_MMA(1, 0, At, B0); PG8_MMA(1, 1, At, B1); PG8_BAR; PG8_SCHED;
            } else {
            PG8_LDB(B0, 0, 0); PG8_SCHED; PG8_LDA(At, 0, 0); PG8_STAGE(PG8_SA(1, 1), a1 + hstep, voffA);
            PG8_WAIT_L(8); PG8_BAR; PG8_WAIT_L(0); PG8_MMA(0, 0, At, B0); PG8_BAR; PG8_SCHED;
            PG8_LDB(B1, 0, 1); PG8_STAGE(PG8_SB(0, 0), b2, voffB);
            PG8_BAR; PG8_WAIT_L(0); PG8_MMA(0, 1, At, B1); PG8_BAR;
            PG8_LDA(At, 0, 1); PG8_STAGE(PG8_SA(0, 0), a2, voffA);
            PG8_BAR; PG8_WAIT_L(0); PG8_MMA(1, 0, At, B0); PG8_BAR; PG8_SCHED;
            PG8_STAGE(PG8_SB(0, 1), b2 + hstep, voffB);
            PG8_WAIT_V(6); PG8_BAR; PG8_MMA(1, 1, At, B1); PG8_BAR;
            PG8_LDB(B0, 1, 0); PG8_SCHED; PG8_LDA(At, 1, 0); PG8_STAGE(PG8_SA(0, 1), a2 + hstep, voffA);
            PG8_WAIT_L(8); PG8_BAR; PG8_WAIT_L(0); PG8_MMA(0, 0, At, B0); PG8_BAR; PG8_SCHED;
            PG8_LDB(B1, 1, 1); PG8_STAGE(PG8_SB(1, 0), b3, voffB);
            PG8_BAR; PG8_WAIT_L(0); PG8_MMA(0, 1, At, B1); PG8_BAR;
            PG8_LDA(At, 1, 1); PG8_STAGE(PG8_SA(1, 0), a3, voffA);
            PG8_BAR; PG8_WAIT_L(0); PG8_MMA(1, 0, At, B0); PG8_BAR; PG8_SCHED;
            PG8_STAGE(PG8_SB(1, 1), b3 + hstep, voffB);
            PG8_WAIT_V(6); PG8_BAR; PG8_MMA(1, 1, At, B1); PG8_BAR;
            }
        }
        if constexpr (ALIGN_EPI) { if (wr == 0) PG8_BAR; }
        if constexpr (!Epi::AFTER_DRAIN) { E(acc, cur, wr, wc, fr, fq); S.done(cur); }
        if (!has_next) break;
#pragma unroll
        for (int a = 0; a < 2; ++a)
#pragma unroll
            for (int b = 0; b < 2; ++b)
#pragma unroll
                for (int m = 0; m < 4; ++m)
#pragma unroll
                    for (int n = 0; n < 2; ++n) acc[a][b][m][n] = (f32x4){0.f, 0.f, 0.f, 0.f};
        cur = nxt; cA = nA; cB = nB; ++ui;
        if constexpr (ALIGN_EPI) { if (wr == 1) PG8_BAR; }
    }
    PG8_WAIT_V(0);
    if constexpr (!ALIGN_EPI) { if (wr == 0) PG8_BAR; }
    PG8_BAR;
    if constexpr (Epi::AFTER_DRAIN) { E.fused(acc, cur, wr, wc, fr, fq, lds, wid, lane); S.done(cur); }
#undef PG8_SA
#undef PG8_SB
#undef PG8_STAGE
#undef PG8_LDA
#undef PG8_LDB
#undef PG8_MMA
#undef PG8_WAIT_V
#undef PG8_WAIT_L
#undef PG8_BAR
#undef PG8_SCHED
}
}
namespace pg8 {
struct EpiRelu2 {
    static constexpr bool PERM = true, AFTER_DRAIN = false;
    bf16_t* O; int ldc;
    __device__ __forceinline__ void operator()(const f32x4 (&acc)[2][2][4][2], const Unit& u, int wr, int wc, int fr, int fq) const {
        const int row0 = u.pm * BM + wr * 64 + fr, col0 = u.pn * BM + wc * 32 + 8 * fq;
#pragma unroll
        for (int ai = 0; ai < 2; ++ai)
#pragma unroll
            for (int m = 0; m < 4; ++m) { bf16_t* rowp = O + (size_t)(row0 + ai * HALF + m * 16) * ldc + col0;
#pragma unroll
                for (int bj = 0; bj < 2; ++bj) { f32x4 v0 = acc[ai][bj][m][0], v1 = acc[ai][bj][m][1];
#pragma unroll
                    for (int j = 0; j < 4; ++j) { const float a = fmaxf(v0[j], 0.f), b = fmaxf(v1[j], 0.f); v0[j] = a * a; v1[j] = b * b; }
                    u32x4 w; w.x = cvt_pk_bf16(v0[0], v0[1]); w.y = cvt_pk_bf16(v0[2], v0[3]); w.z = cvt_pk_bf16(v1[0], v1[1]); w.w = cvt_pk_bf16(v1[2], v1[3]);
                    __builtin_nontemporal_store(w, (u32x4*)(rowp + bj * HALF)); } }
    }
};
struct EpiInProj {
    static constexpr bool PERM = true, AFTER_DRAIN = false;
    bf16_t* O; float* flog;
    __device__ __forceinline__ void operator()(const f32x4 (&acc)[2][2][4][2], const Unit& u, int wr, int wc, int fr, int fq) const {
        constexpr int ldc = 7168; const int row0 = u.pm * BM + wr * 64 + fr, col0 = u.pn * BM + wc * 32 + 8 * fq;
#pragma unroll
        for (int ai = 0; ai < 2; ++ai)
#pragma unroll
            for (int m = 0; m < 4; ++m) { bf16_t* rowp = O + (size_t)(row0 + ai * HALF + m * 16) * ldc + col0;
#pragma unroll
                for (int bj = 0; bj < 2; ++bj) { const f32x4 v0 = acc[ai][bj][m][0], v1 = acc[ai][bj][m][1];
                    u32x4 w; w.x = cvt_pk_bf16(v0[0], v0[1]); w.y = cvt_pk_bf16(v0[2], v0[3]); w.z = cvt_pk_bf16(v1[0], v1[1]); w.w = cvt_pk_bf16(v1[2], v1[3]);
                    __builtin_nontemporal_store(w, (u32x4*)(rowp + bj * HALF));
                    if (bj == 1 && col0 + HALF == 7040) { float* fp = flog + (size_t)(row0 + ai * HALF + m * 16) * 8; *(f32x4*)fp = v0; *(f32x4*)(fp + 4) = v1; } } }
    }
};
struct EpiResid {
    static constexpr bool PERM = false, AFTER_DRAIN = false;
    float* X; const float* Xs; const float* st; const float* g; const float* b; static constexpr int ldc = 2048;     static constexpr float alpha = 1.681792830507429f;
    __device__ __forceinline__ void operator()(const f32x4 (&acc)[2][2][4][2], const Unit& u, int wr, int wc, int fr, int fq) const {
        const int row0 = u.pm * BM + wr * 64 + fr, col0 = u.pn * BM + wc * 32 + 4 * fq;
        f32x4 gv[2][2], bv[2][2];
#pragma unroll
        for (int bj = 0; bj < 2; ++bj)
#pragma unroll
            for (int n = 0; n < 2; ++n) { gv[bj][n] = *(const f32x4*)(g + col0 + bj * HALF + n * 16); bv[bj][n] = *(const f32x4*)(b + col0 + bj * HALF + n * 16); }
#pragma unroll
        for (int ai = 0; ai < 2; ++ai)
#pragma unroll
            for (int m = 0; m < 4; ++m) { const int row = row0 + ai * HALF + m * 16; float* rowp = X + (size_t)row * ldc + col0;
                const f32x2 s2 = *(const f32x2*)(st + 2 * (size_t)row); const float mean = s2.x, rstd = s2.y;
#pragma unroll
                for (int bj = 0; bj < 2; ++bj)
#pragma unroll
                    for (int n = 0; n < 2; ++n) { f32x4* q = (f32x4*)(rowp + bj * HALF + n * 16); const f32x4 xo = __builtin_nontemporal_load((const f32x4*)(Xs + (size_t)row * ldc + col0 + bj * HALF + n * 16)); const f32x4 xn = (xo - mean) * rstd * gv[bj][n] + bv[bj][n]; *q = xn * alpha + acc[ai][bj][m][n]; } }
    }
};
}
#ifndef PG8_SP2
#define PG8_SP2 true
#endif
#ifndef PG8_ALIGN
#define PG8_ALIGN true
#endif
namespace fox {
constexpr int D = 128;
constexpr int LDQ = 7168;
constexpr int LDO = 2048;
constexpr float THR = 8.f;
constexpr bool WSKIP = false;
constexpr float SCALE = 0.08838834764831845f;
constexpr int NW = 8, QBLK = 32, KVBLK = 64, QB = NW * QBLK;
constexpr int SHM_V = KVBLK * D * 2, SHM_K = KVBLK * D * 2;
constexpr int CB_OFF = 2 * SHM_V + 2 * SHM_K + NW * 64 * 4;
constexpr int QL_OFF = 69632;
constexpr int LDS_BYTES = QL_OFF + NW * QBLK * 256;
static_assert(CB_OFF + 2 * 64 * 4 <= QL_OFF, "attention LDS map");
using bf16 = __hip_bfloat16;
typedef short bf16x8 __attribute__((ext_vector_type(8)));
typedef short s16x4 __attribute__((ext_vector_type(4)));
typedef float f32x16 __attribute__((ext_vector_type(16)));
typedef float f32x4 __attribute__((ext_vector_type(4)));
typedef unsigned u32x4 __attribute__((ext_vector_type(4)));
template <class A, class Bt> struct same_t { static constexpr bool v = false; };
template <class A> struct same_t<A, A> { static constexpr bool v = true; };

#define KSWZ(row, colB) ((row) * 256 + ((colB) ^ (((row) & 7) << 4)))
#define SBAR() __builtin_amdgcn_sched_barrier(0)
__device__ __forceinline__ int v_st(int k, int c) { const int kk = (k & ~0xC) | ((k & 4) << 1) | ((k & 8) >> 1); return ((kk >> 3) * 4 + (c >> 5)) * 512 + ((kk & 7) * 32 + (c & 31)) * 2; }
__device__ __forceinline__ int v_rd_base(int lane) { return ((lane & 3) << 3) | (((lane >> 2) & 3) << 6) | (((lane >> 4) & 1) << 5) | (((lane >> 5) & 1) << 8); }
constexpr int v_rd_off(int d0, int ks, int half) { return d0 * 512 + ks * 4096 + half * 2048; }
__device__ __forceinline__ int crow(int r, int hi) { return (r & 3) + 8 * (r >> 2) + 4 * hi; }
__device__ __forceinline__ unsigned cvtpk(float lo, float hi) {
    unsigned r; asm volatile("v_cvt_pk_bf16_f32 %0, %1, %2" : "=v"(r) : "v"(lo), "v"(hi)); return r;
}
__device__ __forceinline__ bf16x8 pack8(f32x4 a, f32x4 b) {
    u32x4 w = {cvtpk(a[0], a[1]), cvtpk(a[2], a[3]), cvtpk(b[0], b[1]), cvtpk(b[2], b[3])};
    return *reinterpret_cast<bf16x8*>(&w);
}
template <class T> __device__ __forceinline__ bf16x8 load8(const T* p) {
    if constexpr (same_t<T, float>::v) { return pack8(*(const f32x4*)p, *(const f32x4*)(p + 4)); }
    else { return *reinterpret_cast<const bf16x8*>(p); }
}
__device__ __forceinline__ void mask_tile(f32x16& p0, f32x16& p1, int dq, unsigned W) {
    const float NEG = -__builtin_inff();
#pragma unroll
    for (int r = 0; r < 16; ++r) {
        const int c = (r & 3) + 8 * (r >> 2);
        if ((unsigned)(dq - c) >= W) p0[r] = NEG;
        if ((unsigned)(dq - c - 32) >= W) p1[r] = NEG;
    }
}
__device__ __forceinline__ void partialSM(f32x16& p0, f32x16& p1, float& m_reg, float& mn, float& alpha) {
    float pmax = p0[0]; for (int r = 1; r < 16; ++r) pmax = fmaxf(pmax, p0[r]); for (int r = 0; r < 16; ++r) pmax = fmaxf(pmax, p1[r]);
    { auto rr = __builtin_amdgcn_permlane32_swap(__float_as_uint(pmax), __float_as_uint(pmax), false, false);
      pmax = fmaxf(__uint_as_float(rr[0]), __uint_as_float(rr[1])); }
    constexpr float C2 = 1.4426950408889634f * SCALE;
    if (__builtin_expect(__all((pmax - m_reg) * SCALE <= THR), 1)) { mn = m_reg; alpha = 1.f; }
    else { mn = fmaxf(m_reg, pmax); alpha = __builtin_amdgcn_exp2f((m_reg - mn) * C2); m_reg = mn; }
    const float mnL = -mn * C2;
    for (int r = 0; r < 16; ++r) p0[r] = fmaf(p0[r], C2, mnL); for (int r = 0; r < 16; ++r) p1[r] = fmaf(p1[r], C2, mnL);
    for (int r = 0; r < 16; ++r) p0[r] = __builtin_amdgcn_exp2f(p0[r]);
}
__device__ __forceinline__ void finishSM(f32x16& p0, f32x16& p1, float alpha, float& l_reg, bf16x8& pa0, bf16x8& pa1, bf16x8& pa2, bf16x8& pa3) {
    for (int r = 0; r < 16; ++r) p1[r] = __builtin_amdgcn_exp2f(p1[r]);
    float ps = 0; for (int r = 0; r < 16; ++r) ps += p0[r]; for (int r = 0; r < 16; ++r) ps += p1[r];
    { auto rr = __builtin_amdgcn_permlane32_swap(__float_as_uint(ps), __float_as_uint(ps), false, false);
      ps = __uint_as_float(rr[0]) + __uint_as_float(rr[1]); }
    l_reg = l_reg * alpha + ps;
#define PK4(P, B_, OUT) do { unsigned a0 = cvtpk(P[B_+0], P[B_+1]), a1 = cvtpk(P[B_+2], P[B_+3]);                          \
        unsigned b0 = cvtpk(P[B_+4], P[B_+5]), b1 = cvtpk(P[B_+6], P[B_+7]);                                             \
        auto r0 = __builtin_amdgcn_permlane32_swap(a0, b0, false, false); auto r1 = __builtin_amdgcn_permlane32_swap(a1, b1, false, false); \
        u32x4 w = {r0[0], r1[0], r0[1], r1[1]}; OUT = *reinterpret_cast<bf16x8*>(&w); } while (0)
    PK4(p0, 0, pa0); PK4(p0, 8, pa1); PK4(p1, 0, pa2); PK4(p1, 8, pa3);
#undef PK4
}
template <int KB, bool SK>
__device__ __forceinline__ void qkt(f32x16& p0, f32x16& p1, const char* K_lds, int r32, int hi, const char* Q_w, bool act) {
    const float* cbp = (const float*)(K_lds + 2 * SHM_K + NW * 64 * 4) + KB * 64;
    if (SK && !act) { const float NEG = -__builtin_inff();
#pragma unroll
        for (int r = 0; r < 16; ++r) { p0[r] = NEG; p1[r] = NEG; } return; }
    {
      const float c0 = cbp[r32], c1 = cbp[32 + r32];
      const unsigned u0 = __float_as_uint(c0), h0 = u0 & 0xffff0000u; const float r0 = c0 - __uint_as_float(h0); const unsigned m0 = __float_as_uint(r0) & 0xffff0000u; const unsigned l0 = __float_as_uint(r0 - __uint_as_float(m0));
      const unsigned u1 = __float_as_uint(c1), h1 = u1 & 0xffff0000u; const float r1 = c1 - __uint_as_float(h1); const unsigned m1 = __float_as_uint(r1) & 0xffff0000u; const unsigned l1 = __float_as_uint(r1 - __uint_as_float(m1));
      const u32x4 a0 = {(h0 >> 16) | m0, l0 >> 16, 0u, 0u}, a1 = {(h1 >> 16) | m1, l1 >> 16, 0u, 0u};
      const unsigned on = hi == 0 ? 0x3f803f80u : 0u; const u32x4 ones = {on, on, 0u, 0u};
      p0 = __builtin_amdgcn_mfma_f32_32x32x16_bf16(*reinterpret_cast<const bf16x8*>(&a0), *reinterpret_cast<const bf16x8*>(&ones), f32x16{}, 0, 0, 0);
      p1 = __builtin_amdgcn_mfma_f32_32x32x16_bf16(*reinterpret_cast<const bf16x8*>(&a1), *reinterpret_cast<const bf16x8*>(&ones), f32x16{}, 0, 0, 0); }
    const char* kb[4]; const char* qb[4];
#pragma unroll
    for (int dd = 0; dd < 4; ++dd) { kb[dd] = K_lds + KB * SHM_K + KSWZ(r32, (dd * 16 + hi * 8) * 2); qb[dd] = Q_w + KSWZ(r32, (dd * 16 + hi * 8) * 2); }
#pragma unroll
    for (int d0 = 0; d0 < 8; ++d0) { const char* a = kb[d0 & 3] + (d0 >> 2) * 128;
        bf16x8 b0 = *reinterpret_cast<const bf16x8*>(a);
        bf16x8 b1 = *reinterpret_cast<const bf16x8*>(a + 32 * 256);
        const bf16x8 qf = *reinterpret_cast<const bf16x8*>(qb[d0 & 3] + (d0 >> 2) * 128);
        p0 = __builtin_amdgcn_mfma_f32_32x32x16_bf16(b0, qf, p0, 0, 0, 0);
        p1 = __builtin_amdgcn_mfma_f32_32x32x16_bf16(b1, qf, p1, 0, 0, 0); }
}
template <int VB, bool SK>
__device__ __forceinline__ void pv_tile(f32x16* o, int vb0, bf16x8 pa0, bf16x8 pa1, bf16x8 pa2, bf16x8 pa3, bool act) {
    if (SK && !act) return;
#define TRRD(dst, off) asm volatile("ds_read_b64_tr_b16 %0, %1 offset:%2" : "=&v"(dst) : "v"(vb0), "i"(off) : "memory")
#define PV_D0(d0) do { s16x4 l0, l1, l2, l3, h0, h1, h2, h3; constexpr int b_ = VB * SHM_V + v_rd_off(d0, 0, 0);     \
        TRRD(l0, b_); TRRD(h0, b_ + 2048); TRRD(l1, b_ + 4096); TRRD(h1, b_ + 6144); TRRD(l2, b_ + 8192); TRRD(h2, b_ + 10240); TRRD(l3, b_ + 12288); TRRD(h3, b_ + 14336); \
        asm volatile("s_waitcnt lgkmcnt(0)" ::: "memory"); SBAR();                 \
        o[d0] = __builtin_amdgcn_mfma_f32_32x32x16_bf16(pa0, (bf16x8){l0[0], l0[1], l0[2], l0[3], h0[0], h0[1], h0[2], h0[3]}, o[d0], 0, 0, 0);   \
        o[d0] = __builtin_amdgcn_mfma_f32_32x32x16_bf16(pa1, (bf16x8){l1[0], l1[1], l1[2], l1[3], h1[0], h1[1], h1[2], h1[3]}, o[d0], 0, 0, 0);   \
        o[d0] = __builtin_amdgcn_mfma_f32_32x32x16_bf16(pa2, (bf16x8){l2[0], l2[1], l2[2], l2[3], h2[0], h2[1], h2[2], h2[3]}, o[d0], 0, 0, 0);   \
        o[d0] = __builtin_amdgcn_mfma_f32_32x32x16_bf16(pa3, (bf16x8){l3[0], l3[1], l3[2], l3[3], h3[0], h3[1], h3[2], h3[3]}, o[d0], 0, 0, 0); } while (0)
    PV_D0(0); PV_D0(1); PV_D0(2); PV_D0(3);
#undef PV_D0
#undef TRRD
}

template <class TIn, class TOut> struct BlockRef { const TIn* Q; const TIn* K; const TIn* V; TOut* O; const float* C; int P0; int JLO; };
template <class TIn> struct Seam {
    bf16x8 qr[8];
    bf16x8 st_v0, st_v1, st_k0, st_k1; f32x4 sf0, sf1, sf2, sf3; float st_c; int wv; int jlo;
    f32x4 tq[16];
};
__device__ __forceinline__ int swa_jlo(int P0, int W) { const int lowk = P0 - W + 1; return lowk > 0 ? lowk / KVBLK : 0; }
#define ROW(p, k0, rr) ((p) + (size_t)((k0) + (rr)) * LDQ + sc)
#define VMW() asm volatile("s_waitcnt vmcnt(0)" ::: "memory")
#define VMWN(n) asm volatile("s_waitcnt vmcnt(%0)" :: "i"(n) : "memory")
#define SLOAD_H(Kp, Vp, Cp, k0) do { S.st_v0 = load8<TIn>(ROW(Vp, k0, sr)); S.st_v1 = load8<TIn>(ROW(Vp, k0, 32 + sr));              \
                         S.st_k0 = load8<TIn>(ROW(Kp, k0, sr)); S.st_k1 = load8<TIn>(ROW(Kp, k0, 32 + sr)); if (tid < 64) S.st_c = (Cp)[(k0) + tid]; } while (0)
#define SWRITE_HK(bf) do { *(bf16x8*)(K_lds + (bf) * SHM_K + kws) = S.st_k0; *(bf16x8*)(K_lds + (bf) * SHM_K + kws + 32 * 256) = S.st_k1; if (tid < 64) ((float*)(lds + CB_OFF))[(bf) * 64 + tid] = S.st_c; } while (0)
#define SWRITE_HV(bf) do { *(bf16x8*)(V_lds + (bf) * SHM_V + vst0) = S.st_v0; *(bf16x8*)(V_lds + (bf) * SHM_V + vst1) = S.st_v1; } while (0)
#define SWRITE_H(bf) do { SWRITE_HV(bf); SWRITE_HK(bf); } while (0)
#define SLOAD_F(p, k0) do { S.sf0 = *(const f32x4*)ROW(p, k0, sr); S.sf1 = *(const f32x4*)(ROW(p, k0, sr) + 4);                \
                            S.sf2 = *(const f32x4*)ROW(p, k0, 32 + sr); S.sf3 = *(const f32x4*)(ROW(p, k0, 32 + sr) + 4); } while (0)
#define SWRITE_KF(bf) do { *(bf16x8*)(K_lds + (bf) * SHM_K + kws) = pack8(S.sf0, S.sf1); *(bf16x8*)(K_lds + (bf) * SHM_K + kws + 32 * 256) = pack8(S.sf2, S.sf3); } while (0)
#define SWRITE_VF(bf) do { *(bf16x8*)(V_lds + (bf) * SHM_V + vst0) = pack8(S.sf0, S.sf1); *(bf16x8*)(V_lds + (bf) * SHM_V + vst1) = pack8(S.sf2, S.sf3); } while (0)
template <class TIn, class TOut>
__device__ __forceinline__ void causal_swa_prime(const BlockRef<TIn, TOut>& cur, int W, char* lds, Seam<TIn>& S) {
    constexpr bool F32 = same_t<TIn, float>::v;
    const int tid = otid(S.wv), wid = __builtin_amdgcn_readfirstlane(tid >> 6), lane = tid & 63, r32 = lane & 31, hi = lane >> 5;
    const int sr = tid >> 4, sc = (tid & 15) * 8, kws = KSWZ(sr, sc * 2); char* K_lds = lds + 2 * SHM_V;
    const int kb0 = cur.JLO * KVBLK; S.jlo = cur.JLO;
    for (int d0 = 0; d0 < 8; ++d0) S.qr[d0] = load8<TIn>(cur.Q + (size_t)(wid * QBLK + r32) * LDQ + d0 * 16 + hi * 8);
    if constexpr (F32) { SLOAD_F((const float*)cur.K, kb0); VMW(); SWRITE_KF(0); SBAR(); SLOAD_F((const float*)cur.V, kb0); }
    else { SLOAD_H(cur.K, cur.V, cur.C, kb0); VMW(); SWRITE_HK(0); }
    __syncthreads();
}
template <class TIn, class TOut, class RF>
__device__ __forceinline__ void causal_swa_block(int it_cur, int it_nxt, const RF& rf, int skv, int W, char* lds, Seam<TIn>& S) {
    const BlockRef<TIn, TOut> cur = rf(it_cur);
    constexpr bool F32 = same_t<TIn, float>::v;
    const int tid = otid(S.wv), wid = __builtin_amdgcn_readfirstlane(tid >> 6), lane = tid & 63, r32 = lane & 31, hi = lane >> 5;
    const int j_lo = S.jlo;
    int j_hi = (cur.P0 + QB - 1) / KVBLK + 1; if (j_hi > skv / KVBLK) j_hi = skv / KVBLK;
    const int NT = j_hi - j_lo;
    const int qlo = cur.P0 + wid * QBLK, qm = qlo + r32 - 4 * hi;
    char* V_lds = lds; char* K_lds = lds + 2 * SHM_V;
    float* ws = (float*)(lds + 2 * SHM_V + 2 * SHM_K) + wid * 64; float* li_l = ws, * al_l = ws + 32;
    float m_reg = -1e30f, l_reg = 0; f32x16 o[4] = {};
    char* Q_w = lds + QL_OFF + wid * (QBLK * 256);
#pragma unroll
    for (int d0 = 0; d0 < 8; ++d0) *reinterpret_cast<bf16x8*>(Q_w + KSWZ(r32, (d0 * 16 + hi * 8) * 2)) = S.qr[d0];
    const int sr = tid >> 4, sc = (tid & 15) * 8, vst0 = v_st(sr, sc), vst1 = v_st(32 + sr, sc), kws = KSWZ(sr, sc * 2);
    const int vb0 = (int)(uintptr_t)V_lds + v_rd_base(lane);
    const TIn* Kh = cur.K; const TIn* Vh = cur.V; const float* Ch = cur.C;
#define RESC(a) do { if (__any((a) < 1.f)) { if (hi == 0) al_l[r32] = (a); asm volatile("s_waitcnt lgkmcnt(0)" ::: "memory");              \
                     for (int d_ = 0; d_ < 4; ++d_) for (int r = 0; r < 16; ++r) o[d_][r] *= al_l[crow(r, hi)]; } } while (0)
#define KBASE(t) ((j_lo + (t)) * KVBLK)
#define ACT(t) (KBASE(t) <= qlo + QBLK - 1 && KBASE(t) + KVBLK - 1 >= qlo - W + 1)
#define MASKT(P0_, P1_, t) do { const int kb_ = KBASE(t); if ((!SK || ACT(t)) && (kb_ + KVBLK - 1 > qlo || kb_ <= qlo + QBLK - 1 - W)) mask_tile(P0_, P1_, qm - kb_, (unsigned)W); } while (0)
    constexpr int NQL = F32 ? 16 : 8;
    constexpr bool SK = WSKIP && !F32;
#define SEAM_K0() do { VMWN(NQL); if constexpr (F32) { SWRITE_KF(0); SBAR(); SLOAD_F((const float*)nxt.V, kbn); } else { SWRITE_HK(0); } SBAR(); } while (0)
    f32x16 pA0, pA1, pB0, pB1; float mnA, mnB, alA, alB; bf16x8 pa0, pa1, pa2, pa3;
    if constexpr (F32) { VMW(); SWRITE_VF(0); SBAR(); } else { SWRITE_HV(0); SBAR(); }
    if (NT > 1) { if constexpr (F32) SLOAD_F((const float*)Kh, KBASE(1)); else SLOAD_H(Kh, Vh, Ch, KBASE(1)); }
    SBAR(); qkt<0, SK>(pA0, pA1, K_lds, r32, hi, Q_w, ACT(0));
    if constexpr (F32) { if (NT > 1) { VMW(); SWRITE_KF(1); SBAR(); SLOAD_F((const float*)Vh, KBASE(1)); } }
    MASKT(pA0, pA1, 0); partialSM(pA0, pA1, m_reg, mnA, alA);
    if (NT > 1) { VMW(); if constexpr (F32) { SWRITE_VF(1); SBAR(); if (NT > 2) SLOAD_F((const float*)Kh, KBASE(2)); } else SWRITE_H(1); }
    __syncthreads();
#define HALF_STEP(PX0, PX1, mnX, alX, PY0, PY1, alY, t, KB, VB, SB) do {                                                      \
        SBAR(); qkt<KB, SK>(PX0, PX1, K_lds, r32, hi, Q_w, ACT(t));                                             \
        finishSM(PY0, PY1, alY, l_reg, pa0, pa1, pa2, pa3); SBAR();                                                           \
        if ((t) + 1 < NT) { if constexpr (F32) { VMW(); SWRITE_KF(SB); SBAR(); SLOAD_F((const float*)Vh, KBASE((t) + 1)); }  \
                            else { SLOAD_H(Kh, Vh, Ch, KBASE((t) + 1)); } SBAR(); }                                               \
        pv_tile<VB, SK>(o, vb0, pa0, pa1, pa2, pa3, ACT((t) - 1)); MASKT(PX0, PX1, (t)); partialSM(PX0, PX1, m_reg, mnX, alX);                                        \
        __syncthreads();                                                                                                      \
        if ((t) + 1 < NT) { VMW(); if constexpr (F32) { SWRITE_VF(SB); SBAR(); if ((t) + 2 < NT) SLOAD_F((const float*)Kh, KBASE((t) + 2)); } \
                            else { SWRITE_H(SB); } }                                                                          \
        RESC(alX); __syncthreads(); } while (0)
    for (int t = 1; t + 1 < NT; t += 2) {
        HALF_STEP(pB0, pB1, mnB, alB, pA0, pA1, alA, t, 1, 0, 0);
        HALF_STEP(pA0, pA1, mnA, alA, pB0, pB1, alB, t + 1, 0, 1, 1);
    }
    const bool even = (NT & 1) == 0;
    if (even) { SBAR(); qkt<1, SK>(pB0, pB1, K_lds, r32, hi, Q_w, ACT(NT - 1)); SBAR(); }
    int itn_ = it_nxt; asm volatile("; late nxt" : "+s"(itn_)); const BlockRef<TIn, TOut> nxt = rf(itn_); const int kbn = nxt.JLO * KVBLK; S.jlo = nxt.JLO;
#define QROW(e) (nxt.Q + (size_t)(wid * QBLK + r32) * LDQ + ((e) >> 1) * 16 + hi * 8 + ((e) & 1) * 4)
    if constexpr (F32) { SLOAD_F((const float*)nxt.K, kbn); SBAR();
#pragma unroll
        for (int e = 0; e < 8; ++e) S.tq[e] = *(const f32x4*)QROW(e); }
    else { SLOAD_H(nxt.K, nxt.V, nxt.C, kbn); SBAR();
#pragma unroll
        for (int d0 = 0; d0 < 8; ++d0) S.qr[d0] = load8<TIn>(nxt.Q + (size_t)(wid * QBLK + r32) * LDQ + d0 * 16 + hi * 8); }
    SBAR();
    finishSM(pA0, pA1, alA, l_reg, pa0, pa1, pa2, pa3); SBAR();
    if constexpr (F32) {
#pragma unroll
        for (int e = 8; e < 16; ++e) S.tq[e] = *(const f32x4*)QROW(e); SBAR(); }
#undef QROW
    pv_tile<0, SK>(o, vb0, pa0, pa1, pa2, pa3, ACT(even ? NT - 2 : NT - 1));
    if (even) { MASKT(pB0, pB1, NT - 1); partialSM(pB0, pB1, m_reg, mnB, alB); __syncthreads(); RESC(alB);
        finishSM(pB0, pB1, alB, l_reg, pa0, pa1, pa2, pa3); SBAR(); pv_tile<1, SK>(o, vb0, pa0, pa1, pa2, pa3, ACT(NT - 1)); }
    SBAR(); SEAM_K0();
    if (hi == 0) li_l[r32] = l_reg; asm volatile("s_waitcnt lgkmcnt(0)" ::: "memory");
    float rli[16];
#pragma unroll
    for (int r = 0; r < 16; ++r) rli[r] = __builtin_amdgcn_rcpf(li_l[crow(r, hi)]);
    int itc_ = it_cur; asm volatile("; late cur" : "+s"(itc_)); TOut* Ow = rf(itc_).O + (size_t)(wid * QBLK) * LDO;
#pragma unroll
    for (int r = 0; r < 16; ++r) { const int orow = crow(r, hi);
#pragma unroll
        for (int d0 = 0; d0 < 4; ++d0) { const float v = o[d0][r] * rli[r];
            if constexpr (same_t<TOut, float>::v) { Ow[(size_t)orow * LDO + d0 * 32 + r32] = v; }
            else { const float vn = __int_as_float(__builtin_amdgcn_update_dpp(0, __float_as_int(v), 0xB1, 0xF, 0xF, true));
                   if ((r32 & 1) == 0) *(unsigned*)(Ow + (size_t)orow * LDO + d0 * 32 + r32) = cvtpk(v, vn); } } }
    if constexpr (F32) {
#pragma unroll
        for (int d0 = 0; d0 < 8; ++d0) S.qr[d0] = pack8(S.tq[2 * d0], S.tq[2 * d0 + 1]); }
    __syncthreads();
#undef RESC
#undef KBASE
#undef ACT
#undef MASKT
#undef SEAM_K0
#undef HALF_STEP
}
#undef ROW
#undef VMW
#undef VMWN
#undef SLOAD_H
#undef SWRITE_HK
#undef SWRITE_HV
#undef SWRITE_H
#undef SLOAD_F
#undef SWRITE_KF
#undef SWRITE_VF
}
#define GAS __attribute__((address_space(1)))
#define LAS __attribute__((address_space(3)))
typedef unsigned short bf16_t;
typedef short bf16x8 __attribute__((ext_vector_type(8)));
typedef float f32x4 __attribute__((ext_vector_type(4)));
typedef float f32x2 __attribute__((ext_vector_type(2)));
typedef unsigned u32x4 __attribute__((ext_vector_type(4)));
typedef unsigned u32x2 __attribute__((ext_vector_type(2)));
typedef _Float16 h16x8 __attribute__((ext_vector_type(8)));
typedef GAS unsigned gu32;
typedef GAS unsigned long long gu64;
#define RLX_AGENT __ATOMIC_RELAXED, __HIP_MEMORY_SCOPE_AGENT

constexpr int NB = 4, SEQ = 8192, DM = 2048, DEPTH = 4, DFF = 8192;
constexpr int M = NB * SEQ;
constexpr int PIN = 7046, PINP = 7168;
constexpr int FOXH = 6, RWH = 10, RETH = 5;
constexpr int C_FQ = 0, C_FK = 768, C_FV = 1536, C_RW = 2304  , C_RR = 2304, C_RK = 2944, C_RV = 3584, C_WD = 4224, C_AD = 4288, C_GD = 4352,
              C_TQ = 4480, C_TK = 5120, C_TV = 5760, C_TG = 6400, C_FF = 7040;
constexpr int MIX_FOX = 0, MIX_RW = 768, MIX_RET = 1408;
constexpr float ALPHA = 1.681792830507429f;
constexpr float LN_EPS = 1e-5f, RWKV_GN_EPS = 64e-5f, RET_GN_EPS = 1e-5f;

constexpr size_t MiB = 1u << 20;
constexpr size_t WS_CTL = 0, CTL_BYTES = 1 * MiB;
constexpr size_t WS_CS = WS_CTL + CTL_BYTES;
constexpr size_t WS_FOXC = WS_CS + 4 * MiB;
constexpr size_t WS_BONUS = WS_FOXC + 1 * MiB;
constexpr size_t WS_WIN = WS_BONUS + 2 * MiB;
constexpr size_t WS_WOUT = WS_WIN + 28 * MiB;
constexpr size_t WS_WUP = WS_WOUT + 8 * MiB;
constexpr size_t WS_WDN = WS_WUP + 32 * MiB;
constexpr size_t WS_XB = WS_WDN + 32 * MiB;
constexpr size_t WS_YRAW = WS_XB + 128 * MiB;
constexpr size_t WS_H = WS_YRAW + 80 * MiB;
constexpr size_t WS_SCAN = WS_H + 448 * MiB;
constexpr size_t WS_HID = WS_H;
constexpr size_t WS_KV = WS_SCAN + 245 * MiB;
constexpr size_t WS_STATS = WS_KV + 40 * MiB;
constexpr size_t WS_FLOG = WS_STATS + 1 * MiB;
constexpr size_t WS_END = WS_FLOG + 1 * MiB;
static_assert(WS_HID + 512 * MiB <= WS_END, "hid overlay");

constexpr int CW_BAR = 0;
constexpr int CW_QATT = 4096;

constexpr int LDS_BYTES = 147456;
constexpr int MISC_OFF = LDS_BYTES - 256;
constexpr int NTHR = 512;

__device__ __forceinline__ float bf2f(bf16_t x) { return __uint_as_float(((unsigned)x) << 16); }
__device__ __forceinline__ unsigned f2bf(float f) { unsigned u = __float_as_uint(f); return (u + 0x7fffu + ((u >> 16) & 1u)) >> 16; }
__device__ __forceinline__ unsigned pk2(float lo, float hi) { return f2bf(lo) | (f2bf(hi) << 16); }
template <int CTRL> __device__ __forceinline__ float dpp_add(float x) {
    const int y = __builtin_amdgcn_update_dpp(0, __float_as_int(x), CTRL, 0xF, 0xF, true); return x + __int_as_float(y);
}
__device__ __forceinline__ float row16_sum(float x) {
    x = dpp_add<0xB1>(x); x = dpp_add<0x4E>(x); x = dpp_add<0x141>(x); x = dpp_add<0x140>(x); return x;
}
__device__ __forceinline__ float rl(float x, int l) { return __int_as_float(__builtin_amdgcn_readlane(__float_as_int(x), l)); }
__device__ __forceinline__ float wave_sum(float v) { v = row16_sum(v); return (rl(v, 0) + rl(v, 16)) + (rl(v, 32) + rl(v, 48)); }
__device__ __forceinline__ float half_sum(float v, int lane) { v = row16_sum(v); const float a = rl(v, 0) + rl(v, 16), b = rl(v, 32) + rl(v, 48); return lane < 32 ? a : b; }
__device__ __forceinline__ float wave_incl_scan(float x, int lane) {
    x = dpp_add<0x111>(x); x = dpp_add<0x112>(x); x = dpp_add<0x114>(x); x = dpp_add<0x118>(x);
    const float r0 = rl(x, 15), r1 = rl(x, 31), r2 = rl(x, 47); const int row = lane >> 4;
    return x + (row > 0 ? r0 : 0.f) + (row > 1 ? r1 : 0.f) + (row > 2 ? r2 : 0.f);
}

#ifndef MK_RWKV_CHUNK
#define MK_RWKV_CHUNK 1
#endif
#ifndef MK_RWKV_SPLIT
#define MK_RWKV_SPLIT 1
#endif
struct Params {
    const float* in[23]; float* out; unsigned char* ws; int ph_lo, ph_hi;
};
typedef const __attribute__((address_space(4))) Params* CP;
struct PX { CP p; int wvs; __device__ __forceinline__ CP operator->() const { return p; } };

__device__ __forceinline__ int win_src(int n) { return n < C_RW ? n : (n < C_FF ? n + 6 : (n < C_FF + 6 ? n - C_FF + 2304 : -1)); }
template <bool MAPPED>
__device__ __forceinline__ void convert_tile(const int wvs, const float* W, int ldw, bf16_t* Wt, int K, int n0, int k0, LAS float* T) {
    const int tid = otid(wvs);
    if (MAPPED) {
#pragma unroll
        for (int i = 0; i < 8; ++i) { const int idx = tid + NTHR * i, r = idx >> 6, c = idx & 63; const int sn = win_src(n0 + c);
            T[r * 65 + c] = W[(size_t)(k0 + r) * ldw + (sn >= 0 ? sn : 0)] * (sn >= 0 ? 1.f : 0.f); }
    } else {
#pragma unroll
        for (int i = 0; i < 2; ++i) { const int idx = tid + NTHR * i, r = idx >> 4, c = (idx & 15) * 4; const f32x4 v = *(const f32x4*)(W + (size_t)(k0 + r) * ldw + n0 + c);
            T[r * 65 + c] = v[0]; T[r * 65 + c + 1] = v[1]; T[r * 65 + c + 2] = v[2]; T[r * 65 + c + 3] = v[3]; }
    }
    __syncthreads();
    { const int n = tid >> 3, kq = tid & 7; float v[8];
#pragma unroll
      for (int j = 0; j < 8; ++j) v[j] = T[(kq * 8 + j) * 65 + n];
      u32x4 w; w.x = pk2(v[0], v[1]); w.y = pk2(v[2], v[3]); w.z = pk2(v[4], v[5]); w.w = pk2(v[6], v[7]);
      *(u32x4*)(Wt + (size_t)(n0 + n) * K + k0 + kq * 8) = w; }
    __syncthreads();
}
template <bool MAPPED>
__device__ __forceinline__ void cv_load(const int tid, const float* W, int ldw, int n0, int k0, f32x4& a, f32x4& b) {
    if (MAPPED) {
        float v[8];
#pragma unroll
        for (int i = 0; i < 8; ++i) { const int idx = tid + NTHR * i, r = idx >> 6, c = idx & 63; const int sn = win_src(n0 + c);
            v[i] = __builtin_nontemporal_load(W + (size_t)(k0 + r) * ldw + (sn >= 0 ? sn : 0)) * (sn >= 0 ? 1.f : 0.f); }
        a = (f32x4){v[0], v[1], v[2], v[3]}; b = (f32x4){v[4], v[5], v[6], v[7]};
    } else {
        { const int r = tid >> 4, c = (tid & 15) * 4; a = __builtin_nontemporal_load((const f32x4*)(W + (size_t)(k0 + r) * ldw + n0 + c)); }
        { const int idx = tid + NTHR, r = idx >> 4, c = (idx & 15) * 4; b = __builtin_nontemporal_load((const f32x4*)(W + (size_t)(k0 + r) * ldw + n0 + c)); }
    }
}
template <bool MAPPED>
__device__ __forceinline__ void cv_stage(const int tid, LAS float* T, const f32x4 a, const f32x4 b) {
    if (MAPPED) {
#pragma unroll
        for (int i = 0; i < 8; ++i) { const int idx = tid + NTHR * i, r = idx >> 6, c = idx & 63; T[r * 65 + c] = i < 4 ? a[i & 3] : b[i & 3]; }
    } else {
        { const int r = tid >> 4, c = (tid & 15) * 4; T[r * 65 + c] = a[0]; T[r * 65 + c + 1] = a[1]; T[r * 65 + c + 2] = a[2]; T[r * 65 + c + 3] = a[3]; }
        { const int idx = tid + NTHR, r = idx >> 4, c = (idx & 15) * 4; T[r * 65 + c] = b[0]; T[r * 65 + c + 1] = b[1]; T[r * 65 + c + 2] = b[2]; T[r * 65 + c + 3] = b[3]; }
    }
}
__device__ __forceinline__ void cv_emit(const int tid, const LAS float* T, bf16_t* Wt, int K, int n0, int k0) {
    const int n = tid >> 3, kq = tid & 7; float v[8];
#pragma unroll
    for (int j = 0; j < 8; ++j) v[j] = T[(kq * 8 + j) * 65 + n];
    u32x4 w; w.x = pk2(v[0], v[1]); w.y = pk2(v[2], v[3]); w.z = pk2(v[4], v[5]); w.w = pk2(v[6], v[7]);
    *(u32x4*)(Wt + (size_t)(n0 + n) * K + k0 + kq * 8) = w;
}
struct CvSeg { const float* W; bf16_t* Wt; int ldw, K, lgk; };
template <bool MAPPED, typename DEC>
__device__ __forceinline__ void cv_run(const int tid, LAS float* T, const int total, DEC dec) {
    const int g = (int)gridDim.x; int u = (int)blockIdx.x;
    if (u >= total) return;
    f32x4 a0, b0, a1, b1;
    { const CvSeg s = dec(u); int uu = u; dec.local(uu); cv_load<MAPPED>(tid, s.W, s.ldw, (uu >> s.lgk) * 64, (uu & ((1 << s.lgk) - 1)) * 64, a0, b0); }
    { const int u1 = min(u + g, total - 1); const CvSeg s = dec(u1); int uu = u1; dec.local(uu); cv_load<MAPPED>(tid, s.W, s.ldw, (uu >> s.lgk) * 64, (uu & ((1 << s.lgk) - 1)) * 64, a1, b1); }
    for (;;) {
        cv_stage<MAPPED>(tid, T, a0, b0);
        { const int u2 = min(u + 2 * g, total - 1); const CvSeg s = dec(u2); int uu = u2; dec.local(uu); cv_load<MAPPED>(tid, s.W, s.ldw, (uu >> s.lgk) * 64, (uu & ((1 << s.lgk) - 1)) * 64, a0, b0); }
        __syncthreads();
        { const CvSeg s = dec(u); int uu = u; dec.local(uu); cv_emit(tid, T, s.Wt, s.K, (uu >> s.lgk) * 64, (uu & ((1 << s.lgk) - 1)) * 64); }
        u += g; if (u >= total) break;
        cv_stage<MAPPED>(tid, T + 64 * 65, a1, b1);
        { const int u2 = min(u + 2 * g, total - 1); const CvSeg s = dec(u2); int uu = u2; dec.local(uu); cv_load<MAPPED>(tid, s.W, s.ldw, (uu >> s.lgk) * 64, (uu & ((1 << s.lgk) - 1)) * 64, a1, b1); }
        __syncthreads();
        { const CvSeg s = dec(u); int uu = u; dec.local(uu); cv_emit(tid, T + 64 * 65, s.Wt, s.K, (uu >> s.lgk) * 64, (uu & ((1 << s.lgk) - 1)) * 64); }
        u += g; if (u >= total) break;
    }
    __syncthreads();
}
__device__ __forceinline__ void phase_convert(PX p, int layer, LAS unsigned char* lds) {
    LAS float* T = (LAS float*)lds; const int tid = otid(p.wvs);
    constexpr int T_IN = (PINP / 64) * (DM / 64), T_OUT = (DM / 64) * (DM / 64), T_UP = (DFF / 64) * (DM / 64), T_DN = (DM / 64) * (DFF / 64);
    { struct D { const float* w; bf16_t* wt;
          __device__ __forceinline__ CvSeg operator()(int) const { return CvSeg{w, wt, PIN, DM, 5}; }
          __device__ __forceinline__ void local(int&) const {} } d{p->in[1] + (size_t)layer * DM * PIN, (bf16_t*)(p->ws + WS_WIN)};
      cv_run<true>(tid, T, T_IN, d); }
    { struct D { const float* w_out; const float* w_up; const float* w_dn; bf16_t* o; bf16_t* u; bf16_t* d;
          __device__ __forceinline__ CvSeg operator()(int t) const { return t < T_OUT ? CvSeg{w_out, o, DM, DM, 5} : (t < T_OUT + T_UP ? CvSeg{w_up, u, DFF, DM, 5} : CvSeg{w_dn, d, DM, DFF, 7}); }
          __device__ __forceinline__ void local(int& t) const { t -= t < T_OUT ? 0 : (t < T_OUT + T_UP ? T_OUT : T_OUT + T_UP); } }
          d{p->in[16] + (size_t)layer * DM * DM, p->in[19] + (size_t)layer * DM * DFF, p->in[20] + (size_t)layer * DFF * DM, (bf16_t*)(p->ws + WS_WOUT), (bf16_t*)(p->ws + WS_WUP), (bf16_t*)(p->ws + WS_WDN)};
      cv_run<false>(tid, T, T_OUT + T_UP + T_DN, d); }
}
__device__ __forceinline__ void phase_prologue(PX p) {
    const f32x4* x4 = (const f32x4*)p->in[0]; f32x4* o4 = (f32x4*)p->out; u32x2* xb = (u32x2*)(p->ws + WS_XB);
    const size_t n4 = (size_t)M * DM / 4, stride = (size_t)gridDim.x * NTHR;
    for (size_t i = (size_t)blockIdx.x * NTHR + otid(p.wvs); i < n4; i += stride) { const f32x4 v = __builtin_nontemporal_load(x4 + i); u32x2 w;     w.x = pk2(v[0], v[1]); w.y = pk2(v[2], v[3]); xb[i] = w; }
    { float* st = (float*)(p->ws + WS_STATS);
      for (size_t i = (size_t)blockIdx.x * NTHR + otid(p.wvs); i < (size_t)M; i += stride) *(f32x2*)(st + 4 * (size_t)M + 2 * i) = (f32x2){0.f, 1.f};
      for (size_t i = (size_t)blockIdx.x * NTHR + otid(p.wvs); i < (size_t)DM; i += stride) { st[6 * (size_t)M + i] = 1.f; st[6 * (size_t)M + DM + i] = 0.f; } }
    f32x2* cs = (f32x2*)(p->ws + WS_CS);
    for (size_t i = (size_t)blockIdx.x * NTHR + otid(p.wvs); i < (size_t)SEQ * 64; i += stride) {
        const int pos = (int)(i >> 6), j = (int)(i & 63);
        const float pw = (float)pow(10000.0, (double)((float)j / 64.0f)); const float inv = 1.0f / pw; const float ang = (float)pos * inv;
        cs[i] = (f32x2){(float)cos((double)ang), (float)sin((double)ang)};
    }
}

template <bool FULL>
__device__ __forceinline__ void phase_ln(PX p, const float* g, const float* b, float* stats) {
    const int tid = otid(p.wvs), lane = tid & 63, wv = tid >> 6; float* xf = p->out; bf16_t* xb = (bf16_t*)(p->ws + WS_XB);
    f32x4 gg[8], bb[8];
#pragma unroll
    for (int i = 0; i < 8; ++i) { gg[i] = *(const f32x4*)(g + i * 256 + lane * 4); bb[i] = *(const f32x4*)(b + i * 256 + lane * 4); }
    for (int row = blockIdx.x * 8 + wv; row < M; row += gridDim.x * 8) {
        float* xr = xf + (size_t)row * DM; f32x4 v[8]; float s = 0.f;
#pragma unroll
        for (int i = 0; i < 8; ++i) { v[i] = __builtin_nontemporal_load((const f32x4*)(xr + i * 256 + lane * 4)); s += (v[i][0] + v[i][1]) + (v[i][2] + v[i][3]); }
        const float mean = wave_sum(s) * (1.0f / DM); float q = 0.f;
#pragma unroll
        for (int i = 0; i < 8; ++i) { const f32x4 d = v[i] - mean; q += (d[0] * d[0] + d[1] * d[1]) + (d[2] * d[2] + d[3] * d[3]); }
        const float rstd = 1.0f / sqrtf(wave_sum(q) * (1.0f / DM) + LN_EPS);
        if (!FULL && lane == 0) *(f32x2*)(stats + 2 * (size_t)row) = (f32x2){mean, rstd};
#pragma unroll
        for (int i = 0; i < 8; ++i) { const f32x4 o = (v[i] - mean) * rstd * gg[i] + bb[i]; if (FULL) __builtin_nontemporal_store(o, (f32x4*)(xr + i * 256 + lane * 4));
            if (!FULL) { u32x2 w; w.x = pk2(o[0], o[1]); w.y = pk2(o[2], o[3]); *(u32x2*)(xb + (size_t)row * DM + i * 256 + lane * 4) = w; } }
    }
}

__device__ __forceinline__ float log_sigmoid(float x) { return fminf(x, 0.f) - log1pf(expf(-fabsf(x))); }
__device__ __forceinline__ void fox_scan_unit(PX p, int layer, int bh, LAS unsigned char* lds) {
    const int tid = otid(p.wvs), lane = tid & 63, wv = tid >> 6, b = bh / FOXH, hh = bh % FOXH;
    const bf16_t* H = (const bf16_t*)(p->ws + WS_H); float* C = (float*)(p->ws + WS_FOXC) + (size_t)bh * SEQ; LAS float* wsum = (LAS float*)lds;
    const float fb = p->in[2][layer * FOXH + hh];
    float v[16]; float run = 0.f; const float* FL = (const float*)(p->ws + WS_FLOG) + ((size_t)b * SEQ + tid * 16) * 8 + hh;
#pragma unroll
    for (int i = 0; i < 16; ++i) { run += log_sigmoid(FL[i * 8] + fb); v[i] = run; }
    const float inc = wave_incl_scan(run, lane);
    if (lane == 63) wsum[wv] = inc;
    __syncthreads();
    float base = inc - run;
    for (int w = 0; w < wv; ++w) base += wsum[w];
    __syncthreads();
#pragma unroll
    for (int i = 0; i < 16; ++i) C[tid * 16 + i] = -(base + v[i]) * (1.0f / fox::SCALE);
}
constexpr size_t FOX_QN = WS_FOXC + 768 * 1024, FOX_KN = FOX_QN + 4096;
__device__ __forceinline__ float row16_max(float x) {
    x = fmaxf(x, __int_as_float(__builtin_amdgcn_update_dpp(0, __float_as_int(x), 0xB1, 0xF, 0xF, true))); x = fmaxf(x, __int_as_float(__builtin_amdgcn_update_dpp(0, __float_as_int(x), 0x4E, 0xF, 0xF, true)));
    x = fmaxf(x, __int_as_float(__builtin_amdgcn_update_dpp(0, __float_as_int(x), 0x141, 0xF, 0xF, true))); x = fmaxf(x, __int_as_float(__builtin_amdgcn_update_dpp(0, __float_as_int(x), 0x140, 0xF, 0xF, true))); return x;
}
__device__ __forceinline__ void fox_norm_unit(PX p, int unit, LAS unsigned char* lds) {
    const int tid = otid(p.wvs), wv = tid >> 6, bh = unit / (SEQ / 256), qb = unit % (SEQ / 256), b = bh / FOXH, hh = bh % FOXH;
    const bf16_t* H = (const bf16_t*)(p->ws + WS_H); LAS float* red = (LAS float*)lds;
    const bf16_t* qr = H + ((size_t)b * SEQ + qb * 256 + (tid >> 1)) * PINP + C_FQ + hh * 128 + (tid & 1) * 64; const bf16_t* kr = qr + (C_FK - C_FQ);
    float sq = 0.f, sk = 0.f;
#pragma unroll
    for (int i = 0; i < 8; ++i) { const bf16x8 a = *(const bf16x8*)(qr + 8 * i), c = *(const bf16x8*)(kr + 8 * i);
#pragma unroll
        for (int j = 0; j < 8; ++j) { const float x = bf2f((bf16_t)a[j]), y = bf2f((bf16_t)c[j]); sq += x * x; sk += y * y; } }
    sq = dpp_add<0xB1>(sq); sk = dpp_add<0xB1>(sk);
    float mq = row16_max(sq), mk = row16_max(sk);
    mq = fmaxf(fmaxf(rl(mq, 0), rl(mq, 16)), fmaxf(rl(mq, 32), rl(mq, 48))); mk = fmaxf(fmaxf(rl(mk, 0), rl(mk, 16)), fmaxf(rl(mk, 32), rl(mk, 48)));
    __syncthreads();
    if ((tid & 63) == 0) { red[wv] = mq; red[8 + wv] = mk; }
    __syncthreads();
    if (tid == 0) { float a = red[0], c = red[8];
#pragma unroll
        for (int w = 1; w < 8; ++w) { a = fmaxf(a, red[w]); c = fmaxf(c, red[8 + w]); }
        ((float*)(p->ws + FOX_QN))[bh * 32 + qb] = sqrtf(a) * 1.01f; ((float*)(p->ws + FOX_KN))[bh * 32 + qb] = sqrtf(c) * 1.01f; }
}
__device__ __forceinline__ float tshift(float cur, float prev, float mu) { return cur + (prev - cur) * mu; }
__device__ __forceinline__ void rwkv_pre_unit(PX p, int layer, int unit, LAS unsigned char* lds) {
    const int tid = otid(p.wvs), lane = tid & 63, wv = tid >> 6;
    const int tile = unit % (SEQ / 64), hd = (unit / (SEQ / 64)) % RWH, b = unit / ((SEQ / 64) * RWH);
    const bf16_t* H = (const bf16_t*)(p->ws + WS_H); LAS float* TA = (LAS float*)lds;
    const float* mu = p->in[3] + (size_t)layer * 2176;
    const int s0 = tile * 64;
    { const int tt = tid >> 3, j0 = (tid & 7) * 16, s = s0 + tt; const size_t row = (size_t)b * SEQ + s;
      const bf16_t* hc = H + row * PINP + C_WD + j0; const bf16_t* hp = hc - PINP;
      bf16x8 c0 = *(const bf16x8*)hc, c1 = *(const bf16x8*)(hc + 8), p0 = {}, p1 = {};
      if (s > 0) { p0 = *(const bf16x8*)hp; p1 = *(const bf16x8*)(hp + 8); }
#pragma unroll
      for (int i = 0; i < 16; ++i) { const float cu = bf2f((bf16_t)(i < 8 ? c0[i] : c1[i - 8])), pr = bf2f((bf16_t)(i < 8 ? p0[i] : p1[i - 8]));
          const float x = tshift(cu, pr, mu[1920 + j0 + i]); const int j = j0 + i; TA[tt * 128 + j] = j < 64 ? tanhf(x) : x; } }
    __syncthreads();
    const int c = hd * 64 + lane;
    float wup[64], aup[64];
    { const float* wu = p->in[5] + (size_t)layer * 64 * 640 + c; const float* au = p->in[7] + (size_t)layer * 64 * 640 + c;
#pragma unroll
      for (int j = 0; j < 64; ++j) { wup[j] = wu[j * 640]; aup[j] = au[j * 640]; } }
    const float w0 = p->in[4][layer * 640 + c], a0 = p->in[6][layer * 640 + c], kkc = p->in[9][layer * 640 + c], kac = p->in[10][layer * 640 + c], rkc = p->in[11][layer * 640 + c];
    const float mur = mu[c], muk = mu[640 + c], muv = mu[1280 + c];
    _Float16* SC = (_Float16*)(p->ws + WS_SCAN); float* BON = (float*)(p->ws + WS_BONUS);
    for (int i = 0; i < 8; ++i) {
        const int tt = wv * 8 + i, s = s0 + tt; const size_t row = (size_t)b * SEQ + s; const bf16_t* hr = H + row * PINP;
        const float rc = bf2f(hr[C_RR + c]), kc = bf2f(hr[C_RK + c]), vc = bf2f(hr[C_RV + c]);
        float rp = 0.f, kp = 0.f, vp = 0.f; if (s > 0) { rp = bf2f(hr[C_RR + c - PINP]); kp = bf2f(hr[C_RK + c - PINP]); vp = bf2f(hr[C_RV + c - PINP]); }
        const float r = tshift(rc, rp, mur), k = tshift(kc, kp, muk), v = tshift(vc, vp, muv);
        float wl = w0, al = a0;
#pragma unroll
        for (int j = 0; j < 64; j += 4) { const f32x4 tw = *(const LAS f32x4*)(TA + tt * 128 + j), ta = *(const LAS f32x4*)(TA + tt * 128 + 64 + j);
            wl += tw[0] * wup[j] + tw[1] * wup[j + 1] + tw[2] * wup[j + 2] + tw[3] * wup[j + 3]; al += ta[0] * aup[j] + ta[1] * aup[j + 1] + ta[2] * aup[j + 2] + ta[3] * aup[j + 3]; }
        const float nx = -wl; const float sp = fmaxf(nx, 0.f) + log1pf(expf(-fabsf(nx)));
        const float w = -sp - 0.5f;
#if MK_RWKV_CHUNK
        const float w1m = -expf(w);
#else
        const float w1m = 1.0f - expf(-expf(w));
#endif
        const float a = 1.0f / (1.0f + expf(-al));
        const float kk = k * kkc; const float nrm = sqrtf(wave_sum(kk * kk)); const float kkn = kk / fmaxf(nrm, 1e-12f);
        const float k2 = k * (1.0f + (a - 1.0f) * kac);
        const float bon = wave_sum(r * k2 * rkc);
        _Float16* rec = SC + (((size_t)(b * RWH + hd) * SEQ + s) * 6) * 64 + lane;
        rec[0] = (_Float16)r; rec[64] = (_Float16)w1m; rec[128] = (_Float16)k2; rec[192] = (_Float16)(-kkn); rec[256] = (_Float16)(kkn * a); rec[320] = (_Float16)v;
        if (lane == 0) BON[row * 16 + hd] = bon;
    }
    __syncthreads();
}

__device__ __forceinline__ void rwkv_post_unit(PX p, int layer, int unit, LAS unsigned char* lds) {
    typedef float f32x4 __attribute__((ext_vector_type(4)));
    const int tid = otid(p.wvs), lane = tid & 63, wv = __builtin_amdgcn_readfirstlane(tid >> 6), l15 = lane & 15, qq = lane >> 4;
    const int tile = unit % (SEQ / 64), b = unit / (SEQ / 64);
    const bf16_t* H = (const bf16_t*)(p->ws + WS_H);
    LAS bf16_t* SG = (LAS bf16_t*)lds;
    LAS bf16_t* GU = (LAS bf16_t*)(lds + 17408);
    LAS float* GT = (LAS float*)(lds + 34816);
    const float* mu = p->in[3] + (size_t)layer * 2176;
    const int s0 = tile * 64;
    __syncthreads();
    { const int tt = tid >> 3, j0 = (tid & 7) * 16, s = s0 + tt; const size_t row = (size_t)b * SEQ + s;
      const bf16_t* hc = H + row * PINP + C_GD + j0; const bf16_t* hp = hc - PINP;
      const bf16_t* hq = s > 0 ? hp : hc; const float pm = s > 0 ? 1.f : 0.f;
      const bf16x8 c0 = *(const bf16x8*)hc, c1 = *(const bf16x8*)(hc + 8), p0 = *(const bf16x8*)hq, p1 = *(const bf16x8*)(hq + 8);
      float x[16];
#pragma unroll
      for (int i = 0; i < 16; ++i) { const float cu = bf2f((bf16_t)(i < 8 ? c0[i] : c1[i - 8])), pr = pm * bf2f((bf16_t)(i < 8 ? p0[i] : p1[i - 8]));
          x[i] = __builtin_amdgcn_rcpf(1.0f + __expf(-tshift(cu, pr, mu[2048 + j0 + i]))); }
      u32x4 w; w.x = pk2(x[0], x[1]); w.y = pk2(x[2], x[3]); w.z = pk2(x[4], x[5]); w.w = pk2(x[6], x[7]); *(LAS u32x4*)(SG + tt * 136 + j0) = w;
      w.x = pk2(x[8], x[9]); w.y = pk2(x[10], x[11]); w.z = pk2(x[12], x[13]); w.w = pk2(x[14], x[15]); *(LAS u32x4*)(SG + tt * 136 + j0 + 8) = w; }
    const float* BON = (const float*)(p->ws + WS_BONUS); const float* Y = (const float*)(p->ws + WS_YRAW); bf16_t* MIX = (bf16_t*)(p->ws + WS_XB);
    const size_t row0 = (size_t)b * SEQ + s0 + wv * 8;
    float y[8], bon[8], gu[16]; bf16x8 v8;
#define POST_LOAD(hd_) do { const int c_ = (hd_) * 64 + lane; \
        _Pragma("unroll") for (int i = 0; i < 8; ++i) { y[i] = __builtin_nontemporal_load(Y + (row0 + i) * 640 + c_); bon[i] = BON[(row0 + i) * 16 + (hd_)]; } \
        v8 = *(const bf16x8*)(p->ws + WS_SCAN + ((size_t)(b * RWH + (hd_)) * (SEQ / 16) + ((s0 + wv * 8) >> 4)) * 12544 + 10240 + (lane * 16 + 8 * (wv & 1)) * 2); \
        const float* g_ = p->in[8] + (size_t)layer * 128 * 640 + (hd_) * 64; \
        _Pragma("unroll") for (int i = 0; i < 16; ++i) { const int idx = tid + NTHR * i; gu[i] = g_[(idx >> 6) * 640 + (idx & 63)]; } } while (0)
    POST_LOAD(0);
    for (int hd = 0; hd < RWH; ++hd) {
        const int c = hd * 64 + lane;
        const float gw = p->in[12][layer * 640 + c], gb = p->in[13][layer * 640 + c];
        float yc[8], bc[8], vc[8];
#pragma unroll
        for (int i = 0; i < 8; ++i) { yc[i] = y[i]; bc[i] = bon[i]; vc[i] = bf2f((bf16_t)v8[i]); }
#pragma unroll
        for (int i = 0; i < 16; ++i) { const int idx = tid + NTHR * i; GU[(idx & 63) * 136 + (idx >> 6)] = (bf16_t)f2bf(gu[i]); }
        __syncthreads();
        POST_LOAD(hd + 1 < RWH ? hd + 1 : hd);
        { const int mt = wv & 3, nh = wv >> 2;
#pragma unroll
          for (int nn = 0; nn < 2; ++nn) { const int nt = 2 * nh + nn; f32x4 acc = {0.f, 0.f, 0.f, 0.f};
#pragma unroll
              for (int s = 0; s < 4; ++s) acc = __builtin_amdgcn_mfma_f32_16x16x32_bf16(*(const LAS bf16x8*)(SG + (16 * mt + l15) * 136 + 32 * s + 8 * qq), *(const LAS bf16x8*)(GU + (16 * nt + l15) * 136 + 32 * s + 8 * qq), acc, 0, 0, 0);
              *(LAS f32x4*)(GT + (16 * nt + l15) * 68 + 16 * mt + 4 * qq) = acc; } }
        __syncthreads();
        const f32x4 g0 = *(const LAS f32x4*)(GT + lane * 68 + 8 * wv), g1 = *(const LAS f32x4*)(GT + lane * 68 + 8 * wv + 4);
#pragma unroll
        for (int i = 0; i < 8; ++i) {
            const float mean = wave_sum(yc[i]) * (1.0f / 64.0f); const float d = yc[i] - mean; const float var = wave_sum(d * d) * (1.0f / 64.0f);
            float yn = d * __builtin_amdgcn_rsqf(var + RWKV_GN_EPS) * gw + gb;
            yn += bc[i] * vc[i];
            const float g = i < 4 ? g0[i & 3] : g1[i & 3];
            MIX[(row0 + i) * DM + MIX_RW + c] = (bf16_t)f2bf(yn * g);
        }
    }
#undef POST_LOAD
}
__device__ __forceinline__ void phase_post(PX p, int layer, LAS unsigned char* lds) {
    constexpr int NPOST = NB * (SEQ / 64);
    for (int u = blockIdx.x; u < NPOST; u += gridDim.x) rwkv_post_unit(p, layer, u, lds);
}

__device__ __forceinline__ void rwkv_scan_unit(PX p, int unit, LAS unsigned char* lds) {
    const int tid = otid(p.wvs), lane = tid & 63, wv = tid >> 6, bh = unit >> 1, half = unit & 1, b = bh / RWH, hd = bh % RWH;
    LAS float* OP = (LAS float*)lds;
    LAS float* VV = (LAS float*)(lds + 81920);
    LAS float* YB = (LAS float*)(lds + 81920 + 8192);
    const h16x8* src = (const h16x8*)(p->ws + WS_SCAN) + (size_t)bh * SEQ * 48;
    float* Y = (float*)(p->ws + WS_YRAW);
    const int rowl = wv * 4 + (lane >> 4), ks = (lane & 15) * 4;
    float S0 = 0.f, S1 = 0.f, S2 = 0.f, S3 = 0.f;
    h16x8 st[6];
#pragma unroll
    for (int j = 0; j < 6; ++j) st[j] = src[tid + NTHR * j];
    for (int blk = 0; blk < SEQ / 64; ++blk) {
#pragma unroll
        for (int j = 0; j < 6; ++j) { const int idx = tid + NTHR * j, tok = idx / 48, wi = idx % 48, op = wi >> 3, c0 = (wi & 7) * 8; float f[8];
#pragma unroll
            for (int e = 0; e < 8; ++e) f[e] = (float)st[j][e];
            if (op == 1) {
#pragma unroll
                for (int e = 0; e < 8; ++e) f[e] = 1.0f - f[e]; }
            if (op < 5) { LAS float* d = OP + (tok * 5 + op) * 64 + c0; *(LAS f32x4*)d = (f32x4){f[0], f[1], f[2], f[3]}; *(LAS f32x4*)(d + 4) = (f32x4){f[4], f[5], f[6], f[7]}; }
            else if ((c0 >> 5) == half) { LAS float* d = VV + tok * 32 + (c0 & 31); *(LAS f32x4*)d = (f32x4){f[0], f[1], f[2], f[3]}; *(LAS f32x4*)(d + 4) = (f32x4){f[4], f[5], f[6], f[7]}; } }
        __syncthreads();
        if (blk + 1 < SEQ / 64) {
#pragma unroll
            for (int j = 0; j < 6; ++j) st[j] = src[(size_t)(blk + 1) * 64 * 48 + tid + NTHR * j]; }
#pragma unroll 4
        for (int t = 0; t < 64; ++t) {
            const LAS float* o = OP + t * 320 + ks;
            const f32x4 r4 = *(const LAS f32x4*)(o), w4 = *(const LAS f32x4*)(o + 64), k4 = *(const LAS f32x4*)(o + 128), a4 = *(const LAS f32x4*)(o + 192), b4 = *(const LAS f32x4*)(o + 256);
            const float vv = VV[t * 32 + rowl];
            float sa = (S0 * a4[0] + S1 * a4[1]) + (S2 * a4[2] + S3 * a4[3]);
            sa = row16_sum(sa);
            S0 = S0 * w4[0] + (sa * b4[0] + vv * k4[0]); S1 = S1 * w4[1] + (sa * b4[1] + vv * k4[1]);
            S2 = S2 * w4[2] + (sa * b4[2] + vv * k4[2]); S3 = S3 * w4[3] + (sa * b4[3] + vv * k4[3]);
            float y = (S0 * r4[0] + S1 * r4[1]) + (S2 * r4[2] + S3 * r4[3]);
            y = row16_sum(y);
            if ((lane & 15) == 0) YB[t * 32 + rowl] = y;
        }
        __syncthreads();
        { const int tt = tid >> 3, r0 = (tid & 7) * 4; const f32x4 yv = *(const LAS f32x4*)(YB + tt * 32 + r0);
          *(f32x4*)(Y + ((size_t)b * SEQ + blk * 64 + tt) * 640 + hd * 64 + half * 32 + r0) = yv; }
    }
    __syncthreads();
}

__device__ __forceinline__ void ret_simple_unit(PX p, int layer, int unit, LAS unsigned char* lds) {
    const int tid = otid(p.wvs), b = unit / RETH, hh = unit % RETH, e = tid & 127, dq = tid >> 7;
    LAS float* QS = (LAS float*)lds; LAS float* KS = QS + 16 * 128; LAS float* VS = KS + 16 * 128; LAS float* OPS = VS + 16 * 128;
    const bf16_t* H = (const bf16_t*)(p->ws + WS_H); const f32x2* CS = (const f32x2*)(p->ws + WS_CS); bf16_t* MIX = (bf16_t*)(p->ws + WS_XB);
    const float gamma = 1.0f - exp2f(-5.0f - (float)hh);
    float R[32];
#pragma unroll
    for (int i = 0; i < 32; ++i) R[i] = 0.f;
    const float* gnw = p->in[14] + layer * 640 + hh * 128; const float* gnb = p->in[15] + layer * 640 + hh * 128;
    for (int s0 = 0; s0 < SEQ; s0 += 16) {
        { const int tt = tid >> 5, f0 = (tid & 31) * 2, s = s0 + tt; const bf16_t* hr = H + ((size_t)b * SEQ + s) * PINP;
#pragma unroll
          for (int j = 0; j < 2; ++j) { const int f = f0 + j; const f32x2 cs = CS[(size_t)s * 64 + f];
              const float q1 = bf2f(hr[C_TQ + hh * 128 + f]), q2 = bf2f(hr[C_TQ + hh * 128 + 64 + f]), k1 = bf2f(hr[C_TK + hh * 128 + f]), k2 = bf2f(hr[C_TK + hh * 128 + 64 + f]);
              QS[tt * 128 + f] = q1 * cs.x - q2 * cs.y; QS[tt * 128 + 64 + f] = q1 * cs.y + q2 * cs.x;
              KS[tt * 128 + f] = (k1 * cs.x - k2 * cs.y) * 0.08838834764831845f; KS[tt * 128 + 64 + f] = (k1 * cs.y + k2 * cs.x) * 0.08838834764831845f; }
          const int e0 = (tid & 31) * 4;
#pragma unroll
          for (int j = 0; j < 4; ++j) VS[tt * 128 + e0 + j] = bf2f(hr[C_TV + hh * 128 + e0 + j]); }
        __syncthreads();
        for (int t = 0; t < 16; ++t) {
            const float ve = VS[t * 128 + e]; float op = 0.f;
#pragma unroll
            for (int i = 0; i < 32; i += 4) { const f32x4 k4 = *(const LAS f32x4*)(KS + t * 128 + dq * 32 + i), q4 = *(const LAS f32x4*)(QS + t * 128 + dq * 32 + i);
#pragma unroll
                for (int j = 0; j < 4; ++j) { R[i + j] = R[i + j] * gamma + k4[j] * ve; op += q4[j] * R[i + j]; } }
            OPS[(t * 4 + dq) * 128 + e] = op;
        }
        __syncthreads();
        { const int tt = tid >> 5, e0 = (tid & 31) * 4, s = s0 + tt; const size_t row = (size_t)b * SEQ + s;
          f32x4 o = *(const LAS f32x4*)(OPS + (tt * 4 + 0) * 128 + e0) + *(const LAS f32x4*)(OPS + (tt * 4 + 1) * 128 + e0) + *(const LAS f32x4*)(OPS + (tt * 4 + 2) * 128 + e0) + *(const LAS f32x4*)(OPS + (tt * 4 + 3) * 128 + e0);
          float sm = half_sum((o[0] + o[1]) + (o[2] + o[3]), tid & 63);
          const float mean = sm * (1.0f / 128.0f); const f32x4 d = o - mean; float q = half_sum((d[0] * d[0] + d[1] * d[1]) + (d[2] * d[2] + d[3] * d[3]), tid & 63);
          const float rstd = 1.0f / sqrtf(q * (1.0f / 128.0f) + RET_GN_EPS);
          float r4[4];
#pragma unroll
          for (int j = 0; j < 4; ++j) { const float g = bf2f(H[row * PINP + C_TG + hh * 128 + e0 + j]); const float sil = g / (1.0f + expf(-g));
              r4[j] = (d[j] * rstd * gnw[e0 + j] + gnb[e0 + j]) * sil; }
          u32x2 w; w.x = pk2(r4[0], r4[1]); w.y = pk2(r4[2], r4[3]); *(u32x2*)(MIX + row * DM + MIX_RET + hh * 128 + e0) = w; }
        __syncthreads();
    }
}
constexpr int RS = 136;
__device__ __forceinline__ int crow32(int r, int hi) { return (r & 3) + 8 * (r >> 2) + 4 * hi; }
constexpr int RET_G = 8, RET_CPG = (SEQ / 128) / RET_G;
typedef float f32x16r __attribute__((ext_vector_type(16)));
template <bool WANT_KB, bool WANT_KDT>
__device__ __forceinline__ void ret_stage_kv(const bf16_t* H, const f32x2* CS, int tid, size_t rowbase, int c, int hh, float lg2, LAS bf16_t* KB, LAS bf16_t* KDT, LAS bf16_t* VT) {
    const int kp = tid >> 3, part = tid & 7, f0 = part * 8;
    float y1[2][8], y2[2][8];
#pragma unroll
    for (int kk = 0; kk < 2; ++kk) { const int key = 2 * kp + kk; const bf16_t* hr = H + (rowbase + key) * PINP + C_TK + hh * 128 + f0;
        const bf16x8 x1 = *(const bf16x8*)hr, x2 = *(const bf16x8*)(hr + 64); const f32x4* cp = (const f32x4*)(CS + (size_t)(c * 128 + key) * 64 + f0);
        const f32x4 c0 = cp[0], c1 = cp[1], c2 = cp[2], c3 = cp[3]; const float cs[16] = {c0[0], c0[1], c0[2], c0[3], c1[0], c1[1], c1[2], c1[3], c2[0], c2[1], c2[2], c2[3], c3[0], c3[1], c3[2], c3[3]};
#pragma unroll
        for (int j = 0; j < 8; ++j) { const float a = bf2f((bf16_t)x1[j]), bb = bf2f((bf16_t)x2[j]), co = cs[2 * j], si = cs[2 * j + 1];
            y1[kk][j] = (a * co - bb * si) * 0.08838834764831845f; y2[kk][j] = (a * si + bb * co) * 0.08838834764831845f; }
        if (WANT_KB) { u32x4 w1, w2; w1.x = pk2(y1[kk][0], y1[kk][1]); w1.y = pk2(y1[kk][2], y1[kk][3]); w1.z = pk2(y1[kk][4], y1[kk][5]); w1.w = pk2(y1[kk][6], y1[kk][7]);
            w2.x = pk2(y2[kk][0], y2[kk][1]); w2.y = pk2(y2[kk][2], y2[kk][3]); w2.z = pk2(y2[kk][4], y2[kk][5]); w2.w = pk2(y2[kk][6], y2[kk][7]);
            *(LAS u32x4*)(KB + key * RS + f0) = w1; *(LAS u32x4*)(KB + key * RS + 64 + f0) = w2; } }
    if (WANT_KDT) { const float kd0 = __builtin_amdgcn_exp2f((float)(127 - 2 * kp) * lg2), kd1 = __builtin_amdgcn_exp2f((float)(126 - 2 * kp) * lg2);
#pragma unroll
        for (int j = 0; j < 8; ++j) { *(LAS unsigned*)(KDT + (f0 + j) * RS + 2 * kp) = pk2(y1[0][j] * kd0, y1[1][j] * kd1); *(LAS unsigned*)(KDT + (64 + f0 + j) * RS + 2 * kp) = pk2(y2[0][j] * kd0, y2[1][j] * kd1); } }
    const int e0 = part * 16; const bf16_t* v0p = H + (rowbase + 2 * kp) * PINP + C_TV + hh * 128 + e0; const bf16_t* v1p = v0p + PINP;
    const bf16x8 va0 = *(const bf16x8*)v0p, va1 = *(const bf16x8*)(v0p + 8), vb0 = *(const bf16x8*)v1p, vb1 = *(const bf16x8*)(v1p + 8);
#pragma unroll
    for (int j = 0; j < 8; ++j) { *(LAS unsigned*)(VT + (e0 + j) * RS + 2 * kp) = (unsigned)(unsigned short)va0[j] | ((unsigned)(unsigned short)vb0[j] << 16);
                                  *(LAS unsigned*)(VT + (e0 + 8 + j) * RS + 2 * kp) = (unsigned)(unsigned short)va1[j] | ((unsigned)(unsigned short)vb1[j] << 16); }
}
__device__ __forceinline__ void ret_kv_unit(PX p, int unit, LAS unsigned char* lds) {
    const int tid = otid(p.wvs), lane = tid & 63, wv = __builtin_amdgcn_readfirstlane(tid >> 6), r = lane & 31, hi = lane >> 5, wr = wv >> 1, wc = wv & 1;
    const int c = unit % (SEQ / 128), bhh = unit / (SEQ / 128), b = bhh / RETH, hh = bhh % RETH;
    LAS bf16_t* KDT = (LAS bf16_t*)(lds + 34816); LAS bf16_t* VT = (LAS bf16_t*)(lds + 69632);
    const bf16_t* H = (const bf16_t*)(p->ws + WS_H); const f32x2* CS = (const f32x2*)(p->ws + WS_CS);
    const float lg2 = log2f(1.0f - exp2f(-5.0f - (float)hh));
    const size_t rowbase = (size_t)b * SEQ + (size_t)c * 128;
    __syncthreads();
    ret_stage_kv<false, true>(H, CS, tid, rowbase, c, hh, lg2, nullptr, KDT, VT);
    __syncthreads();
    const LAS bf16_t* xv = VT + (32 * wr + r) * RS + 8 * hi; bf16x8 vf[8];
#pragma unroll
    for (int s = 0; s < 8; ++s) vf[s] = *(const LAS bf16x8*)(xv + 16 * s);
    u32x4* dst = (u32x4*)(p->ws + WS_KV) + ((size_t)unit * NTHR + tid) * 4;
#pragma unroll
    for (int n = 0; n < 2; ++n) { f32x16r rt = {}; const LAS bf16_t* yk = KDT + (64 * wc + 32 * n + r) * RS + 8 * hi;
#pragma unroll
        for (int s = 0; s < 8; ++s) rt = __builtin_amdgcn_mfma_f32_32x32x16_bf16(vf[s], *(const LAS bf16x8*)(yk + 16 * s), rt, 0, 0, 0);
        u32x4 w0, w1; w0.x = pk2(rt[0], rt[1]); w0.y = pk2(rt[2], rt[3]); w0.z = pk2(rt[4], rt[5]); w0.w = pk2(rt[6], rt[7]);
        w1.x = pk2(rt[8], rt[9]); w1.y = pk2(rt[10], rt[11]); w1.z = pk2(rt[12], rt[13]); w1.w = pk2(rt[14], rt[15]);
        dst[2 * n] = w0; dst[2 * n + 1] = w1; }
}
__device__ __forceinline__ void ret_kv_add(f32x16r (&RTacc)[2], const u32x4* src, float cdec) {
#pragma unroll
    for (int n = 0; n < 2; ++n) { const u32x4 w0 = src[2 * n], w1 = src[2 * n + 1]; const unsigned ww[8] = {w0.x, w0.y, w0.z, w0.w, w1.x, w1.y, w1.z, w1.w};
#pragma unroll
        for (int i = 0; i < 8; ++i) { RTacc[n][2 * i] = RTacc[n][2 * i] * cdec + __uint_as_float(ww[i] << 16); RTacc[n][2 * i + 1] = RTacc[n][2 * i + 1] * cdec + __uint_as_float(ww[i] & 0xffff0000u); } }
}
__device__ __forceinline__ void ret_mfma_unit(PX p, int layer, int unit, LAS unsigned char* lds) {
    typedef f32x16r f32x16;
    const int tid = otid(p.wvs), lane = tid & 63, wv = __builtin_amdgcn_readfirstlane(tid >> 6), r = lane & 31, hi = lane >> 5, wr = wv >> 1, wc = wv & 1;
    const int grp = unit % RET_G, bhh = unit / RET_G, b = bhh / RETH, hh = bhh % RETH;
    LAS bf16_t* KB = (LAS bf16_t*)lds; LAS bf16_t* KDT = (LAS bf16_t*)(lds + 34816); LAS bf16_t* VT = (LAS bf16_t*)(lds + 69632); LAS bf16_t* RT = (LAS bf16_t*)(lds + 104448);
    LAS float* OB = (LAS float*)lds;
    const bf16_t* H = (const bf16_t*)(p->ws + WS_H); const f32x2* CS = (const f32x2*)(p->ws + WS_CS); bf16_t* MIX = (bf16_t*)(p->ws + WS_XB);
    const float lg2 = log2f(1.0f - exp2f(-5.0f - (float)hh));
    const float* gnw = p->in[14] + layer * 640 + hh * 128; const float* gnb = p->in[15] + layer * 640 + hh * 128;
    f32x16 RTacc[2];
#pragma unroll
    for (int n = 0; n < 2; ++n)
#pragma unroll
        for (int i = 0; i < 16; ++i) RTacc[n][i] = 0.f;
    const float cdec = __builtin_amdgcn_exp2f(128.0f * lg2);
    const u32x4* kvsrc = (const u32x4*)(p->ws + WS_KV) + ((size_t)bhh * (SEQ / 128) * NTHR + tid) * 4;
    for (int cp = 0; cp < grp * RET_CPG; cp += 4) {
        u32x4 t[4][4];
#pragma unroll
        for (int j = 0; j < 4; ++j)
#pragma unroll
            for (int i = 0; i < 4; ++i) t[j][i] = kvsrc[(size_t)(cp + j) * NTHR * 4 + i];
#pragma unroll
        for (int j = 0; j < 4; ++j) { const float w = __builtin_amdgcn_exp2f((float)(grp * RET_CPG - 1 - cp - j) * 128.0f * lg2);
#pragma unroll
            for (int n = 0; n < 2; ++n) { const unsigned ww[8] = {t[j][2 * n].x, t[j][2 * n].y, t[j][2 * n].z, t[j][2 * n].w, t[j][2 * n + 1].x, t[j][2 * n + 1].y, t[j][2 * n + 1].z, t[j][2 * n + 1].w};
#pragma unroll
                for (int i = 0; i < 8; ++i) { RTacc[n][2 * i] += w * __uint_as_float(ww[i] << 16); RTacc[n][2 * i + 1] += w * __uint_as_float(ww[i] & 0xffff0000u); } } }
    }
    __syncthreads();
#pragma unroll
    for (int n = 0; n < 2; ++n)
#pragma unroll
        for (int i = 0; i < 16; ++i) RT[(32 * wr + crow32(i, hi)) * RS + 64 * wc + 32 * n + r] = (bf16_t)f2bf(RTacc[n][i]);
    for (int c = grp * RET_CPG; c < (grp + 1) * RET_CPG; ++c) {
        const size_t rowbase = (size_t)b * SEQ + (size_t)c * 128;
        int tl = tid; asm volatile("; per-chunk tid" : "+v"(tl));
        const int r_ = tl & 31, hi_ = (tl >> 5) & 1;
        __syncthreads();
        ret_stage_kv<true, false>(H, CS, tl, rowbase, c, hh, lg2, KB, KDT, VT);
        bf16x8 qf[8];
        {
            const int q = 32 * wr + r_; const bf16_t* hr = H + (rowbase + q) * PINP + C_TQ + hh * 128 + 8 * hi_; const f32x4* cp = (const f32x4*)(CS + (size_t)(c * 128 + q) * 64 + 8 * hi_);
#pragma unroll
            for (int s = 0; s < 4; ++s) { const bf16x8 x1 = *(const bf16x8*)(hr + 16 * s), x2 = *(const bf16x8*)(hr + 64 + 16 * s);
                const f32x4 c0 = cp[8 * s], c1 = cp[8 * s + 1], c2 = cp[8 * s + 2], c3 = cp[8 * s + 3]; const float cs[16] = {c0[0], c0[1], c0[2], c0[3], c1[0], c1[1], c1[2], c1[3], c2[0], c2[1], c2[2], c2[3], c3[0], c3[1], c3[2], c3[3]};
                float y1[8], y2[8];
#pragma unroll
                for (int j = 0; j < 8; ++j) { const float a = bf2f((bf16_t)x1[j]), bb = bf2f((bf16_t)x2[j]), co = cs[2 * j], si = cs[2 * j + 1]; y1[j] = a * co - bb * si; y2[j] = a * si + bb * co; }
                u32x4 w1, w2; w1.x = pk2(y1[0], y1[1]); w1.y = pk2(y1[2], y1[3]); w1.z = pk2(y1[4], y1[5]); w1.w = pk2(y1[6], y1[7]);
                w2.x = pk2(y2[0], y2[1]); w2.y = pk2(y2[2], y2[3]); w2.z = pk2(y2[4], y2[5]); w2.w = pk2(y2[6], y2[7]);
                qf[s] = *reinterpret_cast<bf16x8*>(&w1); qf[s + 4] = *reinterpret_cast<bf16x8*>(&w2); }
        }
        __syncthreads();
        const u32x4* kvc = (const u32x4*)(p->ws + WS_KV) + ((size_t)(bhh * (SEQ / 128) + c) * NTHR + tl) * 4; const u32x4 kv0 = kvc[0], kv1 = kvc[1], kv2 = kvc[2], kv3 = kvc[3];
        f32x16 O[2], S[2];
#pragma unroll
        for (int n = 0; n < 2; ++n) {
            f32x16 o = {}, sc = {};
            const LAS bf16_t* yr = RT + (64 * wc + 32 * n + r) * RS + 8 * hi; const LAS bf16_t* yk = KB + (64 * wc + 32 * n + r) * RS + 8 * hi;
#pragma unroll
            for (int s = 0; s < 8; ++s) { o = __builtin_amdgcn_mfma_f32_32x32x16_bf16(qf[s], *(const LAS bf16x8*)(yr + 16 * s), o, 0, 0, 0);
                                          sc = __builtin_amdgcn_mfma_f32_32x32x16_bf16(qf[s], *(const LAS bf16x8*)(yk + 16 * s), sc, 0, 0, 0); }
            O[n] = o; S[n] = sc;
        }
#pragma unroll
        for (int i = 0; i < 16; ++i) { const int q = 32 * wr + crow32(i, hi); const float qd = __builtin_amdgcn_exp2f((float)(q + 1) * lg2);
#pragma unroll
            for (int n = 0; n < 2; ++n) { O[n][i] *= qd; const int key = 64 * wc + 32 * n + r; S[n][i] = q >= key ? S[n][i] * __builtin_amdgcn_exp2f((float)(q - key) * lg2) : 0.f; } }
        __syncthreads();
#pragma unroll
        for (int n = 0; n < 2; ++n)
#pragma unroll
            for (int i = 0; i < 16; ++i) KB[(32 * wr + crow32(i, hi)) * RS + 64 * wc + 32 * n + r] = (bf16_t)f2bf(S[n][i]);
        __syncthreads();
        {
            const LAS bf16_t* xp = KB + (32 * wr + r) * RS + 8 * hi;
            bf16x8 pf[8];
#pragma unroll
            for (int s = 0; s < 8; ++s) pf[s] = *(const LAS bf16x8*)(xp + 16 * s);
#pragma unroll
            for (int n = 0; n < 2; ++n) { f32x16 o = O[n]; const LAS bf16_t* yv = VT + (64 * wc + 32 * n + r) * RS + 8 * hi;
#pragma unroll
                for (int s = 0; s < 8; ++s) o = __builtin_amdgcn_mfma_f32_32x32x16_bf16(pf[s], *(const LAS bf16x8*)(yv + 16 * s), o, 0, 0, 0);
                O[n] = o; }
            { const u32x4 kvv[4] = {kv0, kv1, kv2, kv3}; ret_kv_add(RTacc, kvv, cdec); }
        }
        __syncthreads();
#pragma unroll
        for (int n = 0; n < 2; ++n)
#pragma unroll
            for (int i = 0; i < 16; ++i) { const int row = 32 * wr + crow32(i, hi), col = 64 * wc + 32 * n + r; RT[row * RS + col] = (bf16_t)f2bf(RTacc[n][i]); OB[row * 132 + col] = O[n][i]; }
        __syncthreads();
        {
            const int q = tl >> 2, qu = tl & 3; const size_t row = rowbase + q; const LAS float* ob = OB + q * 132 + 32 * qu;
            f32x4 v[8]; float sm = 0.f;
#pragma unroll
            for (int i = 0; i < 8; ++i) { v[i] = *(const LAS f32x4*)(ob + 4 * i); sm += (v[i][0] + v[i][1]) + (v[i][2] + v[i][3]); }
            sm = dpp_add<0xB1>(sm); sm = dpp_add<0x4E>(sm);
            const float mean = sm * (1.0f / 128.0f); float qq = 0.f;
#pragma unroll
            for (int i = 0; i < 8; ++i) { const f32x4 d = v[i] - mean; qq += (d[0] * d[0] + d[1] * d[1]) + (d[2] * d[2] + d[3] * d[3]); }
            qq = dpp_add<0xB1>(qq); qq = dpp_add<0x4E>(qq);
            const float rstd = 1.0f / sqrtf(qq * (1.0f / 128.0f) + RET_GN_EPS);
            const bf16_t* gp = H + row * PINP + C_TG + hh * 128 + 32 * qu; bf16_t* mp = MIX + row * DM + MIX_RET + hh * 128 + 32 * qu;
#pragma unroll
            for (int i = 0; i < 4; ++i) { const bf16x8 g8 = *(const bf16x8*)(gp + 8 * i); float o8[8];
#pragma unroll
                for (int j = 0; j < 8; ++j) { const int e = 8 * i + j; const float x = v[e >> 2][e & 3]; const float g = bf2f((bf16_t)g8[j]); const float sil = g / (1.0f + __expf(-g));
                    o8[j] = ((x - mean) * rstd * gnw[32 * qu + e] + gnb[32 * qu + e]) * sil; }
                u32x4 w; w.x = pk2(o8[0], o8[1]); w.y = pk2(o8[2], o8[3]); w.z = pk2(o8[4], o8[5]); w.w = pk2(o8[6], o8[7]); *(u32x4*)(mp + 8 * i) = w; }
        }
    }
    __syncthreads();
}
namespace rk {
constexpr int AT = 0, BT = 2304, KT = 4608, RM = 6912, WT = 10240, ATT = 13568, KBH = 18688, PVT = 23808, E15 = 28928, NAB = 29184, NKT = 30464, TT = 31744, CHB = 33024;
constexpr int SB = 4 * CHB, HS = SB + 4 * 2304, LDS_END = HS + 2048;
static_assert(LDS_END <= MISC_OFF, "rwkv chunk LDS map");
typedef float f32x4 __attribute__((ext_vector_type(4)));
__device__ __forceinline__ f32x4 mm16(const LAS bf16_t* A, int lda, const LAS bf16_t* B, int ldb, int nks, f32x4 acc, int l15, int qq) {
    for (int s = 0; s < nks; ++s) { const bf16x8 a = *(const LAS bf16x8*)(A + l15 * lda + 32 * s + 8 * qq), b = *(const LAS bf16x8*)(B + l15 * ldb + 32 * s + 8 * qq);
        acc = __builtin_amdgcn_mfma_f32_16x16x32_bf16(a, b, acc, 0, 0, 0); }
    return acc;
}
__device__ __forceinline__ void store_t(LAS bf16_t* D, f32x4 c) { u32x2 w; w.x = pk2(c[0], c[1]); w.y = pk2(c[2], c[3]); *(LAS u32x2*)D = w; }
}
__device__ __forceinline__ void rwkv_chunk_unit(PX p, int bh, LAS unsigned char* lds) {
    using namespace rk;
    const int tid = otid(p.wvs), lane = tid & 63, wv = __builtin_amdgcn_readfirstlane(tid >> 6), l15 = lane & 15, qq = lane >> 4, b = bh / RWH, hd = bh % RWH;
    const int cq = wv >> 1, ch = wv & 1;
    for (int i = tid; i < LDS_END / 4; i += NTHR) ((LAS unsigned*)lds)[i] = 0u;
    const _Float16* src = (const _Float16*)(p->ws + WS_SCAN) + (size_t)bh * SEQ * 384 + lane;
    float* Y = (float*)(p->ws + WS_YRAW);
    LAS unsigned char* cb = lds + cq * CHB;
    LAS float* hs = (LAS float*)(lds + HS);
    f32x4 ST[4];
#pragma unroll
    for (int m = 0; m < 4; ++m) ST[m] = (f32x4){0.f, 0.f, 0.f, 0.f};
    _Float16 in[8][6];
#pragma unroll
    for (int n = 0; n < 8; ++n)
#pragma unroll
        for (int o = 0; o < 6; ++o) in[n][o] = src[(size_t)(wv * 8 + n) * 384 + o * 64];
    __syncthreads();
    for (int sc = 0; sc < SEQ / 64; ++sc) {
        float ld[8], clv[8], run = 0.f;
#pragma unroll
        for (int n = 0; n < 8; ++n) { ld[n] = (float)in[n][1]; run += ld[n]; clv[n] = run; }
        hs[wv * 64 + lane] = run;
        __syncthreads();
        const float other = hs[(wv ^ 1) * 64 + lane]; const float pre = ch ? other : 0.f, tot = run + other;
        {
            float va[8], vb[8], vk[8], vkh[8], vbh[8];
            LAS bf16_t* at = (LAS bf16_t*)(cb + AT); LAS bf16_t* bt = (LAS bf16_t*)(cb + BT); LAS bf16_t* kt = (LAS bf16_t*)(cb + KT); LAS bf16_t* rm = (LAS bf16_t*)(cb + RM);
#pragma unroll
            for (int n = 0; n < 8; ++n) { const int i = 8 * ch + n; const float cl = pre + clv[n]; const float E = __expf(cl), Eex = __expf(cl - ld[n]), Einv = __expf(-cl), Eh = __expf(tot - cl);
                const float r = (float)in[n][0], k = (float)in[n][2], a = (float)in[n][3], bb = (float)in[n][4];
                va[n] = a * Eex; vb[n] = bb * Einv; vk[n] = k * Einv; vkh[n] = k * Eh; vbh[n] = bb * Eh;
                at[i * 72 + lane] = (bf16_t)f2bf(va[n]); bt[i * 72 + lane] = (bf16_t)f2bf(vb[n]); kt[i * 72 + lane] = (bf16_t)f2bf(vk[n]); rm[i * 104 + lane] = (bf16_t)f2bf(r * E); }
            u32x4 w;
            w.x = pk2(va[0], va[1]); w.y = pk2(va[2], va[3]); w.z = pk2(va[4], va[5]); w.w = pk2(va[6], va[7]); *(LAS u32x4*)((LAS bf16_t*)(cb + ATT) + lane * 40 + 8 * ch) = w;
            w.x = pk2(vkh[0], vkh[1]); w.y = pk2(vkh[2], vkh[3]); w.z = pk2(vkh[4], vkh[5]); w.w = pk2(vkh[6], vkh[7]); *(LAS u32x4*)((LAS bf16_t*)(cb + KBH) + lane * 40 + 8 * ch) = w;
            w.x = pk2(vbh[0], vbh[1]); w.y = pk2(vbh[2], vbh[3]); w.z = pk2(vbh[4], vbh[5]); w.w = pk2(vbh[6], vbh[7]); *(LAS u32x4*)((LAS bf16_t*)(cb + KBH) + lane * 40 + 16 + 8 * ch) = w;
            w.x = pk2((float)in[0][5], (float)in[1][5]); w.y = pk2((float)in[2][5], (float)in[3][5]); w.z = pk2((float)in[4][5], (float)in[5][5]); w.w = pk2((float)in[6][5], (float)in[7][5]);
            *(LAS u32x4*)((LAS bf16_t*)(cb + PVT) + lane * 40 + 8 * ch) = w;
            if (ch == 0) ((LAS float*)(cb + E15))[lane] = __expf(tot);
        }
        __syncthreads();
        if (sc + 1 < SEQ / 64) {
#pragma unroll
            for (int n = 0; n < 8; ++n)
#pragma unroll
                for (int o = 0; o < 6; ++o) in[n][o] = src[(size_t)((sc + 1) * 64 + wv * 8 + n) * 384 + o * 64]; }
        {
            const LAS bf16_t* at = (const LAS bf16_t*)(cb + AT); const LAS bf16_t* bt = (const LAS bf16_t*)(cb + BT); const LAS bf16_t* kt = (const LAS bf16_t*)(cb + KT); LAS bf16_t* rm = (LAS bf16_t*)(cb + RM);
            const f32x4 z = {0.f, 0.f, 0.f, 0.f};
            if (ch == 0) {
                f32x4 nab = mm16(at, 72, bt, 72, 2, z, l15, qq), nak = mm16(at, 72, kt, 72, 2, z, l15, qq);
#pragma unroll
                for (int g = 0; g < 4; ++g) { const bool ok = l15 < 4 * qq + g; ((LAS float*)(cb + NAB))[(4 * qq + g) * 20 + l15] = ok ? nab[g] : 0.f; nak[g] = ok ? nak[g] : 0.f; }
                store_t((LAS bf16_t*)(cb + NKT) + l15 * 40 + 4 * qq, nak);
            } else {
                f32x4 mrk = mm16(kt, 72, rm, 104, 2, z, l15, qq), mrb = mm16(bt, 72, rm, 104, 2, z, l15, qq);
#pragma unroll
                for (int g = 0; g < 4; ++g) { const bool ok = 4 * qq + g <= l15; mrk[g] = ok ? mrk[g] : 0.f; mrb[g] = ok ? mrb[g] : 0.f; }
                store_t(rm + l15 * 104 + 64 + 4 * qq, mrk); store_t(rm + l15 * 104 + 80 + 4 * qq, mrb);
            }
        }
        __syncthreads();
        if (wv == 0) {
            const LAS float* nab = (const LAS float*)(lds + qq * CHB + NAB); LAS bf16_t* tt = (LAS bf16_t*)(lds + qq * CHB + TT);
            float tc[16];
#pragma unroll
            for (int i = 0; i < 16; ++i) { float acc = (i == l15) ? 1.f : 0.f;
#pragma unroll
                for (int j4 = 0; j4 < 16; j4 += 4) { if (j4 < i) { const f32x4 nr = *(const LAS f32x4*)(nab + i * 20 + j4);
#pragma unroll
                        for (int j = 0; j < 4; ++j) if (j4 + j < i) acc += nr[j] * tc[j4 + j]; } }
                tc[i] = acc; tt[i * 40 + l15] = (bf16_t)f2bf(acc); }
        }
        __syncthreads();
        {
            const LAS bf16_t* att = (const LAS bf16_t*)(cb + ATT); const LAS bf16_t* tt = (const LAS bf16_t*)(cb + TT); LAS bf16_t* wt = (LAS bf16_t*)(cb + WT);
            const f32x4 z = {0.f, 0.f, 0.f, 0.f};
#pragma unroll
            for (int mm = 0; mm < 2; ++mm) { const int mt = 2 * ch + mm; const f32x4 c = mm16(att + 16 * mt * 40, 40, tt, 40, 1, z, l15, qq);
                store_t(wt + l15 * 104 + 16 * mt + 4 * qq, c); }
            if (ch == 0) { const f32x4 c = mm16((const LAS bf16_t*)(cb + NKT), 40, tt, 40, 1, z, l15, qq); store_t(wt + l15 * 104 + 64 + 4 * qq, c); }
        }
        __syncthreads();
        if (wv < 4) {
            LAS bf16_t* sb = (LAS bf16_t*)(lds + SB + wv * 2304);
            for (int q = 0; q < 4; ++q) {
                LAS unsigned char* cc = lds + q * CHB; const LAS bf16_t* wt = (const LAS bf16_t*)(cc + WT); const LAS bf16_t* rm = (const LAS bf16_t*)(cc + RM);
                LAS bf16_t* pvt = (LAS bf16_t*)(cc + PVT) + (16 * wv) * 40; const LAS bf16_t* kbh = (const LAS bf16_t*)(cc + KBH);
                const bf16x8 s0 = *(const LAS bf16x8*)(sb + l15 * 72 + 8 * qq), s1 = *(const LAS bf16x8*)(sb + l15 * 72 + 32 + 8 * qq);
                bf16x8 pv = *(const LAS bf16x8*)(pvt + l15 * 40 + 8 * qq);
                f32x4 P = {0.f, 0.f, 0.f, 0.f};
                P = __builtin_amdgcn_mfma_f32_16x16x32_bf16(*(const LAS bf16x8*)(wt + l15 * 104 + 8 * qq), s0, P, 0, 0, 0);
                P = __builtin_amdgcn_mfma_f32_16x16x32_bf16(*(const LAS bf16x8*)(wt + l15 * 104 + 32 + 8 * qq), s1, P, 0, 0, 0);
                P = __builtin_amdgcn_mfma_f32_16x16x32_bf16(*(const LAS bf16x8*)(wt + l15 * 104 + 64 + 8 * qq), pv, P, 0, 0, 0);
                store_t(pvt + l15 * 40 + 16 + 4 * qq, P);
                pv = *(const LAS bf16x8*)(pvt + l15 * 40 + 8 * qq);
                f32x4 Yc = {0.f, 0.f, 0.f, 0.f};
                Yc = __builtin_amdgcn_mfma_f32_16x16x32_bf16(*(const LAS bf16x8*)(rm + l15 * 104 + 8 * qq), s0, Yc, 0, 0, 0);
                Yc = __builtin_amdgcn_mfma_f32_16x16x32_bf16(*(const LAS bf16x8*)(rm + l15 * 104 + 32 + 8 * qq), s1, Yc, 0, 0, 0);
                Yc = __builtin_amdgcn_mfma_f32_16x16x32_bf16(*(const LAS bf16x8*)(rm + l15 * 104 + 64 + 8 * qq), pv, Yc, 0, 0, 0);
                const LAS float* e15 = (const LAS float*)(cc + E15);
#pragma unroll
                for (int m = 0; m < 4; ++m) { const f32x4 e = *(const LAS f32x4*)(e15 + 16 * m + 4 * qq);
                    ST[m] = __builtin_amdgcn_mfma_f32_16x16x32_bf16(*(const LAS bf16x8*)(kbh + (16 * m + l15) * 40 + 8 * qq), pv, ST[m] * e, 0, 0, 0);
                    store_t(sb + l15 * 72 + 16 * m + 4 * qq, ST[m]); }
                float* yo = Y + ((size_t)b * SEQ + (size_t)sc * 64 + 16 * q + 4 * qq) * 640 + hd * 64 + 16 * wv + l15;
#pragma unroll
                for (int g = 0; g < 4; ++g) yo[(size_t)g * 640] = Yc[g];
            }
        }
        __syncthreads();
    }
}
namespace rk2 {
constexpr int P_WT = 0, P_RM = 3072, P_KBH = 6144, P_VT = 10240, P_E15 = 12288, P_SZ = 12544;
constexpr int XW = 0, XA = 9216, WUP = 18432, AUP = 27648, WLT = 40960, ALT = 58368;
static_assert(ALT + 17408 <= 4 * rk::CHB && (size_t)NB * RWH * (SEQ / 16) * P_SZ <= 245 * MiB, "rwkv packet / staging map");
}
__device__ __forceinline__ void rwkv_prep_unit(PX p, int layer, int unit, LAS unsigned char* lds) {
    using namespace rk;
    const int tid = otid(p.wvs), lane = tid & 63, wv = __builtin_amdgcn_readfirstlane(tid >> 6), l15 = lane & 15, qq = lane >> 4;
    const int tile = unit % (SEQ / 64), b = unit / (SEQ / 64);
    const int cq = wv >> 1, ch = wv & 1, s0 = tile * 64;
    const bf16_t* H = (const bf16_t*)(p->ws + WS_H); const float* mu = p->in[3] + (size_t)layer * 2176;
    LAS unsigned char* cb = lds + cq * CHB; LAS float* hs = (LAS float*)(lds + HS);
    u32x4 xin0, xin1; const int xtt = tid >> 3, xj0 = (tid & 7) * 16;
    {
        const int s = s0 + xtt; const size_t row = (size_t)b * SEQ + s;
        const bf16_t* hc = H + row * PINP + C_WD + xj0; const bf16_t* hp = hc - PINP;
        const bf16_t* hq = s > 0 ? hp : hc; const float pm = s > 0 ? 1.f : 0.f;
        const bf16x8 c0 = *(const bf16x8*)hc, c1 = *(const bf16x8*)(hc + 8), p0 = *(const bf16x8*)hq, p1 = *(const bf16x8*)(hq + 8);
        float x[16];
#pragma unroll
        for (int i = 0; i < 16; ++i) { const float cu = bf2f((bf16_t)(i < 8 ? c0[i] : c1[i - 8])), pr = pm * bf2f((bf16_t)(i < 8 ? p0[i] : p1[i - 8]));
            x[i] = tshift(cu, pr, mu[1920 + xj0 + i]); if (xj0 < 64) x[i] = 1.0f - 2.0f * __builtin_amdgcn_rcpf(1.0f + __expf(2.0f * x[i])); }
        xin0.x = pk2(x[0], x[1]); xin0.y = pk2(x[2], x[3]); xin0.z = pk2(x[4], x[5]); xin0.w = pk2(x[6], x[7]);
        xin1.x = pk2(x[8], x[9]); xin1.y = pk2(x[10], x[11]); xin1.z = pk2(x[12], x[13]); xin1.w = pk2(x[14], x[15]);
    }
    const bf16_t* hr = H + ((size_t)b * SEQ + s0 + wv * 8) * PINP; const bool hasp = s0 + wv * 8 > 0; const bf16_t* hqr = hasp ? hr - PINP : hr; const float pmr = hasp ? 1.f : 0.f;
    float wgt[16]; bf16_t raw[27];
#define PREP_LOAD(hd_) do { const float* wu_ = p->in[5] + (size_t)layer * 64 * 640 + (hd_) * 64; const float* au_ = p->in[7] + (size_t)layer * 64 * 640 + (hd_) * 64; \
        _Pragma("unroll") for (int i = 0; i < 8; ++i) { const int idx = tid + NTHR * i, j = idx >> 6, cc = idx & 63; wgt[i] = wu_[j * 640 + cc]; wgt[8 + i] = au_[j * 640 + cc]; } \
        const int c_ = (hd_) * 64 + lane; raw[0] = hqr[C_RR + c_]; raw[1] = hqr[C_RK + c_]; raw[2] = hqr[C_RV + c_]; \
        _Pragma("unroll") for (int n = 0; n < 8; ++n) { raw[3 + 3 * n] = hr[(size_t)n * PINP + C_RR + c_]; raw[4 + 3 * n] = hr[(size_t)n * PINP + C_RK + c_]; raw[5 + 3 * n] = hr[(size_t)n * PINP + C_RV + c_]; } } while (0)
    PREP_LOAD(0);
  for (int hd = 0; hd < RWH; ++hd) {
    const int bh = b * RWH + hd, c = hd * 64 + lane;
    __syncthreads();
    {
        LAS bf16_t* dst = (LAS bf16_t*)(lds + (xj0 < 64 ? rk2::XW : rk2::XA)) + xtt * 72 + (xj0 & 63);
        *(LAS u32x4*)dst = xin0; *(LAS u32x4*)(dst + 8) = xin1;
#pragma unroll
        for (int i = 0; i < 8; ++i) { const int idx = tid + NTHR * i, j = idx >> 6, cc = idx & 63;
            ((LAS bf16_t*)(lds + rk2::WUP))[cc * 72 + j] = (bf16_t)f2bf(wgt[i]); ((LAS bf16_t*)(lds + rk2::AUP))[cc * 72 + j] = (bf16_t)f2bf(wgt[8 + i]); }
    }
    float rr[8], kk_[8], vv[8];
    { const float mur = mu[c], muk = mu[640 + c], muv = mu[1280 + c];
      float rp = pmr * bf2f(raw[0]), kp = pmr * bf2f(raw[1]), vp = pmr * bf2f(raw[2]);
#pragma unroll
      for (int n = 0; n < 8; ++n) { const float rc = bf2f(raw[3 + 3 * n]), kc = bf2f(raw[4 + 3 * n]), vc = bf2f(raw[5 + 3 * n]);
          rr[n] = tshift(rc, rp, mur); kk_[n] = tshift(kc, kp, muk); vv[n] = tshift(vc, vp, muv); rp = rc; kp = kc; vp = vc; } }
    PREP_LOAD(hd + 1 < RWH ? hd + 1 : hd);
    __syncthreads();
    {
        const int mat = wv >> 2, mt = wv & 3; const LAS bf16_t* X = (const LAS bf16_t*)(lds + (mat ? rk2::XA : rk2::XW)) + 16 * mt * 72;
        const LAS bf16_t* W = (const LAS bf16_t*)(lds + (mat ? rk2::AUP : rk2::WUP)); LAS float* O = (LAS float*)(lds + (mat ? rk2::ALT : rk2::WLT));
        const f32x4 z = {0.f, 0.f, 0.f, 0.f};
#pragma unroll
        for (int nt = 0; nt < 4; ++nt) { const f32x4 cc = mm16(X, 72, W + 16 * nt * 72, 72, 2, z, l15, qq);
            *(LAS f32x4*)(O + (16 * nt + l15) * 68 + 16 * mt + 4 * qq) = cc; }
    }
    __syncthreads();
    float wl[8], al[8];
    { const f32x4 a0 = *(const LAS f32x4*)((LAS float*)(lds + rk2::WLT) + lane * 68 + 8 * wv), a1 = *(const LAS f32x4*)((LAS float*)(lds + rk2::WLT) + lane * 68 + 8 * wv + 4);
      const f32x4 b0 = *(const LAS f32x4*)((LAS float*)(lds + rk2::ALT) + lane * 68 + 8 * wv), b1 = *(const LAS f32x4*)((LAS float*)(lds + rk2::ALT) + lane * 68 + 8 * wv + 4);
#pragma unroll
      for (int n = 0; n < 4; ++n) { wl[n] = a0[n]; wl[n + 4] = a1[n]; al[n] = b0[n]; al[n + 4] = b1[n]; } }
    __syncthreads();
    const float w0 = p->in[4][layer * 640 + c], a0c = p->in[6][layer * 640 + c], kkc = p->in[9][layer * 640 + c], kac = p->in[10][layer * 640 + c], rkc = p->in[11][layer * 640 + c];
    float* BON = (float*)(p->ws + WS_BONUS);
    float ld[8], clv[8], k2[8], av[8], bv[8], run = 0.f;
#pragma unroll
    for (int n = 0; n < 8; ++n) {
        const float nx = -(w0 + wl[n]); const float sp = fmaxf(nx, 0.f) + __logf(1.0f + __expf(-fabsf(nx)));
        ld[n] = -__expf(-sp - 0.5f); run += ld[n]; clv[n] = run;
        const float a = __builtin_amdgcn_rcpf(1.0f + __expf(-(a0c + al[n])));
        const float kk = kk_[n] * kkc; const float nrm = __builtin_amdgcn_sqrtf(wave_sum(kk * kk)); const float kkn = kk * __builtin_amdgcn_rcpf(fmaxf(nrm, 1e-12f));
        k2[n] = kk_[n] * (1.0f + (a - 1.0f) * kac); av[n] = -kkn; bv[n] = kkn * a;
        const float bon = wave_sum(rr[n] * k2[n] * rkc);
        if (lane == 0) BON[((size_t)b * SEQ + s0 + wv * 8 + n) * 16 + hd] = bon;
    }
    hs[wv * 64 + lane] = run;
    __syncthreads();
    const float other = hs[(wv ^ 1) * 64 + lane]; const float pre = ch ? other : 0.f, tot = run + other;
    {
        float va[8], vb[8], vk[8], vkh[8], vbh[8];
        LAS bf16_t* at = (LAS bf16_t*)(cb + AT); LAS bf16_t* bt = (LAS bf16_t*)(cb + BT); LAS bf16_t* kt = (LAS bf16_t*)(cb + KT); LAS bf16_t* rm = (LAS bf16_t*)(cb + RM);
#pragma unroll
        for (int n = 0; n < 8; ++n) { const int i = 8 * ch + n; const float cl = pre + clv[n]; const float E = __expf(cl), Eex = __expf(cl - ld[n]), Einv = __expf(-cl), Eh = __expf(tot - cl);
            va[n] = av[n] * Eex; vb[n] = bv[n] * Einv; vk[n] = k2[n] * Einv; vkh[n] = k2[n] * Eh; vbh[n] = bv[n] * Eh;
            at[i * 72 + lane] = (bf16_t)f2bf(va[n]); bt[i * 72 + lane] = (bf16_t)f2bf(vb[n]); kt[i * 72 + lane] = (bf16_t)f2bf(vk[n]); rm[i * 104 + lane] = (bf16_t)f2bf(rr[n] * E); }
        u32x4 w;
        w.x = pk2(va[0], va[1]); w.y = pk2(va[2], va[3]); w.z = pk2(va[4], va[5]); w.w = pk2(va[6], va[7]); *(LAS u32x4*)((LAS bf16_t*)(cb + ATT) + lane * 40 + 8 * ch) = w;
        w.x = pk2(vkh[0], vkh[1]); w.y = pk2(vkh[2], vkh[3]); w.z = pk2(vkh[4], vkh[5]); w.w = pk2(vkh[6], vkh[7]); *(LAS u32x4*)((LAS bf16_t*)(cb + KBH) + lane * 40 + 8 * ch) = w;
        w.x = pk2(vbh[0], vbh[1]); w.y = pk2(vbh[2], vbh[3]); w.z = pk2(vbh[4], vbh[5]); w.w = pk2(vbh[6], vbh[7]); *(LAS u32x4*)((LAS bf16_t*)(cb + KBH) + lane * 40 + 16 + 8 * ch) = w;
        w.x = pk2(vv[0], vv[1]); w.y = pk2(vv[2], vv[3]); w.z = pk2(vv[4], vv[5]); w.w = pk2(vv[6], vv[7]); *(LAS u32x4*)((LAS bf16_t*)(cb + PVT) + lane * 40 + 8 * ch) = w;
        const u32x4 zz = {0u, 0u, 0u, 0u};
        *(LAS u32x4*)((LAS bf16_t*)(cb + ATT) + lane * 40 + 16 + 8 * ch) = zz;
        if (lane < 16) { *(LAS u32x4*)((LAS bf16_t*)(cb + NKT) + lane * 40 + 16 + 8 * ch) = zz; *(LAS u32x4*)((LAS bf16_t*)(cb + TT) + lane * 40 + 16 + 8 * ch) = zz; *(LAS u32x4*)((LAS bf16_t*)(cb + WT) + lane * 104 + 80 + 8 * ch) = zz; }
        if (ch == 0) ((LAS float*)(cb + E15))[lane] = __expf(tot);
    }
    __syncthreads();
    {
        const LAS bf16_t* at = (const LAS bf16_t*)(cb + AT); const LAS bf16_t* bt = (const LAS bf16_t*)(cb + BT); const LAS bf16_t* kt = (const LAS bf16_t*)(cb + KT); LAS bf16_t* rm = (LAS bf16_t*)(cb + RM);
        const f32x4 z = {0.f, 0.f, 0.f, 0.f};
        if (ch == 0) {
            f32x4 nab = mm16(at, 72, bt, 72, 2, z, l15, qq), nak = mm16(at, 72, kt, 72, 2, z, l15, qq);
#pragma unroll
            for (int g = 0; g < 4; ++g) { const bool ok = l15 < 4 * qq + g; ((LAS float*)(cb + NAB))[(4 * qq + g) * 20 + l15] = ok ? nab[g] : 0.f; nak[g] = ok ? nak[g] : 0.f; }
            store_t((LAS bf16_t*)(cb + NKT) + l15 * 40 + 4 * qq, nak);
            asm volatile("s_waitcnt lgkmcnt(0)" ::: "memory");
            if (lane < 16) {
                const LAS float* nabr = (const LAS float*)(cb + NAB); LAS bf16_t* tt = (LAS bf16_t*)(cb + TT);
                float tc[16];
#pragma unroll
                for (int i = 0; i < 16; ++i) { float acc = (i == lane) ? 1.f : 0.f;
#pragma unroll
                    for (int j4 = 0; j4 < 16; j4 += 4) { if (j4 < i) { const f32x4 nr = *(const LAS f32x4*)(nabr + i * 20 + j4);
#pragma unroll
                            for (int j = 0; j < 4; ++j) if (j4 + j < i) acc += nr[j] * tc[j4 + j]; } }
                    tc[i] = acc; tt[i * 40 + lane] = (bf16_t)f2bf(acc); }
            }
        } else {
            f32x4 mrk = mm16(kt, 72, rm, 104, 2, z, l15, qq), mrb = mm16(bt, 72, rm, 104, 2, z, l15, qq);
#pragma unroll
            for (int g = 0; g < 4; ++g) { const bool ok = 4 * qq + g <= l15; mrk[g] = ok ? mrk[g] : 0.f; mrb[g] = ok ? mrb[g] : 0.f; }
            store_t(rm + l15 * 104 + 64 + 4 * qq, mrk); store_t(rm + l15 * 104 + 80 + 4 * qq, mrb);
        }
    }
    __syncthreads();
    {
        const LAS bf16_t* att = (const LAS bf16_t*)(cb + ATT); const LAS bf16_t* tt = (const LAS bf16_t*)(cb + TT); LAS bf16_t* wt = (LAS bf16_t*)(cb + WT);
        const f32x4 z = {0.f, 0.f, 0.f, 0.f};
#pragma unroll
        for (int mm = 0; mm < 2; ++mm) { const int mt = 2 * ch + mm; const f32x4 cc = mm16(att + 16 * mt * 40, 40, tt, 40, 1, z, l15, qq); store_t(wt + l15 * 104 + 16 * mt + 4 * qq, cc); }
        if (ch == 0) { const f32x4 cc = mm16((const LAS bf16_t*)(cb + NKT), 40, tt, 40, 1, z, l15, qq); store_t(wt + l15 * 104 + 64 + 4 * qq, cc); }
    }
    __syncthreads();
    {
        unsigned char* pk = p->ws + WS_SCAN + ((size_t)bh * (SEQ / 16) + (size_t)tile * 4) * rk2::P_SZ;
        for (int idx = tid; idx < 4 * 192; idx += NTHR) { const int q = idx / 192, rem = idx % 192, row = rem / 12, pc = rem % 12;
            *(u32x4*)(pk + (size_t)q * rk2::P_SZ + rk2::P_WT + (row * 96 + pc * 8) * 2) = *(const LAS u32x4*)((const LAS bf16_t*)(lds + q * CHB + WT) + row * 104 + pc * 8);
            *(u32x4*)(pk + (size_t)q * rk2::P_SZ + rk2::P_RM + (row * 96 + pc * 8) * 2) = *(const LAS u32x4*)((const LAS bf16_t*)(lds + q * CHB + RM) + row * 104 + pc * 8); }
        for (int idx = tid; idx < 4 * 256; idx += NTHR) { const int q = idx >> 8, rem = idx & 255, row = rem >> 2, pc = rem & 3;
            *(u32x4*)(pk + (size_t)q * rk2::P_SZ + rk2::P_KBH + (row * 32 + pc * 8) * 2) = *(const LAS u32x4*)((const LAS bf16_t*)(lds + q * CHB + KBH) + row * 40 + pc * 8); }
        { const int q = tid >> 7, rem = tid & 127, row = rem >> 1, pc = rem & 1;
          *(u32x4*)(pk + (size_t)q * rk2::P_SZ + rk2::P_VT + (row * 16 + pc * 8) * 2) = *(const LAS u32x4*)((const LAS bf16_t*)(lds + q * CHB + PVT) + row * 40 + pc * 8); }
        if (tid < 64) { const int q = tid >> 4, pc = tid & 15; *(u32x4*)(pk + (size_t)q * rk2::P_SZ + rk2::P_E15 + pc * 16) = *(const LAS u32x4*)(lds + q * CHB + E15 + pc * 16); }
    }
  }
#undef PREP_LOAD
}
namespace rk3 {
constexpr int L_WT = 0, L_RM = 3328, L_KBH = 6656, L_VT = 11776, L_E15 = 14848, L_SZ = 15104, NBATCH = 4, BUF0 = 16384, BUFB = NBATCH * L_SZ;
static_assert(BUF0 + 2 * BUFB <= MISC_OFF, "rwkv chain LDS map");
typedef float f32x2_ __attribute__((ext_vector_type(2))); typedef __bf16 bf16x2_ __attribute__((ext_vector_type(2)));
__device__ __forceinline__ unsigned cvt2(float a, float b) { const f32x2_ v = {a, b}; const bf16x2_ r = __builtin_convertvector(v, bf16x2_); return __builtin_bit_cast(unsigned, r); }
constexpr int NPIECE = 784;
__device__ __forceinline__ int lds_off(int r) {
    const int a0 = L_WT + (r / 12) * 208 + (r % 12) * 16; const int x1 = r - 192, a1 = L_RM + (x1 / 12) * 208 + (x1 % 12) * 16;
    const int x2 = r - 384, a2 = L_KBH + (x2 >> 2) * 80 + (x2 & 3) * 16; const int x3 = r - 640, a3 = L_VT + (x3 >> 1) * 48 + (x3 & 1) * 16; const int a4 = L_E15 + (r - 768) * 16;
    return r < 192 ? a0 : (r < 384 ? a1 : (r < 640 ? a2 : (r < 768 ? a3 : a4)));
}
}
__device__ __forceinline__ void rwkv_chain_unit(PX p, int bh, LAS unsigned char* lds) {
    using namespace rk;
    const int tid = otid(p.wvs), lane = tid & 63, wv = __builtin_amdgcn_readfirstlane(tid >> 6), l15 = lane & 15, qq = lane >> 4, b = bh / RWH, hd = bh % RWH;
    const unsigned char* pk = p->ws + WS_SCAN + (size_t)bh * (SEQ / 16) * rk2::P_SZ;
    constexpr int NB_ = (SEQ / 16) / rk3::NBATCH, PPB = rk3::NBATCH * rk3::NPIECE;
    __syncthreads();
    if (wv >= 4) {
        const int lt = tid - 256; u32x4 sa[13], sb_[13];
#define RK_LD(st, bi) do { const unsigned char* g_ = pk + (size_t)((bi) < NB_ ? (bi) : NB_ - 1) * rk3::NBATCH * rk2::P_SZ; \
        _Pragma("unroll") for (int i = 0; i < 13; ++i) { int x = lt + 256 * i; x = x < PPB ? x : PPB - 1; st[i] = __builtin_nontemporal_load((const u32x4*)(g_ + (size_t)x * 16)); } } while (0)
#define RK_ST(st, bi) do { LAS unsigned char* d_ = lds + rk3::BUF0 + ((bi) & 1) * rk3::BUFB; \
        _Pragma("unroll") for (int i = 0; i < 13; ++i) { int x = lt + 256 * i; x = x < PPB ? x : PPB - 1; const int q = x / rk3::NPIECE, r = x % rk3::NPIECE; *(LAS u32x4*)(d_ + q * rk3::L_SZ + rk3::lds_off(r)) = st[i]; } } while (0)
        asm volatile("; RKLOADER begin");
        RK_LD(sa, 0); RK_LD(sb_, 1); RK_ST(sa, 0); RK_LD(sa, 2);
        __syncthreads();
        for (int bi = 0; bi < NB_; bi += 2) {
            RK_ST(sb_, bi + 1); RK_LD(sb_, bi + 3); __syncthreads();
            RK_ST(sa, bi + 2); RK_LD(sa, bi + 4); __syncthreads();
        }
#undef RK_LD
#undef RK_ST
        return;
    }
    float* Y = (float*)(p->ws + WS_YRAW) + (size_t)b * SEQ * 640 + hd * 64 + 16 * wv + l15;
    f32x4 ST[4];
#pragma unroll
    for (int m = 0; m < 4; ++m) ST[m] = (f32x4){0.f, 0.f, 0.f, 0.f};
    __syncthreads();
#define RK_PK(v) rk3::cvt2((v)[0], (v)[1]), rk3::cvt2((v)[2], (v)[3])
#define RK_F8(lo, hi) ({ const u32x4 w_ = {(lo).x, (lo).y, (hi).x, (hi).y}; *reinterpret_cast<const bf16x8*>(&w_); })
    for (int bi = 0; bi < NB_; ++bi) {
#pragma unroll
        for (int q = 0; q < rk3::NBATCH; ++q) {
            const LAS unsigned char* cc = lds + rk3::BUF0 + (bi & 1) * rk3::BUFB + q * rk3::L_SZ;
            const LAS bf16_t* wt = (const LAS bf16_t*)(cc + rk3::L_WT) + l15 * 104 + 4 * qq; const LAS bf16_t* rm = (const LAS bf16_t*)(cc + rk3::L_RM) + l15 * 104 + 4 * qq;
            const LAS bf16_t* kbh = (const LAS bf16_t*)(cc + rk3::L_KBH) + l15 * 40 + 4 * qq; const LAS float* e15 = (const LAS float*)(cc + rk3::L_E15) + 4 * qq;
            const u32x2 vtf = *(const LAS u32x2*)((const LAS bf16_t*)(cc + rk3::L_VT) + (16 * wv + l15) * 24 + 4 * qq);
            const u32x2 w00 = *(const LAS u32x2*)(wt), w01 = *(const LAS u32x2*)(wt + 16), w10 = *(const LAS u32x2*)(wt + 32), w11 = *(const LAS u32x2*)(wt + 48), wtn = *(const LAS u32x2*)(wt + 64);
            const u32x2 r00 = *(const LAS u32x2*)(rm), r01 = *(const LAS u32x2*)(rm + 16), r10 = *(const LAS u32x2*)(rm + 32), r11 = *(const LAS u32x2*)(rm + 48), rmk = *(const LAS u32x2*)(rm + 64), rmb = *(const LAS u32x2*)(rm + 80);
            const u32x2 zz = {0u, 0u};
            const u32x2 s00 = {RK_PK(ST[0])}, s01 = {RK_PK(ST[1])}, s10 = {RK_PK(ST[2])}, s11 = {RK_PK(ST[3])};
            const bf16x8 sf0 = RK_F8(s00, s01), sf1 = RK_F8(s10, s11);
            f32x4 P = {0.f, 0.f, 0.f, 0.f};
            P = __builtin_amdgcn_mfma_f32_16x16x32_bf16(RK_F8(w00, w01), sf0, P, 0, 0, 0);
            P = __builtin_amdgcn_mfma_f32_16x16x32_bf16(RK_F8(w10, w11), sf1, P, 0, 0, 0);
            P = __builtin_amdgcn_mfma_f32_16x16x32_bf16(RK_F8(wtn, zz), RK_F8(vtf, zz), P, 0, 0, 0);
            const u32x2 pp = {RK_PK(P)};
            const bf16x8 pvf = RK_F8(vtf, pp);
            f32x4 Yc = {0.f, 0.f, 0.f, 0.f};
            Yc = __builtin_amdgcn_mfma_f32_16x16x32_bf16(RK_F8(r00, r01), sf0, Yc, 0, 0, 0);
            Yc = __builtin_amdgcn_mfma_f32_16x16x32_bf16(RK_F8(r10, r11), sf1, Yc, 0, 0, 0);
            Yc = __builtin_amdgcn_mfma_f32_16x16x32_bf16(RK_F8(rmk, rmb), pvf, Yc, 0, 0, 0);
#pragma unroll
            for (int m = 0; m < 4; ++m) { const u32x2 k0 = *(const LAS u32x2*)(kbh + 16 * m * 40), k1 = *(const LAS u32x2*)(kbh + 16 * m * 40 + 16);
                ST[m] = __builtin_amdgcn_mfma_f32_16x16x32_bf16(RK_F8(k0, k1), pvf, ST[m] * *(const LAS f32x4*)(e15 + 16 * m), 0, 0, 0); }
            float* yo = Y + ((size_t)(bi * rk3::NBATCH + q) * 16 + 4 * qq) * 640;
#pragma unroll
            for (int g = 0; g < 4; ++g) yo[(size_t)g * 640] = Yc[g];
        }
        __syncthreads();
    }
#undef RK_PK
#undef RK_F8
}
#define XB_TMO      128
#define XB_XCNT(j)  (256  + 64 * (j))
#define XB_XSUB(j)  (1280 + 64 * (j))
#define XB_XGEN(j)  (2304 + 64 * (j))
#define XB_TOP      3328
#define XB_TOPGEN   3392
#define XCD_BAR_WORDS 3456
#define XB_SPIN_CAP (1u << 18)

__device__ __forceinline__ unsigned xb_ld(unsigned* p)              { return __hip_atomic_load(p, __ATOMIC_RELAXED, __HIP_MEMORY_SCOPE_AGENT); }
__device__ __forceinline__ unsigned xb_add(unsigned* p, unsigned v) { return __hip_atomic_fetch_add(p, v, __ATOMIC_RELAXED, __HIP_MEMORY_SCOPE_AGENT); }
__device__ __forceinline__ unsigned xb_xcc_id() { return (unsigned)__builtin_amdgcn_s_getreg((3 << 11) | 20) & 0xFu; }
#define XB_SPIN(cond, bar) do { unsigned _sp = 0; while (cond) { __builtin_amdgcn_s_sleep(1); \
    if ((++_sp & 255u) == 0u) { if (xb_ld(&(bar)[XB_TMO])) break; if (_sp > XB_SPIN_CAP) { atomicAdd(&(bar)[XB_TMO], 1u); break; } } } } while (0)

struct XcdBarrier {
    bool lead;
    unsigned* bar; unsigned x;
    volatile LAS unsigned* st;
};

__device__ __forceinline__ XcdBarrier xcd_barrier_post(unsigned* bar, volatile LAS unsigned* st) {
    XcdBarrier b; b.bar = bar; b.x = xb_xcc_id(); b.st = st;
    if (threadIdx.x == 0) (void)xb_add(&bar[XB_XCNT(b.x)], 1u);
    return b;
}
__device__ __forceinline__ void xcd_barrier_complete(unsigned* bar, unsigned x, unsigned& nloc, unsigned& nx) {
    const unsigned G = gridDim.x * gridDim.y * gridDim.z;
    unsigned sum, cnt, mine, sp = 0u;
    for (;;) {
        sum = 0u; cnt = 0u; mine = 0u;
#pragma unroll
        for (unsigned j = 0; j < 16; ++j) { const unsigned c = xb_ld(&bar[XB_XCNT(j)]); sum += c; cnt += (c > 0u) ? 1u : 0u; mine = (j == x) ? c : mine; }
        if (sum == G) break;
        __builtin_amdgcn_s_sleep(1);
        if ((++sp & 255u) == 0u) { if (xb_ld(&bar[XB_TMO])) break; if (sp > XB_SPIN_CAP) { atomicAdd(&bar[XB_TMO], 1u); break; } }
    }
    nloc = mine > 0u ? mine : 1u; nx = cnt > 0u ? cnt : 1u;
}

__device__ __forceinline__ void xcd_barrier(const XcdBarrier& b) {
    asm volatile("s_waitcnt vmcnt(0)" ::: "memory");
    __syncthreads();
    if (b.lead) {
        unsigned* bar = b.bar;
        __builtin_amdgcn_s_waitcnt(0);
        unsigned nloc = b.st[0], nx = b.st[1];
        if (nloc == 0u) { xcd_barrier_complete(bar, b.x, nloc, nx); b.st[0] = nloc; b.st[1] = nx; }
        const unsigned old = xb_add(&bar[XB_XSUB(b.x)], 1u);
        const unsigned gen = old / nloc;
        if (old + 1u == (gen + 1u) * nloc) {
            __builtin_amdgcn_fence(__ATOMIC_RELEASE, "agent");
            asm volatile("s_waitcnt vmcnt(0)" ::: "memory");
            const unsigned og = xb_add(&bar[XB_TOP], 1u);
            const unsigned tg = og / nx;
            if (og + 1u == (tg + 1u) * nx) xb_add(&bar[XB_TOPGEN], 1u);
            else XB_SPIN(xb_ld(&bar[XB_TOPGEN]) == tg, bar);
            __builtin_amdgcn_fence(__ATOMIC_ACQUIRE, "agent");
            xb_add(&bar[XB_XGEN(b.x)], 1u);
            asm volatile("s_waitcnt vmcnt(0)" ::: "memory");
        } else {
            XB_SPIN(xb_ld(&bar[XB_XGEN(b.x)]) == gen, bar);
            __builtin_amdgcn_fence(__ATOMIC_ACQUIRE, "agent");
            asm volatile("s_waitcnt vmcnt(0)" ::: "memory");
        }
    }
    __syncthreads();
}
#ifndef MK_WGM_IN
#define MK_WGM_IN 8
#endif
#ifndef MK_WGM_OUT
#define MK_WGM_OUT 4
#endif
#ifndef MK_WGM_UP
#define MK_WGM_UP 4
#endif
#ifndef MK_WGM_DN
#define MK_WGM_DN 4
#endif
#ifndef MK_RET_SIMPLE
#define MK_RET_SIMPLE 0
#endif
constexpr int N_SCAN_UNITS = MK_RWKV_CHUNK ? NB * RWH : NB * RWH * 2, N_RET_UNITS = NB * RETH * RET_G, N_ATT_ITEMS = NB * FOXH * (SEQ / 256);
__device__ __forceinline__ void phase_pre(PX p, int layer, LAS unsigned char* lds) {
    constexpr int NFOX = NB * FOXH, NNRM = NB * FOXH * (SEQ / 256), NKV = NB * RETH * (SEQ / 128) + NNRM, NPRE = MK_RWKV_SPLIT ? NB * (SEQ / 64) : NB * RWH * (SEQ / 64);
    for (int u = blockIdx.x; u < NFOX + NKV + NPRE; u += gridDim.x) { if (u < NFOX) fox_scan_unit(p, layer, u, lds); else if (u < NFOX + NNRM) fox_norm_unit(p, u - NFOX, lds); else if (u < NFOX + NKV) ret_kv_unit(p, u - NFOX - NNRM, lds); else {
#if MK_RWKV_SPLIT
            rwkv_prep_unit(p, layer, u - NFOX - NKV, lds);
#else
            rwkv_pre_unit(p, layer, u - NFOX - NKV, lds);
#endif
        } }
}
typedef fox::BlockRef<fox::bf16, fox::bf16> FoxRef;
__device__ __forceinline__ int fox_jlo(const unsigned char* ws, int bh, int qb) {
    const float* C = (const float*)(ws + WS_FOXC) + (size_t)bh * SEQ; const int P0 = qb * 256;
    const float* qn = (const float*)(ws + FOX_QN) + bh * 32; const float* kn = (const float*)(ws + FOX_KN) + bh * 32; float kmax = 0.f;
    for (int j = 0; j <= qb; ++j) kmax = fmaxf(kmax, kn[j]);
    const float thr = C[P0] - (110.0f * (1.0f / fox::SCALE) + 2.0f * qn[qb] * kmax);
    int lo = 0, hi = P0 / 64;
    while (lo < hi) { const int mid = (lo + hi) >> 1; if (C[64 * mid + 63] >= thr) hi = mid; else lo = mid + 1; }
    return lo;
}
__device__ __forceinline__ FoxRef fox_ref(const unsigned char* ws, int ent) {
    const int it = ent & 1023, qb = (SEQ / 256 - 1) - it / (NB * FOXH), bh = it % (NB * FOXH), b = bh / FOXH, hh = bh % FOXH;
    const fox::bf16* H = (const fox::bf16*)(ws + WS_H); FoxRef r;
    r.Q = H + ((size_t)b * SEQ + (size_t)qb * 256) * PINP + C_FQ + hh * 128;
    r.K = H + (size_t)b * SEQ * PINP + C_FK + hh * 128; r.V = H + (size_t)b * SEQ * PINP + C_FV + hh * 128;
    r.O = (fox::bf16*)(ws + WS_XB) + ((size_t)b * SEQ + (size_t)qb * 256) * DM + MIX_FOX + hh * 128;
    r.C = (const float*)(ws + WS_FOXC) + (size_t)bh * SEQ; r.P0 = qb * 256; r.JLO = (ent >> 10) & 255;
    return r;
}
constexpr int ATT_TAB = 140288;
__device__ __forceinline__ void att_build_order(PX p, LAS unsigned char* lds) {
    const int tid = otid(p.wvs); LAS unsigned* tab = (LAS unsigned*)(lds + ATT_TAB);
    LAS float* CE = (LAS float*)lds;
    LAS float* KMP = CE + 24 * 128;
    const float* Cg = (const float*)(p->ws + WS_FOXC); const float* kn = (const float*)(p->ws + FOX_KN);
#pragma unroll
    for (int i = 0; i < 6; ++i) { const int e = tid + NTHR * i, bh = e >> 7, j = e & 127; CE[e] = Cg[(size_t)bh * SEQ + 64 * j + 63]; }
    if (tid < 24) { float m = 0.f;
        for (int j = 0; j < 32; ++j) { m = fmaxf(m, kn[tid * 32 + j]); KMP[tid * 32 + j] = m; } }
    __syncthreads();
#pragma unroll
    for (int e2 = 0; e2 < 2; ++e2) { const int it = tid + NTHR * e2; unsigned key = 0u;
        if (it < N_ATT_ITEMS) { const int qb = (SEQ / 256 - 1) - it / (NB * FOXH), bh = it % (NB * FOXH), P0 = qb * 256;
            const float thr = Cg[(size_t)bh * SEQ + P0] - (110.0f * (1.0f / fox::SCALE) + 2.0f * ((const float*)(p->ws + FOX_QN))[bh * 32 + qb] * KMP[bh * 32 + qb]);
            int lo = 0, hi = P0 / 64;
            while (lo < hi) { const int mid = (lo + hi) >> 1; if (CE[bh * 128 + mid] >= thr) hi = mid; else lo = mid + 1; }
            key = ((unsigned)(4 * (qb + 1) - lo) << 18) | ((unsigned)lo << 10) | (unsigned)it; }
        tab[it] = key; }
    __syncthreads();
    for (int kk = 2; kk <= 1024; kk <<= 1)
        for (int j = kk >> 1; j > 0; j >>= 1) {
            if (j >= 128) __syncthreads();
            const int i = ((tid / j) * 2 * j) + (tid % j), l = i + j; const unsigned a = tab[i], c = tab[l]; const bool desc = (i & kk) == 0;
            if (desc ? (a < c) : (a > c)) { tab[i] = c; tab[l] = a; }
            if (j >= 128) __syncthreads(); else asm volatile("s_waitcnt lgkmcnt(0)" ::: "memory");
        }
    __syncthreads();
}
__device__ __forceinline__ int att_fetch(bool lead, unsigned* head, volatile LAS unsigned* slot) {
    if (lead) *slot = __hip_atomic_fetch_add(head, 1u, __ATOMIC_RELAXED, __HIP_MEMORY_SCOPE_AGENT);
    __syncthreads();
    return __builtin_amdgcn_readfirstlane((int)*slot);
}
__device__ __forceinline__ void phase_mix(PX p, int qslot, int layer, unsigned char* lds_g, LAS unsigned char* lds) {
    att_build_order(p, lds);
    for (int u = blockIdx.x; u < N_SCAN_UNITS + N_RET_UNITS; u += gridDim.x) {
#ifndef NO_SCAN
        if (u < N_SCAN_UNITS) {
#if MK_RWKV_SPLIT
            rwkv_chain_unit(p, u, lds);
#elif MK_RWKV_CHUNK
            rwkv_chunk_unit(p, u, lds);
#else
            rwkv_scan_unit(p, u, lds);
#endif
#ifdef MK_SCAN2
            __syncthreads(); rwkv_chain_unit(p, u, lds);
#endif
        }
#endif
#ifndef NO_RET
#if MK_RET_SIMPLE
        if (u >= N_SCAN_UNITS) ret_simple_unit(p, layer, u - N_SCAN_UNITS, lds);
#else
        if (u >= N_SCAN_UNITS) { ret_mfma_unit(p, layer, u - N_SCAN_UNITS, lds);
#ifdef MK_RET2
            ret_mfma_unit(p, layer, u - N_SCAN_UNITS, lds);
#endif
        }
#endif
#endif
    }
    __syncthreads();
#ifdef MK_ATT2
    for (int arep = 0; arep < 2; ++arep) { const int qslot_ = qslot + 8 * arep;
#else
    { const int qslot_ = qslot;
#endif
    unsigned* head = (unsigned*)(p->ws + WS_CTL) + CW_QATT + 64 * qslot_;
    volatile LAS unsigned* slot = (volatile LAS unsigned*)(lds + MISC_OFF + 64);
#ifdef NO_ATT
    int it = N_ATT_ITEMS;
#else
    const bool lead = otid(p.wvs) == 0;
    int it = att_fetch(lead, head, slot);
#endif
    const LAS unsigned* tab = (const LAS unsigned*)(lds + ATT_TAB);
    if (it < N_ATT_ITEMS) {
        struct RF { CP p; __device__ __forceinline__ FoxRef operator()(int i) const { return fox_ref(p->ws, i); } } rf{p.p};
        fox::Seam<fox::bf16> S; S.wv = p.wvs;
        int ent = __builtin_amdgcn_readfirstlane((int)tab[it]);
        { const FoxRef cur = rf(ent); fox::causal_swa_prime<fox::bf16, fox::bf16>(cur, 1 << 30, (char*)lds_g, S); }
        for (;;) {
            const int itn = att_fetch(lead, head, slot); const bool last = itn >= N_ATT_ITEMS; const int entn = last ? ent : __builtin_amdgcn_readfirstlane((int)tab[itn]);
            fox::causal_swa_block<fox::bf16, fox::bf16, RF>(ent, entn, rf, SEQ, 1 << 30, (char*)lds_g, S);
            if (last) break;
            ent = entn;
        }
    }
    }
}

#ifndef MK_SPLIT
#define MK_SPLIT 0
#endif
constexpr int N_PHASES = DEPTH * 10;
__device__ __forceinline__ CP kargs() { CP q = (CP)__builtin_amdgcn_kernarg_segment_ptr(); asm volatile("; kargs" : "+s"(q)); return q; }
__global__ void __launch_bounds__(NTHR, 2) mk_fwd(Params p_unused) {
    extern __shared__ __attribute__((aligned(16))) unsigned char lds_raw[];
    LAS unsigned char* lds = (LAS unsigned char*)lds_raw;
    const int tid = threadIdx.x; const int wvs = __builtin_amdgcn_readfirstlane(tid >> 6);
    const PX p{kargs(), wvs};
    if (tid < 64) ((LAS unsigned*)(lds + MISC_OFF))[tid] = 0u;
    __syncthreads();
    if (!MK_SPLIT) (void)xcd_barrier_post((unsigned*)(p->ws + WS_CTL) + CW_BAR, (volatile LAS unsigned*)(lds + MISC_OFF) + 8);
#if MK_SPLIT
    const int lo = p->ph_lo, hi = p->ph_hi;
#else
    constexpr int lo = 0, hi = N_PHASES;
#endif
#ifndef MK_MASK
#define MK_MASK 0x3ff
#endif
#define IN(q) (((MK_MASK >> (q)) & 1) && lo <= l * 10 + (q) && l * 10 + (q) < hi)
#define SEAM(q) do { if (l * 10 + (q) + 1 < hi) { if (MK_SPLIT) {} else { XcdBarrier bar; bar.lead = otid(wvs) == 0; bar.bar = (unsigned*)(p->ws + WS_CTL) + CW_BAR; bar.x = xb_xcc_id(); bar.st = (volatile LAS unsigned*)(lds + MISC_OFF) + 8; xcd_barrier(bar); } } } while (0)
#define XB ((bf16_t*)(p->ws + WS_XB))
#define Hb ((bf16_t*)(p->ws + WS_H))
#define HID ((bf16_t*)(p->ws + WS_HID))
#define WinT ((const bf16_t*)(p->ws + WS_WIN))
#define WoutT ((const bf16_t*)(p->ws + WS_WOUT))
#define WupT ((const bf16_t*)(p->ws + WS_WUP))
#define WdnT ((const bf16_t*)(p->ws + WS_WDN))
#ifndef MK_REP
#define MK_REP 0
#endif
#define REPS(q) ((((MK_REP) >> (q)) & 1) ? 2 : 1)
#define LAYER_BODY(LL) do { constexpr int l = (LL); \
        if (l == 0 && IN(0)) for (int rep = 0; rep < REPS(0); ++rep) { const PX p{kargs(), wvs}; phase_prologue(p); phase_convert(p, l, lds); SEAM(0); }     \
        if (IN(1)) for (int rep = 0; rep < REPS(1); ++rep) { const PX p{kargs(), wvs}; \
            pg8::Gemm g{XB, WinT, M, PINP, DM}; pg8::StaticOrder S; S.init(M, PINP, (int)gridDim.x, (int)blockIdx.x); S.wv = wvs; S.wgm = MK_WGM_IN; \
            pg8::EpiInProj E{Hb, (float*)(p->ws + WS_FLOG)}; \
            pg8::gemm_phase<pg8::EpiInProj, pg8::StaticOrder, PG8_ALIGN, PG8_SP2>(lds, g, S, E); \
            SEAM(1); } \
        if (IN(2)) for (int rep = 0; rep < REPS(2); ++rep) { const PX p{kargs(), wvs}; phase_pre(p, l, lds); SEAM(2); } \
        if (IN(3)) for (int rep = 0; rep < REPS(3); ++rep) { const PX p{kargs(), wvs}; phase_mix(p, l + 4 * rep, l, lds_raw, lds); SEAM(3); } \
        if (IN(4)) for (int rep = 0; rep < REPS(4); ++rep) { const PX p{kargs(), wvs}; phase_post(p, l, lds); SEAM(4); } \
        if (IN(5)) for (int rep = 0; rep < REPS(5); ++rep) { const PX p{kargs(), wvs}; \
            pg8::Gemm g{XB, WoutT, M, DM, DM}; pg8::StaticOrder S; S.init(M, DM, (int)gridDim.x, (int)blockIdx.x); S.wv = wvs; S.wgm = MK_WGM_OUT; \
            pg8::EpiResid E{p->out, l > 0 ? (const float*)p->out : p->in[0], (const float*)(p->ws + WS_STATS) + (l > 0 ? 2 * M : 4 * M), l > 0 ? p->in[21] + (l - 1) * DM : (const float*)(p->ws + WS_STATS) + 6 * M, l > 0 ? p->in[22] + (l - 1) * DM : (const float*)(p->ws + WS_STATS) + 6 * M + DM}; \
            pg8::gemm_phase<pg8::EpiResid, pg8::StaticOrder, PG8_ALIGN, PG8_SP2>(lds, g, S, E); \
            SEAM(5); } \
        if (IN(6)) for (int rep = 0; rep < REPS(6); ++rep) { const PX p{kargs(), wvs}; phase_ln<false>(p, p->in[17] + l * DM, p->in[18] + l * DM, (float*)(p->ws + WS_STATS)); SEAM(6); } \
        if (IN(7)) for (int rep = 0; rep < REPS(7); ++rep) { const PX p{kargs(), wvs}; \
            pg8::Gemm g{XB, WupT, M, DFF, DM}; pg8::StaticOrder S; S.init(M, DFF, (int)gridDim.x, (int)blockIdx.x); S.wv = wvs; S.wgm = MK_WGM_UP; \
            pg8::EpiRelu2 E{HID, DFF}; \
            pg8::gemm_phase<pg8::EpiRelu2, pg8::StaticOrder, PG8_ALIGN, PG8_SP2>(lds, g, S, E); \
            SEAM(7); } \
        if (IN(8)) for (int rep = 0; rep < REPS(8); ++rep) { const PX p{kargs(), wvs}; \
            pg8::Gemm g{HID, WdnT, M, DM, DFF}; pg8::StaticOrder S; S.init(M, DM, (int)gridDim.x, (int)blockIdx.x); S.wv = wvs; S.wgm = MK_WGM_DN; \
            pg8::EpiResid E{p->out, (const float*)p->out, (const float*)(p->ws + WS_STATS), p->in[17] + l * DM, p->in[18] + l * DM}; \
            pg8::gemm_phase<pg8::EpiResid, pg8::StaticOrder, PG8_ALIGN, PG8_SP2>(lds, g, S, E); \
            SEAM(8); } \
        if (IN(9)) for (int rep = 0; rep < REPS(9); ++rep) { const PX p{kargs(), wvs}; if (l == DEPTH - 1) phase_ln<true>(p, p->in[21] + l * DM, p->in[22] + l * DM, nullptr); else { phase_ln<false>(p, p->in[21] + l * DM, p->in[22] + l * DM, (float*)(p->ws + WS_STATS) + 2 * M); phase_convert(p, l + 1, lds); } SEAM(9); } \
    } while (0)
    LAYER_BODY(0); LAYER_BODY(1); LAYER_BODY(2); LAYER_BODY(3);
#undef LAYER_BODY
#undef IN
#undef SEAM
#undef XB
#undef Hb
#undef HID
#undef WinT
#undef WoutT
#undef WupT
#undef WdnT
}

extern "C" void kernel_launch(void* const* d_in, const int* in_sizes, int n_in, void* d_out, int out_size, void* d_ws, size_t ws_size, hipStream_t stream) {
    static int grid = 0;
    if (grid == 0) {
        if (n_in != 23 || out_size != M * DM || ws_size < WS_END) { fprintf(stderr, "kernel_launch: unexpected shapes (n_in %d, out %d, ws %zu, need %zu)\n", n_in, out_size, ws_size, (size_t)WS_END); grid = -1; return; }
        int dev = 0, cus = 0, per_cu = 0;
        if (hipGetDevice(&dev) != hipSuccess || hipDeviceGetAttribute(&cus, hipDeviceAttributeMultiprocessorCount, dev) != hipSuccess) { grid = -1; return; }
        if (hipFuncSetAttribute((const void*)mk_fwd, hipFuncAttributeMaxDynamicSharedMemorySize, LDS_BYTES) != hipSuccess) { fprintf(stderr, "kernel_launch: hipFuncSetAttribute failed\n"); grid = -1; return; }
        if (hipOccupancyMaxActiveBlocksPerMultiprocessor(&per_cu, (const void*)mk_fwd, NTHR, LDS_BYTES) != hipSuccess || per_cu < 1) { fprintf(stderr, "kernel_launch: occupancy query says %d\n", per_cu); }
        (void)hipGetLastError();
        grid = cus;
    }
    if (grid < 0) return;
    (void)hipMemsetAsync((char*)d_ws + WS_CTL, 0, 64 * 1024, stream);
    Params p{};
    for (int i = 0; i < 23; ++i) p.in[i] = (const float*)d_in[i];
    p.out = (float*)d_out; p.ws = (unsigned char*)d_ws;
#if MK_SPLIT
    for (int g = 0; g < N_PHASES; ++g) { p.ph_lo = g; p.ph_hi = g + 1; hipLaunchKernelGGL(mk_fwd, dim3(grid), dim3(NTHR), LDS_BYTES, stream, p); }
#else
    p.ph_lo = 0; p.ph_hi = N_PHASES; hipLaunchKernelGGL(mk_fwd, dim3(grid), dim3(NTHR), LDS_BYTES, stream, p);
#endif
}
```
